# Optimizing an MI355X kernel written in HIP

```python
import math
import jax, jax.numpy as jnp
from jax import lax
import numpy as np

D_MODEL = 4096
BATCH = 4
SEQ = 2048
DEPTH = 2
DEC_BATCH = 32
DEC_SEQ = 4
PAST_LEN = 16384
PAGE_SIZE = 128

N_EVEN = (DEPTH + 1) // 2
N_ODD = DEPTH // 2

D_S5 = D_MODEL // 2
S5_GROUP = 16
S5_GROUPS = D_S5 // S5_GROUP
S5_STATE = 64

HEAD_DIM = 64
SWA_HEADS = (D_MODEL // 2) // HEAD_DIM
SWA_KV_HEADS = 8
SWA_GQ = SWA_HEADS // SWA_KV_HEADS
D_SWA_Q = SWA_HEADS * HEAD_DIM
D_SWA_KV = SWA_KV_HEADS * HEAD_DIM
WINDOW = 128
SWA_BLOCK = 128
N_BUCKETS = 32
MAX_DISTANCE = 128

HG_DK = 128
HG_HEADS = D_MODEL // HG_DK
HG_DV = D_MODEL // HG_HEADS
HG_CHUNK = 32

N_MEM = 256
MEM_HEADS = 4
MEM_HEAD_DIM = 128
D_MEM = MEM_HEADS * MEM_HEAD_DIM

D_FF = 256 * ((-(-8 * D_MODEL // 3) + 255) // 256)

ALPHA = (2 * DEPTH) ** 0.25
BETA = (8 * DEPTH) ** -0.25
LN_EPS = 1e-5
RMS_EPS = 1e-6
NEG_BIG = -1e30

kernel_name = "s5_swa_hgrn2_memory_hybrid_step"


def layer_norm(x, g, b):
    xf = x.astype(jnp.float32)
    mu = jnp.mean(xf, axis=-1, keepdims=True)
    var = jnp.mean(jnp.square(xf - mu), axis=-1, keepdims=True)
    return ((xf - mu) * lax.rsqrt(var + LN_EPS) * g.astype(jnp.float32) + b.astype(jnp.float32)).astype(x.dtype)


def rms_norm(x, g):
    xf = x.astype(jnp.float32)
    return xf * lax.rsqrt(jnp.mean(xf * xf, axis=-1, keepdims=True) + RMS_EPS) * g.astype(jnp.float32)


def t5_bucket(dist):
    n = jnp.maximum(dist, 0)
    max_exact = N_BUCKETS // 2
    nf = jnp.maximum(n, 1).astype(jnp.float32)
    large = max_exact + (jnp.log(nf / max_exact) / math.log(MAX_DISTANCE / max_exact)
                         * (N_BUCKETS - max_exact)).astype(jnp.int32)
    large = jnp.minimum(large, N_BUCKETS - 1)
    return jnp.where(n < max_exact, n, large)


def s5_discretize(lam_re, lam_im, log_dt, b_re, b_im):
    f32 = jnp.float32
    lr = jnp.minimum(lam_re.astype(f32), -1e-4)
    li = lam_im.astype(f32)
    dt = jnp.exp(log_dt.astype(f32))[:, None]
    mag = jnp.exp(lr * dt)
    a_re = mag * jnp.cos(li * dt)
    a_im = mag * jnp.sin(li * dt)
    den = lr * lr + li * li
    fr = ((a_re - 1.0) * lr + a_im * li) / den
    fi = (a_im * lr - (a_re - 1.0) * li) / den
    br, bi = b_re.astype(f32), b_im.astype(f32)
    bb_re = fr[..., None] * br - fi[..., None] * bi
    bb_im = fr[..., None] * bi + fi[..., None] * br
    return a_re, a_im, bb_re, bb_im


def _complex_affine_combine(e1, e2):
    a1r, a1i, b1r, b1i = e1
    a2r, a2i, b2r, b2i = e2
    return (a2r * a1r - a2i * a1i,
            a2r * a1i + a2i * a1r,
            a2r * b1r - a2i * b1i + b2r,
            a2r * b1i + a2i * b1r + b2i)


def s5_scan(u, h0_re, h0_im, a_re, a_im, bb_re, bb_im, c_re, c_im, d_skip):
    f32 = jnp.float32
    uf = u.astype(f32)
    br = jnp.einsum('gph,btgh->btgp', bb_re, uf)
    bi = jnp.einsum('gph,btgh->btgp', bb_im, uf)
    h0r, h0i = h0_re.astype(f32), h0_im.astype(f32)
    br = br.at[:, 0].add(a_re * h0r - a_im * h0i)
    bi = bi.at[:, 0].add(a_re * h0i + a_im * h0r)
    t = u.shape[1]
    ar = jnp.broadcast_to(a_re, (1, t) + a_re.shape)
    ai = jnp.broadcast_to(a_im, (1, t) + a_im.shape)
    _, _, hr, hi = lax.associative_scan(_complex_affine_combine, (ar, ai, br, bi), axis=1)
    y = (jnp.einsum('ghp,btgp->btgh', c_re.astype(f32), hr)
         - jnp.einsum('ghp,btgp->btgh', c_im.astype(f32), hi)
         + d_skip.astype(f32) * uf)
    return y, hr[:, -1], hi[:, -1]


def swa_attend(q, k, v, q_pos, k_pos, sinks, rel_bias):
    f32 = jnp.float32
    lead = q.shape[:-3]
    tq, tk = q.shape[-3], k.shape[-3]
    qg = q.reshape(*lead, tq, SWA_KV_HEADS, SWA_GQ, HEAD_DIM)
    s = jnp.einsum('...qhgd,...shd->...hgqs', qg, k).astype(f32) * (HEAD_DIM ** -0.5)
    dist = q_pos[..., :, None] - k_pos[..., None, :]
    valid = (dist >= 0) & (dist < WINDOW) & (k_pos[..., None, :] >= 0)
    bias = jnp.moveaxis(rel_bias[t5_bucket(dist)], -1, -3)
    bias = bias.reshape(*bias.shape[:-3], SWA_KV_HEADS, SWA_GQ, tq, tk)
    s = s + bias.astype(f32)
    s = jnp.where(valid[..., None, None, :, :], s, NEG_BIG)
    sk = sinks.astype(f32).reshape(SWA_KV_HEADS, SWA_GQ)[..., None, None]
    m = jnp.maximum(jnp.max(s, axis=-1, keepdims=True), sk)
    p = jnp.exp(s - m)
    p = p / (jnp.sum(p, axis=-1, keepdims=True) + jnp.exp(sk - m))
    o = jnp.einsum('...hgqs,...shd->...qhgd', p.astype(v.dtype), v)
    return o.reshape(*lead, tq, SWA_HEADS * HEAD_DIM)


def swa_prompt(q, k, v, sinks, rel_bias):
    b, t = q.shape[:2]
    nb = t // SWA_BLOCK
    qb = q.reshape(b, nb, SWA_BLOCK, SWA_HEADS, HEAD_DIM)
    kb = k.reshape(b, nb, SWA_BLOCK, SWA_KV_HEADS, HEAD_DIM)
    vb = v.reshape(b, nb, SWA_BLOCK, SWA_KV_HEADS, HEAD_DIM)
    kk = jnp.concatenate([jnp.concatenate([jnp.zeros_like(kb[:, :1]), kb[:, :-1]], axis=1), kb], axis=2)
    vv = jnp.concatenate([jnp.concatenate([jnp.zeros_like(vb[:, :1]), vb[:, :-1]], axis=1), vb], axis=2)
    pos = jnp.arange(t, dtype=jnp.int32).reshape(nb, SWA_BLOCK)
    k_pos = jnp.concatenate([pos - SWA_BLOCK, pos], axis=1)
    o = swa_attend(qb, kk, vv, pos, k_pos, sinks, rel_bias)
    return o.reshape(b, t, D_SWA_Q)


def swa_sample(q, k, v, buf_k, buf_v, sinks, rel_bias):
    t = q.shape[1]
    w_buf = buf_k.shape[1]
    kk = jnp.concatenate([buf_k.astype(k.dtype), k], axis=1)
    vv = jnp.concatenate([buf_v.astype(v.dtype), v], axis=1)
    q_pos = PAST_LEN + jnp.arange(t, dtype=jnp.int32)
    k_pos = jnp.concatenate([PAST_LEN - w_buf + jnp.arange(w_buf, dtype=jnp.int32), q_pos])
    o = swa_attend(q, kk, vv, q_pos, k_pos, sinks, rel_bias)
    return o, kk[:, -w_buf:], vv[:, -w_buf:]


def even_mixer(x, h0_re, h0_im, buf_k, buf_v, w_in, s5p, sinks, rel_bias, w_out, w_buf):
    b, t, _ = x.shape
    a_re, a_im, bb_re, bb_im, c_re, c_im, d_skip, w_glu = s5p
    h = x @ w_in
    u, q, k, v = jnp.split(h, [D_S5, D_S5 + D_SWA_Q, D_S5 + D_SWA_Q + D_SWA_KV], axis=-1)
    y, hr, hi = s5_scan(u.reshape(b, t, S5_GROUPS, S5_GROUP), h0_re, h0_im,
                        a_re, a_im, bb_re, bb_im, c_re, c_im, d_skip)
    z = jax.nn.gelu(y.reshape(b, t, D_S5)).astype(x.dtype)
    s5_out = z * jax.nn.sigmoid(z @ w_glu)
    q = q.reshape(b, t, SWA_HEADS, HEAD_DIM)
    k = k.reshape(b, t, SWA_KV_HEADS, HEAD_DIM)
    v = v.reshape(b, t, SWA_KV_HEADS, HEAD_DIM)
    if buf_k is None:
        att = swa_prompt(q, k, v, sinks, rel_bias)
        new_k, new_v = k[:, -w_buf:], v[:, -w_buf:]
    else:
        att, new_k, new_v = swa_sample(q, k, v, buf_k, buf_v, sinks, rel_bias)
    out = jnp.concatenate([s5_out, att.astype(x.dtype)], axis=-1) @ w_out
    return out, hr, hi, new_k, new_v


def hgrn2_recurrence(q, k, v, logf, s0):
    b, t = q.shape[:2]
    pad = (-t) % HG_CHUNK
    if pad:
        pw = ((0, 0), (0, pad), (0, 0), (0, 0))
        q, k, v, logf = (jnp.pad(a, pw) for a in (q, k, v, logf))
    nc = (t + pad) // HG_CHUNK

    def chunks(a):
        return a.reshape(b, nc, HG_CHUNK, HG_HEADS, a.shape[-1]).transpose(1, 0, 3, 2, 4)

    q, k, v, logf = chunks(q), chunks(k), chunks(v), chunks(logf)
    cum = jnp.cumsum(logf, axis=-2)
    q_t = q * jnp.exp(cum)
    k_t = k * jnp.exp(-cum)
    k_last = k * jnp.exp(cum[..., -1:, :] - cum)
    decay_last = jnp.exp(cum[..., -1, :])
    mask = jnp.tril(jnp.ones((HG_CHUNK, HG_CHUNK), dtype=bool))
    attn = jnp.where(mask, jnp.einsum('nbhcd,nbhsd->nbhcs', q_t, k_t), 0.0)
    o_intra = jnp.einsum('nbhcs,nbhsv->nbhcv', attn, v)

    def step(s, inp):
        qc, kc, vc, dc = inp
        o_inter = jnp.einsum('bhcd,bhdv->bhcv', qc, s)
        s = dc[..., None] * s + jnp.einsum('bhcd,bhcv->bhdv', kc, vc)
        return s, o_inter

    s_fin, o_inter = lax.scan(step, s0, (q_t, k_last, v, decay_last))
    o = (o_intra + o_inter).transpose(1, 0, 3, 2, 4).reshape(b, nc * HG_CHUNK, HG_HEADS, HG_DV)[:, :t]
    return o, s_fin


def odd_mixer(x, s0, lb, w_in, norm_g, w_out):
    b, t, _ = x.shape
    f32 = jnp.float32
    q, fz, i, g = jnp.split(x @ w_in, 4, axis=-1)
    q = jax.nn.silu(q.astype(f32))
    f = lb + (1.0 - lb) * jax.nn.sigmoid(fz.astype(f32))
    logf = jnp.log(f)
    k = 1.0 - f
    o, s_new = hgrn2_recurrence(q.reshape(b, t, HG_HEADS, HG_DK), k.reshape(b, t, HG_HEADS, HG_DK),
                                i.astype(f32).reshape(b, t, HG_HEADS, HG_DV),
                                logf.reshape(b, t, HG_HEADS, HG_DK), s0.astype(f32))
    o = rms_norm(o.reshape(b, t, D_MODEL), norm_g) * jax.nn.sigmoid(g.astype(f32))
    return o.astype(x.dtype) @ w_out, s_new


def memory_kv(mem, wk, wv):
    b = mem.shape[0]
    return ((mem @ wk).reshape(b, N_MEM, MEM_HEADS, MEM_HEAD_DIM),
            (mem @ wv).reshape(b, N_MEM, MEM_HEADS, MEM_HEAD_DIM))


def cross_attn(x, mk, mv, wq, wo):
    b, t, _ = x.shape
    q = (x @ wq).reshape(b, t, MEM_HEADS, MEM_HEAD_DIM)
    s = jnp.einsum('bthd,bshd->bhts', q, mk.astype(q.dtype)).astype(jnp.float32) * (MEM_HEAD_DIM ** -0.5)
    p = jax.nn.softmax(s, axis=-1)
    o = jnp.einsum('bhts,bshd->bthd', p.astype(x.dtype), mv.astype(x.dtype)).reshape(b, t, D_MEM)
    return o @ wo


def swiglu(x, wg, wu, wd):
    return (jax.nn.silu(x @ wg) * (x @ wu)) @ wd


def setup_inputs(seed: int = 0) -> dict:
    key = jax.random.key(seed)
    keys = iter(jax.random.split(key, 48))
    f32 = jnp.float32

    def nrm(shape, scale):
        return jax.random.normal(next(keys), shape, f32) * scale

    w_buf = min(WINDOW, PAST_LEN)
    d_in_even = D_S5 + D_SWA_Q + 2 * D_SWA_KV
    n_idx = jnp.arange(S5_STATE, dtype=f32)
    return {
        "x_prompt": nrm((BATCH, SEQ, D_MODEL), 1.0),
        "x_sample": nrm((DEC_BATCH, DEC_SEQ, D_MODEL), 1.0),
        "cache_mem_k": nrm((DEPTH, DEC_BATCH, N_MEM, MEM_HEADS, MEM_HEAD_DIM), 1.0),
        "cache_mem_v": nrm((DEPTH, DEC_BATCH, N_MEM, MEM_HEADS, MEM_HEAD_DIM), 1.0),
        "cache_swa_k": nrm((N_EVEN, DEC_BATCH, w_buf, SWA_KV_HEADS, HEAD_DIM), 1.0),
        "cache_swa_v": nrm((N_EVEN, DEC_BATCH, w_buf, SWA_KV_HEADS, HEAD_DIM), 1.0),
        "state_s5_re": nrm((N_EVEN, DEC_BATCH, S5_GROUPS, S5_STATE), 0.5),
        "state_s5_im": nrm((N_EVEN, DEC_BATCH, S5_GROUPS, S5_STATE), 0.5),
        "state_hgrn": nrm((N_ODD, DEC_BATCH, HG_HEADS, HG_DK, HG_DV), 0.5),
        "mem_prompt": nrm((BATCH, N_MEM, D_MODEL), 1.0),
        "rel_bias": nrm((N_BUCKETS, SWA_HEADS), 0.5),
        "w_even_in": nrm((N_EVEN, D_MODEL, d_in_even), D_MODEL ** -0.5),
        "s5_lam_re": -0.5 + nrm((N_EVEN, S5_GROUPS, S5_STATE), 0.01),
        "s5_lam_im": jnp.pi * n_idx + nrm((N_EVEN, S5_GROUPS, S5_STATE), 0.01),
        "s5_log_dt": jax.random.uniform(next(keys), (N_EVEN, S5_GROUPS), f32,
                                        minval=math.log(1e-3), maxval=math.log(1e-1)),
        "s5_b_re": nrm((N_EVEN, S5_GROUPS, S5_STATE, S5_GROUP), (2 * S5_GROUP) ** -0.5),
        "s5_b_im": nrm((N_EVEN, S5_GROUPS, S5_STATE, S5_GROUP), (2 * S5_GROUP) ** -0.5),
        "s5_c_re": nrm((N_EVEN, S5_GROUPS, S5_GROUP, S5_STATE), S5_STATE ** -0.5),
        "s5_c_im": nrm((N_EVEN, S5_GROUPS, S5_GROUP, S5_STATE), S5_STATE ** -0.5),
        "s5_d": nrm((N_EVEN, S5_GROUPS, S5_GROUP), 1.0),
        "s5_w_glu": nrm((N_EVEN, D_S5, D_S5), D_S5 ** -0.5),
        "swa_sinks": nrm((N_EVEN, SWA_HEADS), 1.0),
        "w_even_out": nrm((N_EVEN, D_MODEL, D_MODEL), BETA * D_MODEL ** -0.5),
        "hg_lb_logits": nrm((DEPTH, D_MODEL), 0.5),
        "w_odd_in": nrm((N_ODD, D_MODEL, 4 * D_MODEL), D_MODEL ** -0.5),
        "hg_norm_g": 1.0 + nrm((N_ODD, D_MODEL), 0.02),
        "w_odd_out": nrm((N_ODD, D_MODEL, D_MODEL), BETA * D_MODEL ** -0.5),
        "w_mem_q": nrm((DEPTH, D_MODEL, D_MEM), D_MODEL ** -0.5),
        "w_mem_k": nrm((DEPTH, D_MODEL, D_MEM), D_MODEL ** -0.5),
        "w_mem_v": nrm((DEPTH, D_MODEL, D_MEM), D_MODEL ** -0.5),
        "w_mem_o": nrm((DEPTH, D_MEM, D_MODEL), BETA * D_MEM ** -0.5),
        "w_ffn_gate": nrm((DEPTH, D_MODEL, D_FF), D_MODEL ** -0.5),
        "w_ffn_up": nrm((DEPTH, D_MODEL, D_FF), D_MODEL ** -0.5),
        "w_ffn_down": nrm((DEPTH, D_FF, D_MODEL), BETA * D_FF ** -0.5),
        "ln_g": 1.0 + nrm((DEPTH, 3, D_MODEL), 0.02),
        "ln_b": nrm((DEPTH, 3, D_MODEL), 0.02),
    }


def reference(x_prompt, x_sample, cache_mem_k, cache_mem_v, cache_swa_k, cache_swa_v,
              state_s5_re, state_s5_im, state_hgrn, mem_prompt, rel_bias,
              w_even_in, s5_lam_re, s5_lam_im, s5_log_dt, s5_b_re, s5_b_im, s5_c_re, s5_c_im,
              s5_d, s5_w_glu, swa_sinks, w_even_out, hg_lb_logits, w_odd_in, hg_norm_g, w_odd_out,
              w_mem_q, w_mem_k, w_mem_v, w_mem_o, w_ffn_gate, w_ffn_up, w_ffn_down, ln_g, ln_b):
    f32 = jnp.float32
    w_buf = cache_swa_k.shape[2]
    lb_soft = jax.nn.softmax(hg_lb_logits.astype(f32), axis=0)
    lower_bounds = jnp.cumsum(lb_soft, axis=0) - lb_soft[0]

    yp, ys = x_prompt, x_sample
    p_mem_k, p_mem_v = [], []
    p_swa_k, p_swa_v, p_s5_re, p_s5_im, p_hg = [], [], [], [], []
    s_swa_k, s_swa_v, s_s5_re, s_s5_im, s_hg = [], [], [], [], []

    for l in range(DEPTH):
        j = l // 2
        if l % 2 == 0:
            a_re, a_im, bb_re, bb_im = s5_discretize(s5_lam_re[j], s5_lam_im[j], s5_log_dt[j],
                                                     s5_b_re[j], s5_b_im[j])
            s5p = (a_re, a_im, bb_re, bb_im, s5_c_re[j], s5_c_im[j], s5_d[j], s5_w_glu[j])
            h0 = jnp.zeros((yp.shape[0], S5_GROUPS, S5_STATE), f32)
            mix_p, hr, hi, nk, nv = even_mixer(yp, h0, h0, None, None, w_even_in[j], s5p,
                                               swa_sinks[j], rel_bias, w_even_out[j], w_buf)
            p_s5_re.append(hr); p_s5_im.append(hi); p_swa_k.append(nk); p_swa_v.append(nv)
            mix_s, hr, hi, nk, nv = even_mixer(ys, state_s5_re[j], state_s5_im[j], cache_swa_k[j],
                                               cache_swa_v[j], w_even_in[j], s5p, swa_sinks[j],
                                               rel_bias, w_even_out[j], w_buf)
            s_s5_re.append(hr); s_s5_im.append(hi); s_swa_k.append(nk); s_swa_v.append(nv)
        else:
            s0 = jnp.zeros((yp.shape[0], HG_HEADS, HG_DK, HG_DV), f32)
            mix_p, sp = odd_mixer(yp, s0, lower_bounds[l], w_odd_in[j], hg_norm_g[j], w_odd_out[j])
            p_hg.append(sp)
            mix_s, ss = odd_mixer(ys, state_hgrn[j], lower_bounds[l], w_odd_in[j], hg_norm_g[j], w_odd_out[j])
            s_hg.append(ss)
        yp = layer_norm(ALPHA * yp + mix_p, ln_g[l, 0], ln_b[l, 0])
        ys = layer_norm(ALPHA * ys + mix_s, ln_g[l, 0], ln_b[l, 0])

        mk, mv = memory_kv(mem_prompt, w_mem_k[l], w_mem_v[l])
        p_mem_k.append(mk); p_mem_v.append(mv)
        yp = layer_norm(ALPHA * yp + cross_attn(yp, mk, mv, w_mem_q[l], w_mem_o[l]), ln_g[l, 1], ln_b[l, 1])
        ys = layer_norm(ALPHA * ys + cross_attn(ys, cache_mem_k[l], cache_mem_v[l], w_mem_q[l], w_mem_o[l]),
                        ln_g[l, 1], ln_b[l, 1])

        yp = layer_norm(ALPHA * yp + swiglu(yp, w_ffn_gate[l], w_ffn_up[l], w_ffn_down[l]), ln_g[l, 2], ln_b[l, 2])
        ys = layer_norm(ALPHA * ys + swiglu(ys, w_ffn_gate[l], w_ffn_up[l], w_ffn_down[l]), ln_g[l, 2], ln_b[l, 2])

    return (yp, ys,
            jnp.stack(p_mem_k), jnp.stack(p_mem_v),
            jnp.stack(p_swa_k), jnp.stack(p_swa_v),
            jnp.stack(p_s5_re), jnp.stack(p_s5_im), jnp.stack(p_hg),
            jnp.stack(s_swa_k), jnp.stack(s_swa_v),
            jnp.stack(s_s5_re), jnp.stack(s_s5_im), jnp.stack(s_hg))
```

```cpp
#include <hip/hip_runtime.h>
#include <cstdio>
#include <cstdint>
namespace pg8 {
#define PG8_LAS __attribute__((address_space(3)))
typedef unsigned short bf16_t;
typedef short bf16x8 __attribute__((ext_vector_type(8)));
typedef float f32x4 __attribute__((ext_vector_type(4)));
typedef unsigned u32x4 __attribute__((ext_vector_type(4)));
constexpr int BM = 256, BK = 64, HALF = 128, HTB = HALF * BK * 2  , STAGE_BYTES = 8 * HTB, NXCD = 8, WGM = 8;

__host__ __device__ __forceinline__ int lds_byte(int r, int c) { const int st = (r >> 4) * 2 + (c >> 5), rr = r & 15, cc = c & 31, ob = rr * 64 + cc * 2; return st * 1024 + (ob ^ (((ob >> 9) & 1) << 5)); }
__host__ __device__ __forceinline__ void stage_rc(int b, int& R, int& C) { const int st = b / 1024, sb = b % 1024, swz = sb ^ (((sb >> 9) & 1) << 5); R = (st >> 1) * 16 + swz / 64; C = (st & 1) * 32 + (swz % 64) / 2; }
__host__ __device__ __forceinline__ int perm32(int rho) { const int n = rho >> 4, i = rho & 15; return 8 * (i >> 2) + 4 * n + (i & 3); }

struct Unit { int pm, pn; };
struct Gemm { const bf16_t* A; const bf16_t* Bt; int M, N, K; };

struct StaticOrder {
    int nM, nN, nwg, G, c;
    __host__ __device__ void init(int M, int N, int G_, int c_) { nM = M / BM; nN = N / BM; nwg = nM * nN; G = G_; c = c_; }
    __host__ __device__ bool next(int i, Unit& u) const {
        const long L = (long)i * G + c; if (L >= nwg) return false;
        int wgid = (int)L; { const int q = nwg / NXCD, r = nwg % NXCD, xcd = wgid % NXCD, off = wgid / NXCD; wgid = (xcd < r ? xcd * (q + 1) : r * (q + 1) + (xcd - r) * q) + off; }
        const int nig = WGM * nN, gid = wgid / nig, fm = gid * WGM, gsz = (nM - fm) < WGM ? (nM - fm) : WGM;
        u.pm = fm + ((wgid % nig) % gsz); u.pn = (wgid % nig) / gsz; return true;
    }
    __device__ __forceinline__ void a_ready(const Unit&) const {}
    __device__ __forceinline__ void done(const Unit&) const {}
};

__device__ __forceinline__ unsigned cvt_pk_bf16(float lo, float hi) { unsigned r; asm volatile("v_cvt_pk_bf16_f32 %0, %1, %2" : "=v"(r) : "v"(lo), "v"(hi)); return r; }
typedef float f32x2 __attribute__((ext_vector_type(2)));
__device__ __forceinline__ f32x2 gelu_pk(f32x2 v) {
    const f32x2 av = __builtin_elementwise_abs(v), d = av * 0.2316418882f + 1.0f;
    f32x2 t; t.x = __builtin_amdgcn_rcpf(d.x); t.y = __builtin_amdgcn_rcpf(d.y);
    f32x2 q = t * 0.5307027145f + (-0.7265760135f); q = q * t + 0.7107068705f; q = q * t + (-0.142248368f); q = q * t + 0.127414796f; q = q * t;
    const f32x2 s = (v * v) * (-0.72134752044f);
    f32x2 e; e.x = __builtin_amdgcn_exp2f(s.x); e.y = __builtin_amdgcn_exp2f(s.y);
    const f32x2 m = v * (q * e), r = v - m;
    f32x2 o; o.x = v.x < 0.f ? m.x : r.x; o.y = v.y < 0.f ? m.y : r.y; return o;
}

template <int ACT  > struct EpiBf16 {
    static constexpr bool PERM = true, AFTER_DRAIN = false; static_assert(ACT == 0 || ACT == 1, "EpiBf16: ACT is 0 (none) or 1 (gelu_pk)");
    bf16_t* O; int ldc; const float* bias; int split_cols; size_t split_stride; float scale0;
    __device__ __forceinline__ void operator()(const f32x4 (&acc)[2][2][4][2], const Unit& u, int wr, int wc, int fr, int fq) const {
        const int row0 = u.pm * BM + wr * 64 + fr; int colt = u.pn * BM; bf16_t* base = O;
        float sc = 1.f; if (split_cols) { const int t = colt / split_cols; base += (size_t)t * split_stride; colt -= t * split_cols; if (t == 0) sc = scale0; }
        const int col0 = colt + wc * 32 + 8 * fq, bcol0 = u.pn * BM + wc * 32 + 8 * fq;
        f32x4 bv[2][2];
#pragma unroll
        for (int bj = 0; bj < 2; ++bj)
#pragma unroll
            for (int n = 0; n < 2; ++n) bv[bj][n] = bias ? *(const f32x4*)(bias + bcol0 + bj * HALF + 4 * n) : (f32x4){0.f, 0.f, 0.f, 0.f};
#pragma unroll
        for (int ai = 0; ai < 2; ++ai)
#pragma unroll
            for (int m = 0; m < 4; ++m) { bf16_t* rowp = base + (size_t)(row0 + ai * HALF + m * 16) * ldc + col0;
#pragma unroll
                for (int bj = 0; bj < 2; ++bj) { f32x4 v0 = acc[ai][bj][m][0] + bv[bj][0], v1 = acc[ai][bj][m][1] + bv[bj][1];
                    if (ACT == 1) { f32x2 a = gelu_pk((f32x2){v0[0], v0[1]}), b = gelu_pk((f32x2){v0[2], v0[3]}), c = gelu_pk((f32x2){v1[0], v1[1]}), d = gelu_pk((f32x2){v1[2], v1[3]});
                        v0 = (f32x4){a.x, a.y, b.x, b.y}; v1 = (f32x4){c.x, c.y, d.x, d.y}; }
                    v0 = v0 * sc; v1 = v1 * sc; u32x4 w; w.x = cvt_pk_bf16(v0[0], v0[1]); w.y = cvt_pk_bf16(v0[2], v0[3]); w.z = cvt_pk_bf16(v1[0], v1[1]); w.w = cvt_pk_bf16(v1[2], v1[3]);
                    *(u32x4*)(rowp + bj * HALF) = w; } }
    }
};

struct PanelStats {
    unsigned* xbuf;
    unsigned* cnt;
    unsigned* tmo;
    int ntn; float eps;
    unsigned code;
    __device__ __forceinline__ bool run(const f32x4 (&v)[2][2][4][2], const Unit& u, int wr, int wc, int fr, int fq, PG8_LAS unsigned char* lds, int wid, int lane) const {
        typedef float f32x2v __attribute__((ext_vector_type(2)));
        PG8_LAS f32x2v* P = (PG8_LAS f32x2v*)lds;
        PG8_LAS f32x2v* S = (PG8_LAS f32x2v*)(lds + 8192);
        PG8_LAS unsigned* flag = (PG8_LAS unsigned*)(lds + 8192 + 2048);
#pragma unroll
        for (int ai = 0; ai < 2; ++ai)
#pragma unroll
            for (int m = 0; m < 4; ++m) {
                float s = 0.f;
#pragma unroll
                for (int bj = 0; bj < 2; ++bj)
#pragma unroll
                    for (int n = 0; n < 2; ++n) { const f32x4 x = v[ai][bj][m][n]; s += (x[0] + x[1]) + (x[2] + x[3]); }
                s += __shfl_xor(s, 16); s += __shfl_xor(s, 32);
                const float mw = s * (1.0f / 64.0f); float q = 0.f;
#pragma unroll
                for (int bj = 0; bj < 2; ++bj)
#pragma unroll
                    for (int n = 0; n < 2; ++n) { const f32x4 d = v[ai][bj][m][n] - mw; q += (d[0] * d[0] + d[1] * d[1]) + (d[2] * d[2] + d[3] * d[3]); }
                q += __shfl_xor(q, 16); q += __shfl_xor(q, 32);
                if (fq == 0) P[(ai * HALF + wr * 64 + m * 16 + fr) * 4 + wc] = (f32x2v){mw, q};
            }
        asm volatile("s_waitcnt lgkmcnt(0)" ::: "memory"); __builtin_amdgcn_s_barrier(); asm volatile("" ::: "memory");
#if defined(BROKEN_EXCHANGE_NO_WAIT)
#warning BROKEN CONTROL BUILD: the row-statistics exchange does not wait; results are wrong by design
        if (blockIdx.x >= 64) { const long long t0_ = clock64(); while (clock64() - t0_ < 60000) __builtin_amdgcn_s_sleep(8); }
#endif
        const int row = wid * 32 + (lane & 31);
        if (lane < 32) {
            const f32x2v a = P[row * 4 + 0], b = P[row * 4 + 1], c = P[row * 4 + 2], d = P[row * 4 + 3];
            const float mt = (a.x + b.x + c.x + d.x) * 0.25f;
            const float da = a.x - mt, db = b.x - mt, dc = c.x - mt, dd = d.x - mt;
            const float m2 = (a.y + b.y) + (c.y + d.y) + 64.0f * ((da * da + db * db) + (dc * dc + dd * dd));
            unsigned long long* slot = (unsigned long long*)xbuf + ((size_t)(u.pm * BM + row) * 4 + u.pn);
            __hip_atomic_store(slot, ((unsigned long long)__float_as_uint(m2) << 32) | __float_as_uint(mt), __ATOMIC_RELAXED, __HIP_MEMORY_SCOPE_AGENT);
        }
        asm volatile("s_waitcnt vmcnt(0)" ::: "memory");
        if (lane == 0) __hip_atomic_fetch_add(cnt + 64 * u.pm, 1u, __ATOMIC_RELAXED, __HIP_MEMORY_SCOPE_AGENT);
        if (wid == 0) {
            bool dead = false; const unsigned long long t0 = __builtin_amdgcn_s_memrealtime(); const unsigned want = 8u * (unsigned)ntn;
            for (;;) {
#if defined(BROKEN_EXCHANGE_NO_WAIT)
                break;
#endif
                if ((unsigned)__builtin_amdgcn_readfirstlane(__hip_atomic_load(cnt + 64 * u.pm, __ATOMIC_RELAXED, __HIP_MEMORY_SCOPE_AGENT)) >= want) break;
                if (__builtin_amdgcn_s_memrealtime() - t0 > 2000000ull) {
                    if (lane == 0) { unsigned expect = 0u; __hip_atomic_compare_exchange_strong(tmo + 1, &expect, code | (unsigned)(u.pm & 0xff), __ATOMIC_RELAXED, __ATOMIC_RELAXED, __HIP_MEMORY_SCOPE_AGENT);
                                     __hip_atomic_store(tmo, 1u, __ATOMIC_RELAXED, __HIP_MEMORY_SCOPE_AGENT); }
                    dead = true; break; }
                __builtin_amdgcn_s_sleep(2);
            }
            __builtin_amdgcn_fence(__ATOMIC_ACQUIRE, "agent");
            if (lane == 0) flag[0] = dead ? 1u : 0u;
        }
        asm volatile("s_waitcnt vmcnt(0) lgkmcnt(0)" ::: "memory"); __builtin_amdgcn_s_barrier(); asm volatile("" ::: "memory");
        const bool bad = flag[0] != 0u;
        if (lane < 32) {
            const unsigned long long* slot = (const unsigned long long*)xbuf + (size_t)(u.pm * BM + row) * 4; float mt[4], m2[4]; float ms = 0.f;
#pragma unroll
            for (int t = 0; t < 4; ++t) { if (t < ntn) { const unsigned long long w = __hip_atomic_load(slot + t, __ATOMIC_RELAXED, __HIP_MEMORY_SCOPE_AGENT); mt[t] = __uint_as_float((unsigned)w); m2[t] = __uint_as_float((unsigned)(w >> 32)); } else { mt[t] = 0.f; m2[t] = 0.f; } ms += mt[t]; }
            const float mean = ms / (float)ntn; float q = 0.f;
#pragma unroll
            for (int t = 0; t < 4; ++t) if (t < ntn) { const float dm = mt[t] - mean; q += m2[t] + 256.0f * dm * dm; }
            S[row] = (f32x2v){mean, 1.0f / sqrtf(q / (256.0f * (float)ntn) + eps)};
        }
        asm volatile("s_waitcnt lgkmcnt(0)" ::: "memory"); __builtin_amdgcn_s_barrier(); asm volatile("" ::: "memory");
        return bad;
    }
};
struct EpiLnRes {
    static constexpr bool PERM = false, AFTER_DRAIN = true;
    const float* base; float* out; int ldc; const float* bias; PanelStats st; unsigned poison;
    __device__ __forceinline__ void fused(f32x4 (&acc)[2][2][4][2], const Unit& u, int wr, int wc, int fr, int fq, PG8_LAS unsigned char* lds, int wid, int lane) const {
        typedef float f32x2v __attribute__((ext_vector_type(2)));
        const PG8_LAS f32x2v* S = (const PG8_LAS f32x2v*)(lds + 8192);
        const int col0 = u.pn * BM + wc * 32 + 4 * fq;
#pragma unroll
        for (int bj = 0; bj < 2; ++bj)
#pragma unroll
            for (int n = 0; n < 2; ++n) { const f32x4 bv = bias ? *(const f32x4*)(bias + col0 + bj * HALF + n * 16) : (f32x4){0.f, 0.f, 0.f, 0.f};
#pragma unroll
                for (int ai = 0; ai < 2; ++ai)
#pragma unroll
                    for (int m = 0; m < 4; ++m) acc[ai][bj][m][n] += bv; }
        f32x4 pre[4][2][2];
#pragma unroll
        for (int m = 0; m < 4; ++m) { const size_t off = (size_t)(u.pm * BM + wr * 64 + m * 16 + fr) * ldc + col0;
#pragma unroll
            for (int bj = 0; bj < 2; ++bj)
#pragma unroll
                for (int n = 0; n < 2; ++n) pre[m][bj][n] = *(const f32x4*)(base + off + bj * HALF + n * 16); }
        const bool bad = st.run(acc, u, wr, wc, fr, fq, lds, wid, lane) || poison != 0u;
        const float qnan = __builtin_nanf("");
#pragma unroll
        for (int ai = 0; ai < 2; ++ai)
#pragma unroll
            for (int m = 0; m < 4; ++m) { const int r = ai * HALF + wr * 64 + m * 16 + fr; const f32x2v sr = S[r]; const size_t off = (size_t)(u.pm * BM + r) * ldc + col0;
#pragma unroll
                for (int bj = 0; bj < 2; ++bj)
#pragma unroll
                    for (int n = 0; n < 2; ++n) { const f32x4 bs = ai == 0 ? pre[m][bj][n] : *(const f32x4*)(base + off + bj * HALF + n * 16); f32x4 o = bs + (acc[ai][bj][m][n] - sr.x) * sr.y;
                        if (bad) o = (f32x4){qnan, qnan, qnan, qnan}; *(f32x4*)(out + off + bj * HALF + n * 16) = o; }
                if (m & 1) asm volatile("" ::: "memory"); }
    }
};
struct EpiLnResLn {
    static constexpr bool PERM = false, AFTER_DRAIN = true;
    const float* base; float* out; bf16_t* xn; int ldc; const float* bias; PanelStats st1, st2; unsigned poison;
    __device__ __forceinline__ void fused(f32x4 (&acc)[2][2][4][2], const Unit& u, int wr, int wc, int fr, int fq, PG8_LAS unsigned char* lds, int wid, int lane) const {
        typedef float f32x2v __attribute__((ext_vector_type(2))); typedef unsigned u32x2v __attribute__((ext_vector_type(2)));
        const PG8_LAS f32x2v* S = (const PG8_LAS f32x2v*)(lds + 8192);
        const int col0 = u.pn * BM + wc * 32 + 4 * fq;
#pragma unroll
        for (int bj = 0; bj < 2; ++bj)
#pragma unroll
            for (int n = 0; n < 2; ++n) { const f32x4 bv = bias ? *(const f32x4*)(bias + col0 + bj * HALF + n * 16) : (f32x4){0.f, 0.f, 0.f, 0.f};
#pragma unroll
                for (int ai = 0; ai < 2; ++ai)
#pragma unroll
                    for (int m = 0; m < 4; ++m) acc[ai][bj][m][n] += bv; }
        bool bad = st1.run(acc, u, wr, wc, fr, fq, lds, wid, lane) || poison != 0u;
        const float qnan = __builtin_nanf("");
#pragma unroll
        for (int ai = 0; ai < 2; ++ai)
#pragma unroll
            for (int m = 0; m < 4; ++m) { const int r = ai * HALF + wr * 64 + m * 16 + fr; const f32x2v sr = S[r]; const size_t off = (size_t)(u.pm * BM + r) * ldc + col0;
#pragma unroll
                for (int bj = 0; bj < 2; ++bj)
#pragma unroll
                    for (int n = 0; n < 2; ++n) { const f32x4 bs = *(const f32x4*)(base + off + bj * HALF + n * 16); acc[ai][bj][m][n] = bs + (acc[ai][bj][m][n] - sr.x) * sr.y; }
                asm volatile("" : "+v"(acc[ai][0][m][0]), "+v"(acc[ai][0][m][1]), "+v"(acc[ai][1][m][0]), "+v"(acc[ai][1][m][1]));
                if (m & 1) asm volatile("" ::: "memory"); }
        const bool bad1 = bad;
        bad = st2.run(acc, u, wr, wc, fr, fq, lds, wid, lane) || bad;
#pragma unroll
        for (int ai = 0; ai < 2; ++ai)
#pragma unroll
            for (int m = 0; m < 4; ++m) { const int r = ai * HALF + wr * 64 + m * 16 + fr; const f32x2v sr = S[r]; const size_t off = (size_t)(u.pm * BM + r) * ldc + col0;
#pragma unroll
                for (int bj = 0; bj < 2; ++bj)
#pragma unroll
                    for (int n = 0; n < 2; ++n) { const f32x4 x1 = acc[ai][bj][m][n]; *(f32x4*)(out + off + bj * HALF + n * 16) = bad1 ? (f32x4){qnan, qnan, qnan, qnan} : x1;
                        const f32x4 o = (x1 - sr.x) * sr.y; u32x2v w; w.x = cvt_pk_bf16(o[0], o[1]); w.y = cvt_pk_bf16(o[2], o[3]);
                        if (bad) { w.x = 0x7fc07fc0u; w.y = 0x7fc07fc0u; } *(u32x2v*)(xn + off + bj * HALF + n * 16) = w; }
                asm volatile("" ::: "memory"); }
    }
};

template <class Epi, class Sched, bool ALIGN_EPI = false, bool SP2 = false>
__device__ __forceinline__ void gemm_phase(PG8_LAS unsigned char* lds, const Gemm g, const Sched& S, const Epi& E) {
    const int tid = threadIdx.x, wid = __builtin_amdgcn_readfirstlane(tid >> 6), lane = tid & 63, wr = wid >> 2, wc = wid & 3, fr = lane & 15, fq = lane >> 4;
    const int K = g.K, nt = K / BK;
    unsigned voffA[2], voffB[2];
#pragma unroll
    for (int i = 0; i < 2; ++i) { int R, C; stage_rc(tid * 16 + i * 8192, R, C); const int Rb = Epi::PERM ? ((R & ~31) + perm32(R & 31)) : R;
        voffA[i] = (unsigned)(R * K + C) * 2u; voffB[i] = (unsigned)(Rb * K + C) * 2u; }
    const size_t kstep = (size_t)(BK * 2);
    const size_t hstep = (size_t)HALF * K * 2;
    const size_t tstep = 2 * hstep;
    const unsigned ldsw = (unsigned)wid * 1024u;
    const int aoff = lds_byte(wr * 64 + fr, fq * 8), boff = lds_byte(wc * 32 + fr, fq * 8);
#define PG8_SA(b, h) (((b) * 2 + (h)) * HTB)
#define PG8_SB(b, h) ((4 + (b) * 2 + (h)) * HTB)
#define PG8_STAGE(bufoff, gbase, voff) do { _Pragma("unroll") for (int _i = 0; _i < 2; ++_i) \
        __builtin_amdgcn_global_load_lds((const unsigned*)((const char*)(gbase) + (voff)[_i]), (PG8_LAS unsigned*)(lds + (bufoff) + ldsw + _i * 8192), 16, 0, 0); } while (0)
#define PG8_LDA(dst, b, h) do { _Pragma("unroll") for (int m = 0; m < 4; ++m) _Pragma("unroll") for (int k = 0; k < 2; ++k) dst[m][k] = *(const PG8_LAS bf16x8*)(lds + PG8_SA(b, h) + aoff + m * 2048 + k * 1024); } while (0)
#define PG8_LDB(dst, b, h) do { _Pragma("unroll") for (int n = 0; n < 2; ++n) _Pragma("unroll") for (int k = 0; k < 2; ++k) dst[n][k] = *(const PG8_LAS bf16x8*)(lds + PG8_SB(b, h) + boff + n * 2048 + k * 1024); } while (0)
#define PG8_MMA(ai, bj, At, Bt) do { __builtin_amdgcn_s_setprio(1); _Pragma("unroll") for (int m = 0; m < 4; ++m) _Pragma("unroll") for (int n = 0; n < 2; ++n) _Pragma("unroll") for (int k = 0; k < 2; ++k) \
        acc[ai][bj][m][n] = __builtin_amdgcn_mfma_f32_16x16x32_bf16(Bt[n][k], At[m][k], acc[ai][bj][m][n], 0, 0, 0); __builtin_amdgcn_s_setprio(0); } while (0)
#define PG8_WAIT_V(n) asm volatile("s_waitcnt vmcnt(" #n ")" ::: "memory")
#define PG8_WAIT_L(n) asm volatile("s_waitcnt lgkmcnt(" #n ")" ::: "memory")
#define PG8_BAR __builtin_amdgcn_s_barrier()
#define PG8_SCHED __builtin_amdgcn_sched_barrier(0)
    Unit cur, nxt; int ui = 0;
    if (!S.next(0, cur)) return;
    f32x4 acc[2][2][4][2];
#pragma unroll
    for (int a = 0; a < 2; ++a)
#pragma unroll
        for (int b = 0; b < 2; ++b)
#pragma unroll
            for (int m = 0; m < 4; ++m)
#pragma unroll
                for (int n = 0; n < 2; ++n) acc[a][b][m][n] = (f32x4){0.f, 0.f, 0.f, 0.f};
    bf16x8 At[4][2], B0[2][2], B1[2][2];
    const char* cA = (const char*)g.A + (size_t)cur.pm * tstep; const char* cB = (const char*)g.Bt + (size_t)cur.pn * tstep;
    S.a_ready(cur);
    if constexpr (SP2) {
        PG8_STAGE(PG8_SB(0, 0), cB, voffB); PG8_STAGE(PG8_SB(0, 1), cB + hstep, voffB); PG8_STAGE(PG8_SA(0, 0), cA, voffA); PG8_STAGE(PG8_SA(0, 1), cA + hstep, voffA);
        if (wr == 1) PG8_BAR;
        PG8_WAIT_V(2); PG8_BAR;
        PG8_STAGE(PG8_SB(1, 0), cB + kstep, voffB); PG8_STAGE(PG8_SA(1, 0), cA + kstep, voffA); PG8_STAGE(PG8_SB(1, 1), cB + hstep + kstep, voffB);
        PG8_WAIT_V(6); PG8_BAR;
    } else {
        PG8_STAGE(PG8_SB(0, 0), cB, voffB); PG8_STAGE(PG8_SA(0, 0), cA, voffA); PG8_STAGE(PG8_SB(0, 1), cB + hstep, voffB); PG8_STAGE(PG8_SA(0, 1), cA + hstep, voffA);
        if (wr == 1) PG8_BAR;
        PG8_WAIT_V(4); PG8_BAR;
        PG8_STAGE(PG8_SB(1, 0), cB + kstep, voffB); PG8_STAGE(PG8_SA(1, 0), cA + kstep, voffA); PG8_STAGE(PG8_SB(1, 1), cB + hstep + kstep, voffB);
        PG8_WAIT_V(6); PG8_BAR;
    }
    for (;;) {
        const bool has_next = S.next(ui + 1, nxt);
        const char* nA = has_next ? (const char*)g.A + (size_t)nxt.pm * tstep : cA; const char* nB = has_next ? (const char*)g.Bt + (size_t)nxt.pn * tstep : cB;
        for (int t = 0; t < nt; t += 2) {
            const bool last = (t == nt - 2);
            const char* a1 = cA + (size_t)(t + 1) * kstep;
            const char* a2 = last ? nA : cA + (size_t)(t + 2) * kstep; const char* b2 = last ? nB : cB + (size_t)(t + 2) * kstep;
            const char* a3 = a2 + kstep; const char* b3 = b2 + kstep;
            if (last && has_next) S.a_ready(nxt);
            if constexpr (SP2) {
            PG8_LDB(B0, 0, 0); PG8_LDB(B1, 0, 1); PG8_SCHED; PG8_LDA(At, 0, 0); PG8_STAGE(PG8_SA(1, 1), a1 + hstep, voffA);
            PG8_WAIT_V(8); PG8_WAIT_L(0); PG8_BAR; PG8_MMA(0, 0, At, B0); PG8_MMA(0, 1, At, B1); PG8_BAR; PG8_SCHED;
            PG8_LDA(At, 0, 1); PG8_STAGE(PG8_SB(0, 0), b2, voffB); PG8_STAGE(PG8_SB(0, 1), b2 + hstep, voffB); PG8_STAGE(PG8_SA(0, 0), a2, voffA);
            PG8_WAIT_V(8); PG8_WAIT_L(0); PG8_BAR; PG8_MMA(1, 0, At, B0); PG8_MMA(1, 1, At, B1); PG8_BAR; PG8_SCHED;
            PG8_LDB(B0, 1, 0); PG8_LDB(B1, 1, 1); PG8_SCHED; PG8_LDA(At, 1, 0); PG8_STAGE(PG8_SA(0, 1), a2 + hstep, voffA);
            PG8_WAIT_V(8); PG8_WAIT_L(0); PG8_BAR; PG8_MMA(0, 0, At, B0); PG8_MMA(0, 1, At, B1); PG8_BAR; PG8_SCHED;
            PG8_LDA(At, 1, 1); PG8_STAGE(PG8_SB(1, 0), b3, voffB); PG8_STAGE(PG8_SB(1, 1), b3 + hstep, voffB); PG8_STAGE(PG8_SA(1, 0), a3, voffA);
            PG8_WAIT_V(8); PG8_WAIT_L(0); PG8_BAR; PG8_MMA(1, 0, At, B0); PG8_MMA(1, 1, At, B1); PG8_BAR; PG8_SCHED;
            } else {
            PG8_LDB(B0, 0, 0); PG8_SCHED; PG8_LDA(At, 0, 0); PG8_STAGE(PG8_SA(1, 1), a1 + hstep, voffA);
            PG8_WAIT_L(8); PG8_BAR; PG8_WAIT_L(0); PG8_MMA(0, 0, At, B0); PG8_BAR; PG8_SCHED;
            PG8_LDB(B1, 0, 1); PG8_STAGE(PG8_SB(0, 0), b2, voffB);
            PG8_BAR; PG8_WAIT_L(0); PG8_MMA(0, 1, At, B1); PG8_BAR;
            PG8_LDA(At, 0, 1); PG8_STAGE(PG8_SA(0, 0), a2, voffA);
            PG8_BAR; PG8_WAIT_L(0); PG8_MMA(1, 0, At, B0); PG8_BAR; PG8_SCHED;
            PG8_STAGE(PG8_SB(0, 1), b2 + hstep, voffB);
            PG8_WAIT_V(6); PG8_BAR; PG8_MMA(1, 1, At, B1); PG8_BAR;
            PG8_LDB(B0, 1, 0); PG8_SCHED; PG8_LDA(At, 1, 0); PG8_STAGE(PG8_SA(0, 1), a2 + hstep, voffA);
            PG8_WAIT_L(8); PG8_BAR; PG8_WAIT_L(0); PG8_MMA(0, 0, At, B0); PG8_BAR; PG8_SCHED;
            PG8_LDB(B1, 1, 1); PG8_STAGE(PG8_SB(1, 0), b3, voffB);
            PG8_BAR; PG8_WAIT_L(0); PG8_MMA(0, 1, At, B1); PG8_BAR;
            PG8_LDA(At, 1, 1); PG8_STAGE(PG8_SA(1, 0), a3, voffA);
            PG8_BAR; PG8_WAIT_L(0); PG8_MMA(1, 0, At, B0); PG8_BAR; PG8_SCHED;
            PG8_STAGE(PG8_SB(1, 1), b3 + hstep, voffB);
            PG8_WAIT_V(6); PG8_BAR; PG8_MMA(1, 1, At, B1); PG8_BAR;
            }
        }
        if constexpr (ALIGN_EPI) { if (wr == 0) PG8_BAR; }
        if constexpr (!Epi::AFTER_DRAIN) { E(acc, cur, wr, wc, fr, fq); S.done(cur); }
        if (!has_next) break;
#pragma unroll
        for (int a = 0; a < 2; ++a)
#pragma unroll
            for (int b = 0; b < 2; ++b)
#pragma unroll
                for (int m = 0; m < 4; ++m)
#pragma unroll
                    for (int n = 0; n < 2; ++n) acc[a][b][m][n] = (f32x4){0.f, 0.f, 0.f, 0.f};
        cur = nxt; cA = nA; cB = nB; ++ui;
        if constexpr (ALIGN_EPI) { if (wr == 1) PG8_BAR; }
    }
    PG8_WAIT_V(0);
    if constexpr (!ALIGN_EPI) { if (wr == 0) PG8_BAR; }
    PG8_BAR;
    if constexpr (Epi::AFTER_DRAIN) { E.fused(acc, cur, wr, wc, fr, fq, lds, wid, lane); S.done(cur); }
#undef PG8_SA
#undef PG8_SB
#undef PG8_STAGE
#undef PG8_LDA
#undef PG8_LDB
#undef PG8_MMA
#undef PG8_WAIT_V
#undef PG8_WAIT_L
#undef PG8_BAR
#undef PG8_SCHED
}
}

constexpr int D = 4096, PBATCH = 4, PSEQ = 2048, MPROMPT = PBATCH * PSEQ, SBATCH = 32, SSEQ = 4, MSAMPLE = SBATCH * SSEQ;
constexpr int MREAL = MPROMPT + MSAMPLE;
constexpr int MPAD = 8448;
constexpr int NE = 5120;
constexpr int NO = 16384;
constexpr int FF = 11008, DM = 512;
constexpr float ALPHA = 1.41421356237309515f;
constexpr float LN_EPS = 1e-5f, RMS_EPS = 1e-6f;
constexpr int NWAVES = 8;

constexpr size_t MiB = 1u << 20;
constexpr size_t WS_CTL = 0, CTL_ZERO_BYTES = 1 * MiB;
constexpr size_t WS_AB = 1 * MiB;
constexpr size_t WS_BB = WS_AB + 65536;
constexpr size_t WS_BT = WS_BB + 1048576;
constexpr size_t WS_LB = WS_BT + 16384;
constexpr size_t WS_SSQ = WS_LB + 16384;
constexpr size_t WS_WEIN = 4 * MiB, WS_WGLU = 44 * MiB, WS_WEOUT = 52 * MiB, WS_WOIN = 84 * MiB, WS_WOOUT = 212 * MiB;
constexpr size_t WS_LAYER = 244 * MiB, LAYER_STRIDE = 274 * MiB;
constexpr size_t L_WMQ = 0, L_WMKV = 4 * MiB, L_WMO = 12 * MiB, L_WGU = 16 * MiB, L_WD = 188 * MiB;
constexpr size_t WS_X = 792 * MiB;
constexpr size_t WS_XN = 924 * MiB;
constexpr size_t WS_MIX = 990 * MiB;
constexpr size_t WS_QC = 1056 * MiB;
constexpr size_t WS_CO = 1065 * MiB;
constexpr size_t WS_MPB = 1074 * MiB;
constexpr size_t WS_KVM = 1082 * MiB;
constexpr size_t WS_HBIG = 1086 * MiB;
constexpr size_t WS_Z = WS_HBIG + 83 * MiB;
constexpr size_t WS_END = WS_HBIG + 264 * MiB;
static_assert((size_t)MPAD * NE * 2 <= 83 * MiB && (size_t)MPAD * NO * 2 <= 264 * MiB && WS_LAYER + 2 * LAYER_STRIDE == WS_X, "ws map");
constexpr int CW_TMO = 0, CW_CODE = 1, CW_BAR = 4096;

constexpr size_t O_Y = 0, O_PMK = 34078720, O_PMV = 35127296, O_PSK = 36175872, O_PSV = 36438016, O_PS5R = 36700160, O_PS5I = 36732928,
                 O_PHG = 36765696, O_SSK = 38862848, O_SSV = 40960000, O_SS5R = 43057152, O_SS5I = 43319296, O_SHG = 43581440, O_END = 60358656;

constexpr int RING_OFF = 0, RING_BYTES = 131072;
constexpr int LDS_BYTES = 147456;
constexpr int MISC_OFF = LDS_BYTES - 256;

#define GAS __attribute__((address_space(1)))
#define LAS __attribute__((address_space(3)))
#define DI __device__ __forceinline__
typedef unsigned short bf16;
typedef unsigned v4u __attribute__((ext_vector_type(4)));
typedef unsigned v2u __attribute__((ext_vector_type(2)));
typedef float f32x4 __attribute__((ext_vector_type(4)));
typedef float f32x2 __attribute__((ext_vector_type(2)));
typedef float f32x16 __attribute__((ext_vector_type(16)));
typedef short bf16x8 __attribute__((ext_vector_type(8)));
typedef GAS unsigned gu32;
#define RLX_AGENT __ATOMIC_RELAXED, __HIP_MEMORY_SCOPE_AGENT
#define LDS_WAIT() asm volatile("s_waitcnt lgkmcnt(0)" ::: "memory")
#define VM_WAIT() asm volatile("s_waitcnt vmcnt(0)" ::: "memory")
typedef __bf16 bf16x2_t __attribute__((ext_vector_type(2)));
DI unsigned pk2(float lo, float hi) { f32x2 v = {lo, hi}; bf16x2_t b = __builtin_convertvector(v, bf16x2_t); return __builtin_bit_cast(unsigned, b); }
DI float bflo(unsigned w) { return __uint_as_float(w << 16); }
DI float bfhi(unsigned w) { return __uint_as_float(w & 0xffff0000u); }
DI float bf2f(bf16 v) { return __uint_as_float(((unsigned)v) << 16); }
DI float wave_sum(float v) {
#pragma unroll
    for (int o = 1; o < 64; o <<= 1) v += __shfl_xor(v, o);
    return v;
}
DI float wave_max(float v) {
#pragma unroll
    for (int o = 1; o < 64; o <<= 1) v = fmaxf(v, __shfl_xor(v, o));
    return v;
}
DI float sigmoidf_(float x) { return 1.0f / (1.0f + __expf(-x)); }
DI int crow(int reg, int h) { return (reg & 3) + 8 * (reg >> 2) + 4 * h; }
#define MFMA32(a, b, c) __builtin_amdgcn_mfma_f32_32x32x16_bf16((a), (b), (c), 0, 0, 0)

#define XB_TMO      128
#define XB_XCNT(j)  (256  + 64 * (j))
#define XB_XSUB(j)  (1280 + 64 * (j))
#define XB_XGEN(j)  (2304 + 64 * (j))
#define XB_TOP      3328
#define XB_TOPGEN   3392
#define XCD_BAR_WORDS 3456
#define XB_SPIN_CAP (1u << 18)

__device__ __forceinline__ unsigned xb_ld(unsigned* p)              { return __hip_atomic_load(p, __ATOMIC_RELAXED, __HIP_MEMORY_SCOPE_AGENT); }
__device__ __forceinline__ unsigned xb_add(unsigned* p, unsigned v) { return __hip_atomic_fetch_add(p, v, __ATOMIC_RELAXED, __HIP_MEMORY_SCOPE_AGENT); }
__device__ __forceinline__ unsigned xb_xcc_id() { return (unsigned)__builtin_amdgcn_s_getreg((3 << 11) | 20) & 0xFu; }
#define XB_SPIN(cond, bar) do { unsigned _sp = 0; while (cond) { __builtin_amdgcn_s_sleep(1); \
    if ((++_sp & 255u) == 0u) { if (xb_ld(&(bar)[XB_TMO])) break; if (_sp > XB_SPIN_CAP) { atomicAdd(&(bar)[XB_TMO], 1u); break; } } } } while (0)

struct XcdBarrier {
    unsigned* bar; unsigned x;
    volatile LAS unsigned* st;
};

__device__ __forceinline__ XcdBarrier xcd_barrier_post(unsigned* bar, volatile LAS unsigned* st) {
    XcdBarrier b; b.bar = bar; b.x = xb_xcc_id(); b.st = st;
    if (threadIdx.x == 0) (void)xb_add(&bar[XB_XCNT(b.x)], 1u);
    return b;
}
__device__ __forceinline__ void xcd_barrier_complete(unsigned* bar, unsigned x, unsigned& nloc, unsigned& nx) {
    const unsigned G = gridDim.x * gridDim.y * gridDim.z;
    unsigned sum, cnt, mine, sp = 0u;
    for (;;) {
        sum = 0u; cnt = 0u; mine = 0u;
#pragma unroll
        for (unsigned j = 0; j < 16; ++j) { const unsigned c = xb_ld(&bar[XB_XCNT(j)]); sum += c; cnt += (c > 0u) ? 1u : 0u; mine = (j == x) ? c : mine; }
        if (sum == G) break;
        __builtin_amdgcn_s_sleep(1);
        if ((++sp & 255u) == 0u) { if (xb_ld(&bar[XB_TMO])) break; if (sp > XB_SPIN_CAP) { atomicAdd(&bar[XB_TMO], 1u); break; } }
    }
    nloc = mine > 0u ? mine : 1u; nx = cnt > 0u ? cnt : 1u;
}

__device__ __forceinline__ void xcd_barrier(const XcdBarrier& b) {
    asm volatile("s_waitcnt vmcnt(0)" ::: "memory");
    __syncthreads();
    if (threadIdx.x == 0) {
        unsigned* bar = b.bar;
        __builtin_amdgcn_s_waitcnt(0);
        unsigned nloc = b.st[0], nx = b.st[1];
        if (nloc == 0u) { xcd_barrier_complete(bar, b.x, nloc, nx); b.st[0] = nloc; b.st[1] = nx; }
        const unsigned old = xb_add(&bar[XB_XSUB(b.x)], 1u);
        const unsigned gen = old / nloc;
        if (old + 1u == (gen + 1u) * nloc) {
            __builtin_amdgcn_fence(__ATOMIC_RELEASE, "agent");
            asm volatile("s_waitcnt vmcnt(0)" ::: "memory");
            const unsigned og = xb_add(&bar[XB_TOP], 1u);
            const unsigned tg = og / nx;
            if (og + 1u == (tg + 1u) * nx) xb_add(&bar[XB_TOPGEN], 1u);
            else XB_SPIN(xb_ld(&bar[XB_TOPGEN]) == tg, bar);
            __builtin_amdgcn_fence(__ATOMIC_ACQUIRE, "agent");
            xb_add(&bar[XB_XGEN(b.x)], 1u);
            asm volatile("s_waitcnt vmcnt(0)" ::: "memory");
        } else {
            XB_SPIN(xb_ld(&bar[XB_XGEN(b.x)]) == gen, bar);
            __builtin_amdgcn_fence(__ATOMIC_ACQUIRE, "agent");
            asm volatile("s_waitcnt vmcnt(0)" ::: "memory");
        }
    }
    __syncthreads();
}

struct EpiStoreBf16 {
    static constexpr bool PERM = true, AFTER_DRAIN = false;
    bf16* O; int ldc;
    DI void operator()(const f32x4 (&acc)[2][2][4][2], const pg8::Unit& u, int wr, int wc, int fr, int fq) const {
        const int row0 = u.pm * 256 + wr * 64 + fr, col0 = u.pn * 256 + wc * 32 + 8 * fq;
#pragma unroll
        for (int ai = 0; ai < 2; ++ai)
#pragma unroll
            for (int m = 0; m < 4; ++m) { bf16* rowp = O + (size_t)(row0 + ai * 128 + m * 16) * ldc + col0;
#pragma unroll
                for (int bj = 0; bj < 2; ++bj) { const f32x4 v0 = acc[ai][bj][m][0], v1 = acc[ai][bj][m][1];
                    v4u w; w.x = pk2(v0[0], v0[1]); w.y = pk2(v0[2], v0[3]); w.z = pk2(v1[0], v1[1]); w.w = pk2(v1[2], v1[3]);
                    *(v4u*)(rowp + bj * 128) = w; } }
    }
};
struct EpiMemKV {
    static constexpr bool PERM = false, AFTER_DRAIN = false;
    float* outk; float* outv; bf16* kvm;
    DI void operator()(const f32x4 (&acc)[2][2][4][2], const pg8::Unit& u, int wr, int wc, int fr, int fq) const {
        const int row0 = u.pm * 256 + wr * 64 + fr, col0 = u.pn * 256 + wc * 32 + 4 * fq;
        float* obase = (u.pn < 2) ? outk : outv; const int ocol0 = col0 - ((u.pn < 2) ? 0 : 512);
#pragma unroll
        for (int ai = 0; ai < 2; ++ai)
#pragma unroll
            for (int m = 0; m < 4; ++m) { const int row = row0 + ai * 128 + m * 16;
#pragma unroll
                for (int bj = 0; bj < 2; ++bj)
#pragma unroll
                    for (int n = 0; n < 2; ++n) { const f32x4 v = acc[ai][bj][m][n]; const int cc = bj * 128 + n * 16;
                        *(f32x4*)(obase + (size_t)row * 512 + ocol0 + cc) = v;
                        v2u w; w.x = pk2(v[0], v[1]); w.y = pk2(v[2], v[3]);
                        *(v2u*)(kvm + (size_t)row * 1024 + col0 + cc) = w; } }
    }
};
struct EpiGlu {
    static constexpr bool PERM = true, AFTER_DRAIN = false;
    const bf16* Z; bf16* O;
    DI void operator()(const f32x4 (&acc)[2][2][4][2], const pg8::Unit& u, int wr, int wc, int fr, int fq) const {
        const int row0 = u.pm * 256 + wr * 64 + fr, col0 = u.pn * 256 + wc * 32 + 8 * fq;
#pragma unroll
        for (int ai = 0; ai < 2; ++ai)
#pragma unroll
            for (int m = 0; m < 4; ++m) { const int row = row0 + ai * 128 + m * 16;
#pragma unroll
                for (int bj = 0; bj < 2; ++bj) { const f32x4 v0 = acc[ai][bj][m][0], v1 = acc[ai][bj][m][1];
                    const v4u z = *(const v4u*)(Z + (size_t)row * 2048 + col0 + bj * 128);
                    v4u w;
                    w.x = pk2(bflo(z.x) * sigmoidf_(v0[0]), bfhi(z.x) * sigmoidf_(v0[1]));
                    w.y = pk2(bflo(z.y) * sigmoidf_(v0[2]), bfhi(z.y) * sigmoidf_(v0[3]));
                    w.z = pk2(bflo(z.z) * sigmoidf_(v1[0]), bfhi(z.z) * sigmoidf_(v1[1]));
                    w.w = pk2(bflo(z.w) * sigmoidf_(v1[2]), bfhi(z.w) * sigmoidf_(v1[3]));
                    *(v4u*)(O + (size_t)row * 4096 + col0 + bj * 128) = w; } }
    }
};
struct EpiRes {
    static constexpr bool PERM = false, AFTER_DRAIN = false;
    float* X; const float* ssq;
    DI void operator()(const f32x4 (&acc)[2][2][4][2], const pg8::Unit& u, int wr, int wc, int fr, int fq) const {
        const int row0 = u.pm * 256 + wr * 64 + fr, col0 = u.pn * 256 + wc * 32 + 4 * fq;
        const float* __restrict__ xin = X; float* __restrict__ xout = X;
#pragma unroll
        for (int ai = 0; ai < 2; ++ai)
#pragma unroll
            for (int m = 0; m < 4; ++m) { const int row = row0 + ai * 128 + m * 16;
                float rs = 1.0f; if (ssq) rs = 1.0f / sqrtf(ssq[row] * (1.0f / 4096.0f) + RMS_EPS);
                const size_t off = (size_t)row * D + col0;
                f32x4 x[2][2];
#pragma unroll
                for (int bj = 0; bj < 2; ++bj)
#pragma unroll
                    for (int n = 0; n < 2; ++n) x[bj][n] = *(const f32x4*)(xin + off + bj * 128 + n * 16);
#pragma unroll
                for (int bj = 0; bj < 2; ++bj)
#pragma unroll
                    for (int n = 0; n < 2; ++n) *(f32x4*)(xout + off + bj * 128 + n * 16) = x[bj][n] * ALPHA + acc[ai][bj][m][n] * rs; }
    }
};
struct EpiGU {
    static constexpr bool PERM = true, AFTER_DRAIN = false;
    bf16* O;
    DI void operator()(const f32x4 (&acc)[2][2][4][2], const pg8::Unit& u, int wr, int wc, int fr, int fq) const {
        const int row0 = u.pm * 256 + wr * 64 + fr, col0 = u.pn * 128 + wc * 32 + 8 * fq;
#pragma unroll
        for (int ai = 0; ai < 2; ++ai)
#pragma unroll
            for (int m = 0; m < 4; ++m) { const int row = row0 + ai * 128 + m * 16;
                const f32x4 g0 = acc[ai][0][m][0], g1 = acc[ai][0][m][1], u0 = acc[ai][1][m][0], u1 = acc[ai][1][m][1];
                v4u w;
                w.x = pk2(g0[0] * sigmoidf_(g0[0]) * u0[0], g0[1] * sigmoidf_(g0[1]) * u0[1]);
                w.y = pk2(g0[2] * sigmoidf_(g0[2]) * u0[2], g0[3] * sigmoidf_(g0[3]) * u0[3]);
                w.z = pk2(g1[0] * sigmoidf_(g1[0]) * u1[0], g1[1] * sigmoidf_(g1[1]) * u1[1]);
                w.w = pk2(g1[2] * sigmoidf_(g1[2]) * u1[2], g1[3] * sigmoidf_(g1[3]) * u1[3]);
                *(v4u*)(O + (size_t)row * FF + col0) = w; }
    }
};
struct EpiOddIn {
    static constexpr bool PERM = true, AFTER_DRAIN = false;
    bf16* O; const float* lb;
    DI float act(float v, int type, float l) const {
        if (type == 0) return v * sigmoidf_(v);
        if (type == 1) return __logf(l + (1.0f - l) * sigmoidf_(v));
        if (type == 2) return v;
        return sigmoidf_(v);
    }
    DI void operator()(const f32x4 (&acc)[2][2][4][2], const pg8::Unit& u, int wr, int wc, int fr, int fq) const {
        const int row0 = u.pm * 256 + wr * 64 + fr, col0 = u.pn * 256 + wc * 32 + 8 * fq;
        const int type = u.pn >> 4;
        float lbv[2][8];
#pragma unroll
        for (int bj = 0; bj < 2; ++bj)
#pragma unroll
            for (int e = 0; e < 8; ++e) lbv[bj][e] = (type == 1) ? lb[(col0 + bj * 128 + e) & 4095] : 0.f;
#pragma unroll
        for (int ai = 0; ai < 2; ++ai)
#pragma unroll
            for (int m = 0; m < 4; ++m) { const int row = row0 + ai * 128 + m * 16;
#pragma unroll
                for (int bj = 0; bj < 2; ++bj) { const f32x4 v0 = acc[ai][bj][m][0], v1 = acc[ai][bj][m][1];
                    v4u w;
                    w.x = pk2(act(v0[0], type, lbv[bj][0]), act(v0[1], type, lbv[bj][1]));
                    w.y = pk2(act(v0[2], type, lbv[bj][2]), act(v0[3], type, lbv[bj][3]));
                    w.z = pk2(act(v1[0], type, lbv[bj][4]), act(v1[1], type, lbv[bj][5]));
                    w.w = pk2(act(v1[2], type, lbv[bj][6]), act(v1[3], type, lbv[bj][7]));
                    *(v4u*)(O + (size_t)row * NO + col0 + bj * 128) = w; } }
    }
};

DI void transpose_item(const float* __restrict__ W, int K, int N, int k0, int n0, bf16* WT, int drow0, LAS float* scr, int lane) {
#pragma unroll 8
    for (int i = 0; i < 32; ++i) { const int kk = 2 * i + (lane >> 5); scr[kk * 33 + (lane & 31)] = W[(size_t)(k0 + kk) * N + n0 + (lane & 31)]; }
    LDS_WAIT(); asm volatile("" ::: "memory");
    const int c = lane & 7;
#pragma unroll
    for (int j = 0; j < 4; ++j) { const int n = (lane >> 3) + 8 * j; const LAS float* s = scr + (8 * c) * 33 + n;
        v4u o; o.x = pk2(s[0 * 33], s[1 * 33]); o.y = pk2(s[2 * 33], s[3 * 33]); o.z = pk2(s[4 * 33], s[5 * 33]); o.w = pk2(s[6 * 33], s[7 * 33]);
        *(GAS v4u*)(WT + (size_t)(drow0 + n) * K + k0 + 8 * c) = o; }
    LDS_WAIT(); asm volatile("" ::: "memory");
}
DI int map_row(int n0, int mode) { return mode == 0 ? n0 : (mode == 1 ? 256 * (n0 >> 7) + (n0 & 127) : (mode == 2 ? 256 * (n0 >> 7) + 128 + (n0 & 127) : n0 + 512)); }
#define P0_MAT(Wp, K_, N_, WTp, mode) { const int cnt_ = ((K_) / 64) * ((N_) / 32); if (r < cnt_) { const int nblk_ = (N_) / 32, kb_ = r / nblk_, nb_ = r % nblk_; \
        transpose_item((Wp), (K_), (N_), 64 * kb_, 32 * nb_, (WTp), map_row(32 * nb_, (mode)), scr, lane); continue; } r -= cnt_; }

DI void ln_row(const float* xin, const float* g, const float* b, float* xout, bf16* xnout, int lane) {
    const GAS f32x4* xr = (const GAS f32x4*)xin + lane;
    f32x4 v[16]; float s = 0.f;
#pragma unroll
    for (int j = 0; j < 16; ++j) { v[j] = xr[64 * j]; s += (v[j].x + v[j].y) + (v[j].z + v[j].w); }
    const float mean = wave_sum(s) * (1.f / D); float s2 = 0.f;
#pragma unroll
    for (int j = 0; j < 16; ++j) { v[j] = v[j] - mean; s2 += (v[j].x * v[j].x + v[j].y * v[j].y) + (v[j].z * v[j].z + v[j].w * v[j].w); }
    const float rstd = 1.f / sqrtf(wave_sum(s2) * (1.f / D) + LN_EPS);
    GAS f32x4* o4 = (GAS f32x4*)xout + lane;
    GAS v2u* o8 = (GAS v2u*)xnout + lane;
#pragma unroll
    for (int j = 0; j < 16; ++j) {
        const f32x4 gg = ((const GAS f32x4*)g)[lane + 64 * j], bb = ((const GAS f32x4*)b)[lane + 64 * j];
        const f32x4 y = v[j] * rstd * gg + bb;
        o4[64 * j] = y;
        if (xnout) { v2u w; w.x = pk2(y.x, y.y); w.y = pk2(y.z, y.w); o8[64 * j] = w; }
    }
}
DI void ln_phase(const float* X, const float* g, const float* b, float* xout, bf16* xn, int gw, int NGW, int lane) {
    for (int m = gw; m < MREAL; m += NGW) ln_row(X + (size_t)m * D, g, b, xout + (size_t)m * D, xn ? xn + (size_t)m * D : nullptr, lane);
}
DI void copy_row(const float* src, float* xout, bf16* xnout, int lane) {
    GAS f32x4* o4 = xout ? (GAS f32x4*)xout + lane : nullptr; GAS v2u* o8 = (GAS v2u*)xnout + lane;
#pragma unroll
    for (int j = 0; j < 16; ++j) {
        f32x4 y = {0.f, 0.f, 0.f, 0.f}; if (src) y = ((const GAS f32x4*)src)[lane + 64 * j];
        if (xout) o4[64 * j] = y;
        v2u w; w.x = pk2(y.x, y.y); w.y = pk2(y.z, y.w); o8[64 * j] = w;
    }
}

DI float reduce16(float (&v)[16], int lane) {
    const bool b5 = (lane & 32) != 0, b4 = (lane & 16) != 0, b3 = (lane & 8) != 0, b2 = (lane & 4) != 0;
#pragma unroll
    for (int i = 0; i < 8; ++i) { const float send = b5 ? v[i] : v[i + 8], keep = b5 ? v[i + 8] : v[i]; v[i] = keep + __shfl_xor(send, 32); }
#pragma unroll
    for (int i = 0; i < 4; ++i) { const float send = b4 ? v[i] : v[i + 4], keep = b4 ? v[i + 4] : v[i]; v[i] = keep + __shfl_xor(send, 16); }
#pragma unroll
    for (int i = 0; i < 2; ++i) { const float send = b3 ? v[i] : v[i + 2], keep = b3 ? v[i + 2] : v[i]; v[i] = keep + __shfl_xor(send, 8); }
    { const float send = b2 ? v[0] : v[1], keep = b2 ? v[1] : v[0]; v[0] = keep + __shfl_xor(send, 4); }
    v[0] += __shfl_xor(v[0], 2); v[0] += __shfl_xor(v[0], 1);
    return v[0];
}
DI int idx16(int lane) { return ((lane >> 5) & 1) * 8 + ((lane >> 4) & 1) * 4 + ((lane >> 3) & 1) * 2 + ((lane >> 2) & 1); }
DI float gelu_tanh(float x) { const float u = 0.7978845608028654f * (x + 0.044715f * x * x * x); const float t = 1.0f - 2.0f / (1.0f + __expf(2.0f * u)); return 0.5f * x * (1.0f + t); }

struct S5Par { float ar, ai; float bbr[16], bbi[16], cr[16], ci[16]; float dsel; int hidx; };

template <bool WITH_Y>
DI void s5_block(const bf16* urows, int ntok, LAS float* ubuf, LAS float* ybuf, bf16* zrows, int lane, const S5Par& P, float& hr, float& hi) {
    if (lane < ntok) {
        const v4u a = *(const v4u*)(urows + (size_t)lane * NE), b = *(const v4u*)(urows + (size_t)lane * NE + 8);
        LAS f32x4* w = (LAS f32x4*)(ubuf + lane * 16);
        w[0] = (f32x4){bflo(a.x), bfhi(a.x), bflo(a.y), bfhi(a.y)}; w[1] = (f32x4){bflo(a.z), bfhi(a.z), bflo(a.w), bfhi(a.w)};
        w[2] = (f32x4){bflo(b.x), bfhi(b.x), bflo(b.y), bfhi(b.y)}; w[3] = (f32x4){bflo(b.z), bfhi(b.z), bflo(b.w), bfhi(b.w)};
    }
    LDS_WAIT(); asm volatile("" ::: "memory");
    for (int t = 0; t < ntok; ++t) {
        const LAS f32x4* up = (const LAS f32x4*)(ubuf + t * 16);
        const f32x4 u0 = up[0], u1 = up[1], u2 = up[2], u3 = up[3];
        const float u[16] = {u0.x, u0.y, u0.z, u0.w, u1.x, u1.y, u1.z, u1.w, u2.x, u2.y, u2.z, u2.w, u3.x, u3.y, u3.z, u3.w};
        float bur = 0.f, bui = 0.f;
#pragma unroll
        for (int h = 0; h < 16; ++h) { bur += P.bbr[h] * u[h]; bui += P.bbi[h] * u[h]; }
        const float nhr = P.ar * hr - P.ai * hi + bur, nhi = P.ar * hi + P.ai * hr + bui;
        hr = nhr; hi = nhi;
        if (WITH_Y) {
            float v[16];
#pragma unroll
            for (int h = 0; h < 16; ++h) v[h] = P.cr[h] * hr - P.ci[h] * hi;
            const float y = reduce16(v, lane) + P.dsel * ubuf[t * 16 + P.hidx];
            if ((lane & 3) == 0) ybuf[t * 16 + P.hidx] = gelu_tanh(y);
        }
    }
    if (WITH_Y) {
        LDS_WAIT(); asm volatile("" ::: "memory");
        if (lane < ntok) {
            const LAS f32x4* yp = (const LAS f32x4*)(ybuf + lane * 16);
            const f32x4 y0 = yp[0], y1 = yp[1], y2 = yp[2], y3 = yp[3];
            v4u a, b; a.x = pk2(y0.x, y0.y); a.y = pk2(y0.z, y0.w); a.z = pk2(y1.x, y1.y); a.w = pk2(y1.z, y1.w);
            b.x = pk2(y2.x, y2.y); b.y = pk2(y2.z, y2.w); b.z = pk2(y3.x, y3.y); b.w = pk2(y3.z, y3.w);
            *(v4u*)(zrows + (size_t)lane * 2048) = a; *(v4u*)(zrows + (size_t)lane * 2048 + 8) = b;
        }
    }
    LDS_WAIT(); asm volatile("" ::: "memory");
}
DI void s5_load_par(S5Par& P, const float* AB, const float* BB, const float* c_re, const float* c_im, const float* dsk, int g, int lane) {
    const f32x2 ab = *(const f32x2*)(AB + (size_t)(g * 64 + lane) * 2); P.ar = ab.x; P.ai = ab.y;
    const f32x4* bb = (const f32x4*)(BB + (size_t)(g * 64 + lane) * 32);
#pragma unroll
    for (int q = 0; q < 4; ++q) { const f32x4 r = bb[q], i = bb[4 + q]; P.bbr[4 * q] = r.x; P.bbr[4 * q + 1] = r.y; P.bbr[4 * q + 2] = r.z; P.bbr[4 * q + 3] = r.w;
        P.bbi[4 * q] = i.x; P.bbi[4 * q + 1] = i.y; P.bbi[4 * q + 2] = i.z; P.bbi[4 * q + 3] = i.w; }
#pragma unroll
    for (int h = 0; h < 16; ++h) { P.cr[h] = c_re[(size_t)g * 1024 + h * 64 + lane]; P.ci[h] = c_im[(size_t)g * 1024 + h * 64 + lane]; }
    P.hidx = idx16(lane); P.dsel = dsk[g * 16 + P.hidx];
}
DI void s5_prompt_unit(LAS unsigned char* lds, const bf16* H0, bf16* Z, const float* AB, const float* BB, const float* c_re, const float* c_im, const float* dsk,
                       float* ps5r, float* ps5i, int b, int g, int wid, int lane) {
    S5Par P; s5_load_par(P, AB, BB, c_re, c_im, dsk, g, lane);
    LAS float* ubuf = (LAS float*)(lds + wid * 8192); LAS float* ybuf = ubuf + 1024;
    LAS f32x2* HE = (LAS f32x2*)(lds + 65536);
    const int rowbase = b * PSEQ + 256 * wid;
    float hr = 0.f, hi = 0.f;
    for (int blk = 0; blk < 4; ++blk) s5_block<false>(H0 + (size_t)(rowbase + 64 * blk) * NE + 16 * g, 64, ubuf, ybuf, nullptr, lane, P, hr, hi);
    HE[wid * 64 + lane] = (f32x2){hr, hi};
    LDS_WAIT(); __syncthreads();
    float pr = P.ar, pi = P.ai;
#pragma unroll
    for (int s = 0; s < 8; ++s) { const float nr = pr * pr - pi * pi, ni = 2.f * pr * pi; pr = nr; pi = ni; }
    hr = 0.f; hi = 0.f;
    for (int v = 0; v < wid; ++v) { const f32x2 e = HE[v * 64 + lane]; const float nr = pr * hr - pi * hi + e.x, ni = pr * hi + pi * hr + e.y; hr = nr; hi = ni; }
    for (int blk = 0; blk < 4; ++blk)
        s5_block<true>(H0 + (size_t)(rowbase + 64 * blk) * NE + 16 * g, 64, ubuf, ybuf, Z + (size_t)(rowbase + 64 * blk) * 2048 + 16 * g, lane, P, hr, hi);
    if (wid == 7) { ps5r[(size_t)(b * 128 + g) * 64 + lane] = hr; ps5i[(size_t)(b * 128 + g) * 64 + lane] = hi; }
    __syncthreads();
}
DI void s5_sample_wave(LAS unsigned char* lds, const bf16* H0, bf16* Z, const float* AB, const float* BB, const float* c_re, const float* c_im, const float* dsk,
                       const float* st_re, const float* st_im, float* ss5r, float* ss5i, int g, int wid, int lane) {
    S5Par P; s5_load_par(P, AB, BB, c_re, c_im, dsk, g, lane);
    LAS float* ubuf = (LAS float*)(lds + wid * 8192); LAS float* ybuf = ubuf + 1024;
    for (int b = 0; b < SBATCH; ++b) {
        float hr = st_re[(size_t)(b * 128 + g) * 64 + lane], hi = st_im[(size_t)(b * 128 + g) * 64 + lane];
        const int row = MPROMPT + 4 * b;
        s5_block<true>(H0 + (size_t)row * NE + 16 * g, 4, ubuf, ybuf, Z + (size_t)row * 2048 + 16 * g, lane, P, hr, hi);
        ss5r[(size_t)(b * 128 + g) * 64 + lane] = hr; ss5i[(size_t)(b * 128 + g) * 64 + lane] = hi;
    }
}

constexpr int SWA_KS = 144, SWA_VS = 392, SWA_VT_OFF = 192 * SWA_KS, SWA_BT_OFF = SWA_VT_OFF + 64 * SWA_VS;
DI bf16x8 pack8(const f32x16& x, int s) {
    v4u p; p.x = pk2(x[8 * s], x[8 * s + 1]); p.y = pk2(x[8 * s + 2], x[8 * s + 3]); p.z = pk2(x[8 * s + 4], x[8 * s + 5]); p.w = pk2(x[8 * s + 6], x[8 * s + 7]);
    return __builtin_bit_cast(bf16x8, p);
}
DI void swa_prompt_unit(LAS unsigned char* lds, const bf16* H0, bf16* MIX, const float* BT, const float* sinks, float* pk_out, float* pv_out,
                        int b, int kvh, int qb, int tid, int wid, int lane) {
    const int q0 = qb * 64;
#pragma unroll
    for (int i = 0; i < 3; ++i) {
        const int c = tid + 512 * i, row = c >> 3, part = c & 7, t = q0 - 128 + row;
        v4u val = {0u, 0u, 0u, 0u};
        if (t >= 0) val = *(const v4u*)(H0 + (size_t)(b * PSEQ + t) * NE + 4096 + kvh * 64 + part * 8);
        *(LAS v4u*)(lds + row * SWA_KS + part * 16) = val;
    }
#pragma unroll
    for (int i = 0; i < 3; ++i) {
        const int c = tid + 512 * i, key = c % 192, dc = c / 192, t = q0 - 128 + key;
        v4u val = {0u, 0u, 0u, 0u};
        if (t >= 0) val = *(const v4u*)(H0 + (size_t)(b * PSEQ + t) * NE + 4608 + kvh * 64 + dc * 8);
        LAS unsigned char* vt = lds + SWA_VT_OFF + (8 * dc) * SWA_VS + key * 2;
        *(LAS bf16*)(vt + 0 * SWA_VS) = (bf16)(val.x & 0xffffu); *(LAS bf16*)(vt + 1 * SWA_VS) = (bf16)(val.x >> 16);
        *(LAS bf16*)(vt + 2 * SWA_VS) = (bf16)(val.y & 0xffffu); *(LAS bf16*)(vt + 3 * SWA_VS) = (bf16)(val.y >> 16);
        *(LAS bf16*)(vt + 4 * SWA_VS) = (bf16)(val.z & 0xffffu); *(LAS bf16*)(vt + 5 * SWA_VS) = (bf16)(val.z >> 16);
        *(LAS bf16*)(vt + 6 * SWA_VS) = (bf16)(val.w & 0xffffu); *(LAS bf16*)(vt + 7 * SWA_VS) = (bf16)(val.w >> 16);
    }
    for (int e = tid; e < 768; e += 512) { const int gg = e / 192, x = e % 192; const int dist = 159 - x;
        ((LAS float*)(lds + SWA_BT_OFF))[e] = (dist >= 0 && dist < 128) ? BT[(size_t)(4 * kvh + gg) * 128 + dist] : -1.0e30f; }
    LDS_WAIT(); __syncthreads();
    if (qb == 31) {
        for (int e = tid; e < 128 * 64; e += 512) { const int j = e >> 6, d = e & 63;
            pk_out[((size_t)(b * 128 + j) * 8 + kvh) * 64 + d] = bf2f(*(const LAS bf16*)(lds + (64 + j) * SWA_KS + d * 2));
            pv_out[((size_t)(b * 128 + j) * 8 + kvh) * 64 + d] = bf2f(*(const LAS bf16*)(lds + SWA_VT_OFF + d * SWA_VS + (64 + j) * 2)); }
    }
    const int g = wid & 3, s = wid >> 2, hq = 4 * kvh + g, r = lane & 31, h = lane >> 5;
    const int tq = q0 + 32 * s + r; const size_t rowq = (size_t)(b * PSEQ + tq);
    bf16x8 qf[4];
#pragma unroll
    for (int ks = 0; ks < 4; ++ks) qf[ks] = *(const bf16x8*)(H0 + rowq * NE + 2048 + hq * 64 + 16 * ks + 8 * h);
    f32x16 S[5];
#pragma unroll
    for (int j = 0; j < 5; ++j) {
#pragma unroll
        for (int i = 0; i < 16; ++i) S[j][i] = 0.f;
#pragma unroll
        for (int ks = 0; ks < 4; ++ks) { const bf16x8 a = *(const LAS bf16x8*)(lds + (32 * (s + j) + r) * SWA_KS + (16 * ks + 8 * h) * 2); S[j] = MFMA32(a, qf[ks], S[j]); }
        __builtin_amdgcn_sched_barrier(0);
    }
    const LAS float* bt = (const LAS float*)(lds + SWA_BT_OFF) + g * 192 + (31 - r + 4 * h);
    const int thr = 128 - q0 - 32 * s - 4 * h;
    const float sink = sinks[hq];
    float mx = -3.0e38f;
#pragma unroll
    for (int j = 0; j < 5; ++j) {
#pragma unroll
        for (int i = 0; i < 16; ++i) { const int cji = 32 * j + (i & 3) + 8 * (i >> 2);
            const float sc = S[j][i] * 0.125f + bt[cji]; S[j][i] = (cji >= thr) ? sc : -1.0e30f; mx = fmaxf(mx, S[j][i]); }
        __builtin_amdgcn_sched_barrier(0); }
    mx = fmaxf(mx, __shfl_xor(mx, 32)); mx = fmaxf(mx, sink);
    float sum = 0.f;
#pragma unroll
    for (int j = 0; j < 5; ++j)
#pragma unroll
        for (int i = 0; i < 16; ++i) { const float p = __expf(S[j][i] - mx); S[j][i] = p; sum += p; }
    sum += __shfl_xor(sum, 32);
    const float inv = 1.0f / (sum + __expf(sink - mx));
    f32x16 O[2];
#pragma unroll
    for (int dt = 0; dt < 2; ++dt)
#pragma unroll
        for (int i = 0; i < 16; ++i) O[dt][i] = 0.f;
#pragma unroll
    for (int j = 0; j < 5; ++j)
#pragma unroll
        for (int k2 = 0; k2 < 2; ++k2) { const bf16x8 pf = pack8(S[j], k2);
#pragma unroll
            for (int dt = 0; dt < 2; ++dt) { const LAS unsigned char* vp = lds + SWA_VT_OFF + (32 * dt + r) * SWA_VS + (32 * (s + j) + 16 * k2 + 4 * h) * 2;
                const v2u lo = *(const LAS v2u*)vp, hi2 = *(const LAS v2u*)(vp + 16);
                v4u av; av.x = lo.x; av.y = lo.y; av.z = hi2.x; av.w = hi2.y;
                O[dt] = MFMA32(__builtin_bit_cast(bf16x8, av), pf, O[dt]); }
            __builtin_amdgcn_sched_barrier(0); }
    bf16* orow = MIX + rowq * D + 2048 + hq * 64;
#pragma unroll
    for (int dt = 0; dt < 2; ++dt)
#pragma unroll
        for (int q4 = 0; q4 < 4; ++q4) { v2u w; w.x = pk2(O[dt][4 * q4] * inv, O[dt][4 * q4 + 1] * inv); w.y = pk2(O[dt][4 * q4 + 2] * inv, O[dt][4 * q4 + 3] * inv);
            *(v2u*)(orow + 32 * dt + 8 * q4 + 4 * h) = w; }
    __syncthreads();
}

constexpr int SS_K = 0, SS_V = 132 * 65 * 4, SS_BT = SS_V + 132 * 64 * 4, SS_Q = SS_BT + 2048, SS_P = SS_Q + 4 * 1024;
DI void swa_sample_unit(LAS unsigned char* lds, const bf16* H0, bf16* MIX, const float* BT, const float* sinks, const float* ck, const float* cv, float* sk_out, float* sv_out,
                        int b, int kvh, int tid, int wid, int lane) {
    LAS float* Kf = (LAS float*)(lds + SS_K); LAS float* Vf = (LAS float*)(lds + SS_V); LAS float* bt = (LAS float*)(lds + SS_BT);
    for (int e = tid; e < 132 * 64; e += 512) { const int L = e >> 6, d = e & 63; float kv, vv;
        if (L < 128) { kv = ck[((size_t)(b * 128 + L) * 8 + kvh) * 64 + d]; vv = cv[((size_t)(b * 128 + L) * 8 + kvh) * 64 + d]; }
        else { const size_t row = (size_t)(MPROMPT + 4 * b + (L - 128)); kv = bf2f(H0[row * NE + 4096 + kvh * 64 + d]); vv = bf2f(H0[row * NE + 4608 + kvh * 64 + d]); }
        Kf[L * 65 + d] = kv; Vf[L * 64 + d] = vv;
        if (L >= 4) { sk_out[((size_t)(b * 128 + (L - 4)) * 8 + kvh) * 64 + d] = kv; sv_out[((size_t)(b * 128 + (L - 4)) * 8 + kvh) * 64 + d] = vv; }
    }
    bt[tid] = BT[(size_t)(4 * kvh + (tid >> 7)) * 128 + (tid & 127)];
    LDS_WAIT(); __syncthreads();
    if (wid < 4) {
        const int t = wid; const size_t row = (size_t)(MPROMPT + 4 * b + t);
        LAS float* qs = (LAS float*)(lds + SS_Q + wid * 1024); LAS float* ps = (LAS float*)(lds + SS_P + wid * 2048);
#pragma unroll
        for (int g = 0; g < 4; ++g) qs[g * 64 + lane] = bf2f(H0[row * NE + 2048 + (4 * kvh + g) * 64 + lane]) * 0.125f;
        LDS_WAIT(); asm volatile("" ::: "memory");
        const int L1 = t + 1 + lane, L2 = t + 65 + lane;
        float s1[4] = {0.f, 0.f, 0.f, 0.f}, s2[4] = {0.f, 0.f, 0.f, 0.f};
        for (int d = 0; d < 64; ++d) { const float k1 = Kf[L1 * 65 + d], k2 = Kf[L2 * 65 + d];
#pragma unroll
            for (int g = 0; g < 4; ++g) { const float q = qs[g * 64 + d]; s1[g] += q * k1; s2[g] += q * k2; } }
        float inv[4];
#pragma unroll
        for (int g = 0; g < 4; ++g) {
            const float a1 = s1[g] + bt[g * 128 + 127 - lane], a2 = s2[g] + bt[g * 128 + 63 - lane];
            const float sink = sinks[4 * kvh + g];
            const float mx = fmaxf(wave_max(fmaxf(a1, a2)), sink);
            const float p1 = __expf(a1 - mx), p2 = __expf(a2 - mx);
            inv[g] = 1.0f / (wave_sum(p1 + p2) + __expf(sink - mx));
            ps[g * 128 + lane] = p1; ps[g * 128 + 64 + lane] = p2;
        }
        LDS_WAIT(); asm volatile("" ::: "memory");
        float o[4] = {0.f, 0.f, 0.f, 0.f};
        for (int kk = 0; kk < 128; ++kk) { const float v = Vf[(t + 1 + kk) * 64 + lane];
#pragma unroll
            for (int g = 0; g < 4; ++g) o[g] += ps[g * 128 + kk] * v; }
#pragma unroll
        for (int g = 0; g < 4; ++g) MIX[row * D + 2048 + (4 * kvh + g) * 64 + lane] = (bf16)(pk2(o[g] * inv[g], 0.f) & 0xffffu);
    }
    __syncthreads();
}

constexpr int CA_KS = 272, CA_VS = 520, CA_VT_OFF = 256 * CA_KS;
DI void cross_prompt_unit(LAS unsigned char* lds, const bf16* QC, const bf16* KVM  , bf16* CO, int b, int hd, int qblk, int tid, int wid, int lane) {
#pragma unroll
    for (int i = 0; i < 8; ++i) {
        const int c = tid + 512 * i, row = c >> 4, part = c & 15;
        const v4u val = *(const v4u*)(KVM + (size_t)(b * 256 + row) * 1024 + hd * 128 + part * 8);
        *(LAS v4u*)(lds + row * CA_KS + part * 16) = val;
    }
#pragma unroll
    for (int i = 0; i < 8; ++i) {
        const int c = tid + 512 * i, key = c & 255, dc = c >> 8;
        const v4u val = *(const v4u*)(KVM + (size_t)(b * 256 + key) * 1024 + 512 + hd * 128 + dc * 8);
        LAS unsigned char* vt = lds + CA_VT_OFF + (8 * dc) * CA_VS + key * 2;
        *(LAS bf16*)(vt + 0 * CA_VS) = (bf16)(val.x & 0xffffu); *(LAS bf16*)(vt + 1 * CA_VS) = (bf16)(val.x >> 16);
        *(LAS bf16*)(vt + 2 * CA_VS) = (bf16)(val.y & 0xffffu); *(LAS bf16*)(vt + 3 * CA_VS) = (bf16)(val.y >> 16);
        *(LAS bf16*)(vt + 4 * CA_VS) = (bf16)(val.z & 0xffffu); *(LAS bf16*)(vt + 5 * CA_VS) = (bf16)(val.z >> 16);
        *(LAS bf16*)(vt + 6 * CA_VS) = (bf16)(val.w & 0xffffu); *(LAS bf16*)(vt + 7 * CA_VS) = (bf16)(val.w >> 16);
    }
    LDS_WAIT(); __syncthreads();
    const int r = lane & 31, h = lane >> 5;
    const size_t rowq = (size_t)(b * PSEQ + qblk * 256 + 32 * wid + r);
    bf16x8 qf[8];
#pragma unroll
    for (int ks = 0; ks < 8; ++ks) qf[ks] = *(const bf16x8*)(QC + rowq * DM + hd * 128 + 16 * ks + 8 * h);
    f32x16 O[4];
#pragma unroll
    for (int dt = 0; dt < 4; ++dt)
#pragma unroll
        for (int i = 0; i < 16; ++i) O[dt][i] = 0.f;
    float mrun = -1.0e30f, lrun = 0.f;
    const float scale = 0.08838834764831845f;
#pragma unroll 1
    for (int c4 = 0; c4 < 4; ++c4) {
        f32x16 S[2];
#pragma unroll
        for (int tt = 0; tt < 2; ++tt) {
#pragma unroll
            for (int i = 0; i < 16; ++i) S[tt][i] = 0.f;
#pragma unroll
            for (int ks = 0; ks < 8; ++ks) { const bf16x8 a = *(const LAS bf16x8*)(lds + (64 * c4 + 32 * tt + r) * CA_KS + (16 * ks + 8 * h) * 2); S[tt] = MFMA32(a, qf[ks], S[tt]); }
        }
        float cm = -3.0e38f;
#pragma unroll
        for (int tt = 0; tt < 2; ++tt)
#pragma unroll
            for (int i = 0; i < 16; ++i) { S[tt][i] *= scale; cm = fmaxf(cm, S[tt][i]); }
        cm = fmaxf(cm, __shfl_xor(cm, 32));
        const float mnew = fmaxf(mrun, cm), alpha = __expf(mrun - mnew);
        float ps = 0.f;
#pragma unroll
        for (int tt = 0; tt < 2; ++tt)
#pragma unroll
            for (int i = 0; i < 16; ++i) { const float p = __expf(S[tt][i] - mnew); S[tt][i] = p; ps += p; }
        lrun = lrun * alpha + ps; mrun = mnew;
#pragma unroll
        for (int dt = 0; dt < 4; ++dt)
#pragma unroll
            for (int i = 0; i < 16; ++i) O[dt][i] *= alpha;
#pragma unroll
        for (int tt = 0; tt < 2; ++tt)
#pragma unroll
            for (int k2 = 0; k2 < 2; ++k2) { const bf16x8 pf = pack8(S[tt], k2);
#pragma unroll
                for (int dt = 0; dt < 4; ++dt) { const LAS unsigned char* vp = lds + CA_VT_OFF + (32 * dt + r) * CA_VS + (64 * c4 + 32 * tt + 16 * k2 + 4 * h) * 2;
                    const v2u lo = *(const LAS v2u*)vp, hi2 = *(const LAS v2u*)(vp + 16);
                    v4u av; av.x = lo.x; av.y = lo.y; av.z = hi2.x; av.w = hi2.y;
                    O[dt] = MFMA32(__builtin_bit_cast(bf16x8, av), pf, O[dt]); } }
    }
    lrun += __shfl_xor(lrun, 32);
    const float inv = 1.0f / lrun;
    bf16* orow = CO + rowq * DM + hd * 128;
#pragma unroll
    for (int dt = 0; dt < 4; ++dt)
#pragma unroll
        for (int q4 = 0; q4 < 4; ++q4) { v2u w; w.x = pk2(O[dt][4 * q4] * inv, O[dt][4 * q4 + 1] * inv); w.y = pk2(O[dt][4 * q4 + 2] * inv, O[dt][4 * q4 + 3] * inv);
            *(v2u*)(orow + 32 * dt + 8 * q4 + 4 * h) = w; }
    __syncthreads();
}
DI void cross_sample_wave(LAS unsigned char* lds, const bf16* QC, const float* ck, const float* cv, bf16* CO, int b, int hd, int wid, int lane) {
    LAS float* sc = (LAS float*)(lds + wid * 4096);
    const int l32 = lane & 31, half = lane >> 5;
    f32x4 qv[4];
#pragma unroll
    for (int t = 0; t < 4; ++t) { const v2u w = *(const v2u*)(QC + (size_t)(MPROMPT + 4 * b + t) * DM + hd * 128 + 4 * l32); qv[t] = (f32x4){bflo(w.x), bfhi(w.x), bflo(w.y), bfhi(w.y)}; }
    const float* kb = ck + ((size_t)b * 256 * 4 + hd) * 128;
    const float scale = 0.08838834764831845f;
    for (int it = 0; it < 128; ++it) {
        const int s = 2 * it + half;
        const f32x4 kv = *(const f32x4*)(kb + (size_t)s * 512 + 4 * l32);
        float d[4];
#pragma unroll
        for (int t = 0; t < 4; ++t) d[t] = kv.x * qv[t].x + kv.y * qv[t].y + kv.z * qv[t].z + kv.w * qv[t].w;
#pragma unroll
        for (int o = 1; o < 32; o <<= 1)
#pragma unroll
            for (int t = 0; t < 4; ++t) d[t] += __shfl_xor(d[t], o);
        if (l32 == 0) *(LAS f32x4*)(sc + s * 4) = (f32x4){d[0] * scale, d[1] * scale, d[2] * scale, d[3] * scale};
    }
    LDS_WAIT(); asm volatile("" ::: "memory");
    f32x4 e[4]; f32x4 mx = {-3e38f, -3e38f, -3e38f, -3e38f};
#pragma unroll
    for (int k = 0; k < 4; ++k) { e[k] = *(const LAS f32x4*)(sc + (lane + 64 * k) * 4); mx.x = fmaxf(mx.x, e[k].x); mx.y = fmaxf(mx.y, e[k].y); mx.z = fmaxf(mx.z, e[k].z); mx.w = fmaxf(mx.w, e[k].w); }
    mx.x = wave_max(mx.x); mx.y = wave_max(mx.y); mx.z = wave_max(mx.z); mx.w = wave_max(mx.w);
    f32x4 sm = {0.f, 0.f, 0.f, 0.f};
#pragma unroll
    for (int k = 0; k < 4; ++k) { e[k].x = __expf(e[k].x - mx.x); e[k].y = __expf(e[k].y - mx.y); e[k].z = __expf(e[k].z - mx.z); e[k].w = __expf(e[k].w - mx.w); sm += e[k]; }
    sm.x = 1.0f / wave_sum(sm.x); sm.y = 1.0f / wave_sum(sm.y); sm.z = 1.0f / wave_sum(sm.z); sm.w = 1.0f / wave_sum(sm.w);
#pragma unroll
    for (int k = 0; k < 4; ++k) *(LAS f32x4*)(sc + (lane + 64 * k) * 4) = e[k] * sm;
    LDS_WAIT(); asm volatile("" ::: "memory");
    const float* vb = cv + ((size_t)b * 256 * 4 + hd) * 128;
    f32x2 o[4] = {{0.f, 0.f}, {0.f, 0.f}, {0.f, 0.f}, {0.f, 0.f}};
    for (int s = 0; s < 256; ++s) {
        const f32x2 vv = *(const f32x2*)(vb + (size_t)s * 512 + 2 * lane);
        const f32x4 p = *(const LAS f32x4*)(sc + s * 4);
        o[0] += vv * p.x; o[1] += vv * p.y; o[2] += vv * p.z; o[3] += vv * p.w;
    }
#pragma unroll
    for (int t = 0; t < 4; ++t) *(unsigned*)(CO + (size_t)(MPROMPT + 4 * b + t) * DM + hd * 128 + 2 * lane) = pk2(o[t].x, o[t].y);
    LDS_WAIT(); asm volatile("" ::: "memory");
}

DI float reduce8(float (&v)[8], int lane) {
    const bool b5 = (lane & 32) != 0, b4 = (lane & 16) != 0, b3 = (lane & 8) != 0;
#pragma unroll
    for (int i = 0; i < 4; ++i) { const float send = b5 ? v[i] : v[i + 4], keep = b5 ? v[i + 4] : v[i]; v[i] = keep + __shfl_xor(send, 32); }
#pragma unroll
    for (int i = 0; i < 2; ++i) { const float send = b4 ? v[i] : v[i + 2], keep = b4 ? v[i + 2] : v[i]; v[i] = keep + __shfl_xor(send, 16); }
    { const float send = b3 ? v[0] : v[1], keep = b3 ? v[1] : v[0]; v[0] = keep + __shfl_xor(send, 8); }
    v[0] += __shfl_xor(v[0], 4); v[0] += __shfl_xor(v[0], 2); v[0] += __shfl_xor(v[0], 1);
    return v[0];
}
DI void hgrn_unit(LAS unsigned char* lds, const bf16* H1, bf16* OG, float* SSQ, const float* norm_g, const float* s0, float* sout,
                  int rowbase, int T, int hh, int dvh, int tid, int wid, int lane) {
    LAS float* SL = (LAS float*)lds;
    float S0r[8], S1r[8];
    if (s0) {
        const int row = tid >> 2, seg = tid & 3;
#pragma unroll
        for (int e = 0; e < 4; ++e) *(LAS f32x4*)(SL + row * 68 + 16 * seg + 4 * e) = *(const f32x4*)(s0 + (size_t)row * 128 + 64 * dvh + 16 * seg + 4 * e);
        LDS_WAIT(); __syncthreads();
#pragma unroll
        for (int i = 0; i < 8; ++i) { S0r[i] = SL[lane * 68 + 8 * wid + i]; S1r[i] = SL[(lane + 64) * 68 + 8 * wid + i]; }
        LDS_WAIT(); __syncthreads();
    } else {
#pragma unroll
        for (int i = 0; i < 8; ++i) { S0r[i] = 0.f; S1r[i] = 0.f; }
    }
    const int idx = ((lane >> 5) & 1) * 4 + ((lane >> 4) & 1) * 2 + ((lane >> 3) & 1);
    const int dvw = 64 * dvh + 8 * wid + idx;
    const float ng = norm_g[hh * 128 + dvw];
    const bf16* base = H1 + (size_t)rowbase * NO + hh * 128;
    for (int t0 = 0; t0 < T; t0 += 4) {
        bf16 q0[4], q1[4], l0[4], l1[4], sg[4]; v4u vv[4];
#pragma unroll
        for (int tt = 0; tt < 4; ++tt) { const bf16* rp = base + (size_t)(t0 + tt) * NO;
            q0[tt] = rp[lane]; q1[tt] = rp[lane + 64]; l0[tt] = rp[4096 + lane]; l1[tt] = rp[4096 + lane + 64];
            vv[tt] = *(const v4u*)(rp + 8192 + 64 * dvh + 8 * wid); sg[tt] = rp[12288 + dvw]; }
#pragma unroll
        for (int tt = 0; tt < 4; ++tt) {
            const float f0 = __expf(bf2f(l0[tt])), f1 = __expf(bf2f(l1[tt])), k0 = 1.0f - f0, k1 = 1.0f - f1, qa = bf2f(q0[tt]), qb = bf2f(q1[tt]);
            const float v[8] = {bflo(vv[tt].x), bfhi(vv[tt].x), bflo(vv[tt].y), bfhi(vv[tt].y), bflo(vv[tt].z), bfhi(vv[tt].z), bflo(vv[tt].w), bfhi(vv[tt].w)};
            float po[8];
#pragma unroll
            for (int i = 0; i < 8; ++i) { S0r[i] = f0 * S0r[i] + k0 * v[i]; S1r[i] = f1 * S1r[i] + k1 * v[i]; po[i] = qa * S0r[i] + qb * S1r[i]; }
            const float o = reduce8(po, lane);
            float sq = o * o; sq += __shfl_xor(sq, 8); sq += __shfl_xor(sq, 16); sq += __shfl_xor(sq, 32);
            const size_t row = (size_t)(rowbase + t0 + tt);
            if (lane == 0) atomicAdd(SSQ + row, sq);
            if ((lane & 7) == 0) OG[row * D + hh * 128 + dvw] = (bf16)(pk2(o * ng * bf2f(sg[tt]), 0.f) & 0xffffu);
        }
    }
#pragma unroll
    for (int i = 0; i < 8; ++i) { SL[lane * 68 + 8 * wid + i] = S0r[i]; SL[(lane + 64) * 68 + 8 * wid + i] = S1r[i]; }
    LDS_WAIT(); __syncthreads();
    { const int row = tid >> 2, seg = tid & 3;
#pragma unroll
      for (int e = 0; e < 4; ++e) *(f32x4*)(sout + (size_t)row * 128 + 64 * dvh + 16 * seg + 4 * e) = *(const LAS f32x4*)(SL + row * 68 + 16 * seg + 4 * e); }
    LDS_WAIT(); __syncthreads();
}

#ifndef MK_SPLIT
#define MK_SPLIT 0
#endif
constexpr int N_PHASES = 24;
struct Args { const float* in[36]; float* outp; unsigned char* wsp; int ph_lo, ph_hi; };
enum { I_XP = 0, I_XS, I_CMK, I_CMV, I_CSK, I_CSV, I_S5R, I_S5I, I_SHG, I_MEMP, I_RELB, I_WEIN, I_LAMR, I_LAMI, I_LOGDT, I_BRE, I_BIM, I_CRE, I_CIM, I_S5D, I_WGLU, I_SINK, I_WEOUT,
       I_LBL, I_WOIN, I_NORMG, I_WOOUT, I_WMQ, I_WMK, I_WMV, I_WMO, I_WFG, I_WFU, I_WFD, I_LNG, I_LNB };

DI const float* arg_in(int k) { const char __attribute__((address_space(4)))* p = (const char __attribute__((address_space(4)))*)__builtin_amdgcn_kernarg_segment_ptr(); asm volatile("" : "+s"(p));
    return *(const float* const __attribute__((address_space(4)))*)(p + 8 * k); }
#define ARG(k) arg_in(k)
#define GEMM_CALL(EpiT, Aptr, Bptr, M_, N_, K_, cidx, ...) do { pg8::Gemm g_{(const pg8::bf16_t*)(Aptr), (const pg8::bf16_t*)(Bptr), (M_), (N_), (K_)}; pg8::StaticOrder S_; S_.init((M_), (N_), G, (cidx)); \
        EpiT E_{__VA_ARGS__}; pg8::gemm_phase<EpiT, pg8::StaticOrder, true, true>(lds + RING_OFF, g_, S_, E_); } while (0)

__global__ void __launch_bounds__(NWAVES * 64, 2) hybrid_fwd(Args args) {
    extern __shared__ __attribute__((aligned(16))) unsigned char lds_raw[];
    LAS unsigned char* lds = (LAS unsigned char*)lds_raw;
    volatile LAS unsigned* MISC = (volatile LAS unsigned*)(lds + MISC_OFF);
    const int tid = threadIdx.x, lane = tid & 63, wid = __builtin_amdgcn_readfirstlane(tid >> 6);
    const int G = gridDim.x, cu = blockIdx.x;
    const int gw = cu * NWAVES + wid, NGW = G * NWAVES;
    gu32* ctl = (gu32*)(args.wsp + WS_CTL);
    for (int u = tid; u < 64; u += NWAVES * 64) ((LAS unsigned*)(lds + MISC_OFF))[u] = 0u;
    __syncthreads();
    XcdBarrier bar = xcd_barrier_post((unsigned*)(ctl + CW_BAR), MISC + 8);
    const int lo = args.ph_lo, hi = args.ph_hi;
    int pid = 0;
#ifndef PMASK
#define PMASK 0xffffffffu
#endif
#define PH_OPEN(k) if (((PMASK >> (k)) & 1u) && pid >= lo && pid < hi) {
#define PH_CLOSE if (pid + 1 < hi) xcd_barrier(bar); } ++pid;

#define AB ((float*)(args.wsp + WS_AB))
#define BB ((float*)(args.wsp + WS_BB))
#define BT ((float*)(args.wsp + WS_BT))
#define LB ((float*)(args.wsp + WS_LB))
#define SSQ ((float*)(args.wsp + WS_SSQ))
#define WEIN ((bf16*)(args.wsp + WS_WEIN))
#define WGLU ((bf16*)(args.wsp + WS_WGLU))
#define WEOUT ((bf16*)(args.wsp + WS_WEOUT))
#define WOIN ((bf16*)(args.wsp + WS_WOIN))
#define WOOUT ((bf16*)(args.wsp + WS_WOOUT))
#define X ((float*)(args.wsp + WS_X))
#define XN ((bf16*)(args.wsp + WS_XN))
#define MIX ((bf16*)(args.wsp + WS_MIX))
#define QC ((bf16*)(args.wsp + WS_QC))
#define CO ((bf16*)(args.wsp + WS_CO))
#define MPB ((bf16*)(args.wsp + WS_MPB))
#define KVM ((bf16*)(args.wsp + WS_KVM))
#define H0 ((bf16*)(args.wsp + WS_HBIG))
#define Z ((bf16*)(args.wsp + WS_Z))
#define H1 ((bf16*)(args.wsp + WS_HBIG))
#define HF ((bf16*)(args.wsp + WS_HBIG))
#define ws (args.wsp)
#define out (args.outp)
    PH_OPEN(0)
    {
        LAS float* scr = (LAS float*)(lds + wid * 16384);
        constexpr int CNT_FIXED = (4096 / 64) * (5120 / 32) + (2048 / 64) * (2048 / 32) + 2 * (4096 / 64) * (4096 / 32) + (4096 / 64) * (16384 / 32);
        constexpr int CNT_LAYER = 3 * (4096 / 64) * (512 / 32) + (512 / 64) * (4096 / 32) + 2 * (4096 / 64) * (11008 / 32) + (11008 / 64) * (4096 / 32);
        constexpr int NITEMS = CNT_FIXED + 2 * CNT_LAYER;
        for (int it = gw; it < NITEMS; it += NGW) {
            int r = it;
            P0_MAT(ARG(I_WEIN), 4096, 5120, WEIN, 0)
            P0_MAT(ARG(I_WGLU), 2048, 2048, WGLU, 0)
            P0_MAT(ARG(I_WEOUT), 4096, 4096, WEOUT, 0)
            P0_MAT(ARG(I_WOOUT), 4096, 4096, WOOUT, 0)
            P0_MAT(ARG(I_WOIN), 4096, 16384, WOIN, 0)
            const int l = r / CNT_LAYER; r -= l * CNT_LAYER;
            unsigned char* lw = ws + WS_LAYER + (size_t)l * LAYER_STRIDE;
            P0_MAT(ARG(I_WMQ) + (size_t)l * 4096 * 512, 4096, 512, (bf16*)(lw + L_WMQ), 0)
            P0_MAT(ARG(I_WMK) + (size_t)l * 4096 * 512, 4096, 512, (bf16*)(lw + L_WMKV), 0)
            P0_MAT(ARG(I_WMV) + (size_t)l * 4096 * 512, 4096, 512, (bf16*)(lw + L_WMKV), 3)
            P0_MAT(ARG(I_WMO) + (size_t)l * 512 * 4096, 512, 4096, (bf16*)(lw + L_WMO), 0)
            P0_MAT(ARG(I_WFG) + (size_t)l * 4096 * FF, 4096, FF, (bf16*)(lw + L_WGU), 1)
            P0_MAT(ARG(I_WFU) + (size_t)l * 4096 * FF, 4096, FF, (bf16*)(lw + L_WGU), 2)
            P0_MAT(ARG(I_WFD) + (size_t)l * FF * 4096, FF, 4096, (bf16*)(lw + L_WD), 0)
        }
        for (int m = gw; m < MPAD; m += NGW) {
            const float* src = m < MPROMPT ? ARG(I_XP) + (size_t)m * D : (m < MREAL ? ARG(I_XS) + (size_t)(m - MPROMPT) * D : nullptr);
            copy_row(src, X + (size_t)m * D, XN + (size_t)m * D, lane);
        }
        for (int m = gw; m < 1024; m += NGW) copy_row(ARG(I_MEMP) + (size_t)m * D, nullptr, MPB + (size_t)m * D, lane);
        const int gt = cu * (NWAVES * 64) + tid, NGT = G * NWAVES * 64;
        for (int e = gt; e < 128 * 64; e += NGT) {
            const int g = e >> 6;
            const float lr = fminf(ARG(I_LAMR)[e], -1e-4f), li = ARG(I_LAMI)[e], dt = expf(ARG(I_LOGDT)[g]);
            const float mag = expf(lr * dt), are = mag * cosf(li * dt), aim = mag * sinf(li * dt), den = lr * lr + li * li;
            const float fr = ((are - 1.0f) * lr + aim * li) / den, fi = (aim * lr - (are - 1.0f) * li) / den;
            AB[2 * e] = are; AB[2 * e + 1] = aim;
            for (int h = 0; h < 16; ++h) { const float br = ARG(I_BRE)[(size_t)e * 16 + h], bi = ARG(I_BIM)[(size_t)e * 16 + h];
                BB[(size_t)e * 32 + h] = fr * br - fi * bi; BB[(size_t)e * 32 + 16 + h] = fr * bi + fi * br; }
        }
        for (int e = gt; e < 32 * 128; e += NGT) {
            const int hq = e >> 7, n = e & 127; int bucket = n;
            if (n >= 16) { const int lg = 16 + (int)(logf((float)n / 16.0f) / 2.0794415416798357f * 16.0f); bucket = lg < 31 ? lg : 31; }
            BT[e] = ARG(I_RELB)[bucket * 32 + hq];
        }
        for (int e = gt; e < 4096; e += NGT) { const float l0 = ARG(I_LBL)[e], l1 = ARG(I_LBL)[4096 + e]; LB[e] = 1.0f / (1.0f + expf(l0 - l1)); }
        for (int e = gt; e < MPAD; e += NGT) SSQ[e] = 0.f;
    }
    PH_CLOSE

    PH_OPEN(1)
    {
        GEMM_CALL(EpiStoreBf16, XN, WEIN, MPAD, NE, 4096, cu, H0, NE);
        GEMM_CALL(EpiMemKV, MPB, ws + WS_LAYER + L_WMKV, 1024, 1024, 4096, (cu + G - 148) % G, out + O_PMK, out + O_PMV, KVM);
        GEMM_CALL(EpiMemKV, MPB, ws + WS_LAYER + LAYER_STRIDE + L_WMKV, 1024, 1024, 4096, (cu + G - 164) % G, out + O_PMK + 524288, out + O_PMV + 524288, KVM + 1024 * 1024);
    }
    PH_CLOSE

    PH_OPEN(2)
    {
        const float* sinks = ARG(I_SINK);
#ifndef NO_U0
        for (int i = cu; i < 512; i += G)
            s5_prompt_unit(lds, H0, Z, AB, BB, ARG(I_CRE), ARG(I_CIM), ARG(I_S5D), out + O_PS5R, out + O_PS5I, i >> 7, i & 127, wid, lane);
#endif
#ifndef NO_U1
        for (int i = 512 + ((cu - 512 % G + G) % G); i < 528; i += G) {
            s5_sample_wave(lds, H0, Z, AB, BB, ARG(I_CRE), ARG(I_CIM), ARG(I_S5D), ARG(I_S5R), ARG(I_S5I), out + O_SS5R, out + O_SS5I, (i - 512) * 8 + wid, wid, lane);
            __syncthreads();
        }
#endif
#ifndef NO_U2
        for (int i = 528 + ((cu - 528 % G + G) % G); i < 1552; i += G) { const int u = i - 528;
            swa_prompt_unit(lds, H0, MIX, BT, sinks, out + O_PSK, out + O_PSV, u >> 8, (u >> 5) & 7, u & 31, tid, wid, lane); }
#endif
#ifndef NO_U3
        for (int i = 1552 + ((cu - 1552 % G + G) % G); i < 1808; i += G) { const int u = i - 1552;
            swa_sample_unit(lds, H0, MIX, BT, sinks, ARG(I_CSK), ARG(I_CSV), out + O_SSK, out + O_SSV, u >> 3, u & 7, tid, wid, lane); }
#endif
    }
    PH_CLOSE

    PH_OPEN(3)
    { GEMM_CALL(EpiGlu, Z, WGLU, MPAD, 2048, 2048, cu, Z, MIX); }
    PH_CLOSE

    PH_OPEN(4)
    { GEMM_CALL(EpiRes, MIX, WEOUT, MPAD, 4096, 4096, cu, X, nullptr); }
    PH_CLOSE

    {
        constexpr int l = 0;
        unsigned char* lw = ws + WS_LAYER + (size_t)l * LAYER_STRIDE;
        const float* lng = ARG(I_LNG) + (size_t)l * 3 * D; const float* lnb = ARG(I_LNB) + (size_t)l * 3 * D;
        PH_OPEN(8)
        { ln_phase(X, lng, lnb, X, XN, gw, NGW, lane); }
        PH_CLOSE
        PH_OPEN(9)
        { GEMM_CALL(EpiStoreBf16, XN, lw + L_WMQ, MPAD, 512, 4096, cu, QC, 512); }
        PH_CLOSE
        PH_OPEN(10)
        {
            for (int i = cu; i < 128; i += G) cross_prompt_unit(lds, QC, KVM + (size_t)l * 1024 * 1024, CO, i >> 5, (i >> 3) & 3, i & 7, tid, wid, lane);
            for (int i = 128 + ((cu - 128 % G + G) % G); i < 144; i += G) { const int wu = (i - 128) * 8 + wid;
                cross_sample_wave(lds, QC, ARG(I_CMK) + (size_t)l * 32 * 256 * 512, ARG(I_CMV) + (size_t)l * 32 * 256 * 512, CO, wu >> 2, wu & 3, wid, lane);
                __syncthreads(); }
        }
        PH_CLOSE
        PH_OPEN(11)
        { GEMM_CALL(EpiRes, CO, lw + L_WMO, MPAD, 4096, 512, cu, X, nullptr); }
        PH_CLOSE
        PH_OPEN(12)
        { ln_phase(X, lng + D, lnb + D, X, XN, gw, NGW, lane); }
        PH_CLOSE
        PH_OPEN(13)
        { GEMM_CALL(EpiGU, XN, lw + L_WGU, MPAD, 2 * FF, 4096, cu, HF); }
        PH_CLOSE
        PH_OPEN(14)
        { GEMM_CALL(EpiRes, HF, lw + L_WD, MPAD, 4096, FF, cu, X, nullptr); }
        PH_CLOSE
        PH_OPEN(15)
        { if (l == 1) ln_phase(X, lng + 2 * D, lnb + 2 * D, out + O_Y, nullptr, gw, NGW, lane); else ln_phase(X, lng + 2 * D, lnb + 2 * D, X, XN, gw, NGW, lane); }
        PH_CLOSE
    }
    {
            PH_OPEN(5)
            { GEMM_CALL(EpiOddIn, XN, WOIN, MPAD, NO, 4096, cu, H1, LB); }
            PH_CLOSE
            PH_OPEN(6)
            {
                for (int i = cu; i < 256; i += G) { const int b = i >> 6, hh = (i >> 1) & 31, dvh = i & 1;
                    hgrn_unit(lds, H1, MIX, SSQ, ARG(I_NORMG), nullptr, out + O_PHG + (size_t)(b * 32 + hh) * 16384, b * PSEQ, PSEQ, hh, dvh, tid, wid, lane); }
                for (int i = 256 + ((cu - 256 % G + G) % G); i < 256 + 2048; i += G) { const int u = i - 256, b = u >> 6, hh = (u >> 1) & 31, dvh = u & 1;
                    hgrn_unit(lds, H1, MIX, SSQ, ARG(I_NORMG), ARG(I_SHG) + (size_t)(b * 32 + hh) * 16384, out + O_SHG + (size_t)(b * 32 + hh) * 16384, MPROMPT + 4 * b, 4, hh, dvh, tid, wid, lane); }
            }
            PH_CLOSE
            PH_OPEN(7)
            { GEMM_CALL(EpiRes, MIX, WOOUT, MPAD, 4096, 4096, cu, X, SSQ); }
            PH_CLOSE
    }
    {
        constexpr int l = 1;
        unsigned char* lw = ws + WS_LAYER + (size_t)l * LAYER_STRIDE;
        const float* lng = ARG(I_LNG) + (size_t)l * 3 * D; const float* lnb = ARG(I_LNB) + (size_t)l * 3 * D;
        PH_OPEN(8)
        { ln_phase(X, lng, lnb, X, XN, gw, NGW, lane); }
        PH_CLOSE
        PH_OPEN(9)
        { GEMM_CALL(EpiStoreBf16, XN, lw + L_WMQ, MPAD, 512, 4096, cu, QC, 512); }
        PH_CLOSE
        PH_OPEN(10)
        {
            for (int i = cu; i < 128; i += G) cross_prompt_unit(lds, QC, KVM + (size_t)l * 1024 * 1024, CO, i >> 5, (i >> 3) & 3, i & 7, tid, wid, lane);
            for (int i = 128 + ((cu - 128 % G + G) % G); i < 144; i += G) { const int wu = (i - 128) * 8 + wid;
                cross_sample_wave(lds, QC, ARG(I_CMK) + (size_t)l * 32 * 256 * 512, ARG(I_CMV) + (size_t)l * 32 * 256 * 512, CO, wu >> 2, wu & 3, wid, lane);
                __syncthreads(); }
        }
        PH_CLOSE
        PH_OPEN(11)
        { GEMM_CALL(EpiRes, CO, lw + L_WMO, MPAD, 4096, 512, cu, X, nullptr); }
        PH_CLOSE
        PH_OPEN(12)
        { ln_phase(X, lng + D, lnb + D, X, XN, gw, NGW, lane); }
        PH_CLOSE
        PH_OPEN(13)
        { GEMM_CALL(EpiGU, XN, lw + L_WGU, MPAD, 2 * FF, 4096, cu, HF); }
        PH_CLOSE
        PH_OPEN(14)
        { GEMM_CALL(EpiRes, HF, lw + L_WD, MPAD, 4096, FF, cu, X, nullptr); }
        PH_CLOSE
        PH_OPEN(15)
        { if (l == 1) ln_phase(X, lng + 2 * D, lnb + 2 * D, out + O_Y, nullptr, gw, NGW, lane); else ln_phase(X, lng + 2 * D, lnb + 2 * D, X, XN, gw, NGW, lane); }
        PH_CLOSE
    }
#undef PH_OPEN
#undef PH_CLOSE
}
#undef AB
#undef BB
#undef BT
#undef LB
#undef SSQ
#undef WEIN
#undef WGLU
#undef WEOUT
#undef WOIN
#undef WOOUT
#undef X
#undef XN
#undef MIX
#undef QC
#undef CO
#undef MPB
#undef KVM
#undef H0
#undef Z
#undef H1
#undef HF
#undef ws
#undef out

extern "C" void kernel_launch(void* const* d_in, const int* in_sizes, int n_in, void* d_out, int out_size, void* d_ws, size_t ws_size, hipStream_t stream) {
    static int grid = 0;
    if (grid == 0) {
        if (n_in != 36 || in_sizes[0] != MPROMPT * D || (size_t)out_size != O_END || ws_size < WS_END) {
            fprintf(stderr, "kernel_launch: shape/workspace mismatch: n_in %d in0 %d out %d ws %zu (need %zu); nothing launched\n", n_in, n_in > 0 ? in_sizes[0] : -1, out_size, ws_size, (size_t)WS_END); grid = -1; return; }
        int dev = 0, cus = 0, per_cu = 0;
        if (hipGetDevice(&dev) != hipSuccess || hipDeviceGetAttribute(&cus, hipDeviceAttributeMultiprocessorCount, dev) != hipSuccess) { grid = -1; return; }
        if (hipFuncSetAttribute((const void*)hybrid_fwd, hipFuncAttributeMaxDynamicSharedMemorySize, LDS_BYTES) != hipSuccess) { fprintf(stderr, "kernel_launch: hipFuncSetAttribute failed\n"); grid = -1; return; }
        if (hipOccupancyMaxActiveBlocksPerMultiprocessor(&per_cu, (const void*)hybrid_fwd, NWAVES * 64, LDS_BYTES) != hipSuccess || per_cu < 1)
            fprintf(stderr, "kernel_launch: note: occupancy query reports %d workgroups per CU\n", per_cu);
        (void)hipGetLastError();
        grid = cus;
    }
    if (grid < 0) return;
    if (hipMemsetAsync((char*)d_ws + WS_CTL, 0, CTL_ZERO_BYTES, stream) != hipSuccess) return;
    Args a{};
    for (int i = 0; i < 36; ++i) a.in[i] = (const float*)d_in[i];
    a.outp = (float*)d_out; a.wsp = (unsigned char*)d_ws;
#if MK_SPLIT
    for (int p = 0; p < N_PHASES; ++p) { a.ph_lo = p; a.ph_hi = p + 1; hipLaunchKernelGGL(hybrid_fwd, dim3(grid), dim3(NWAVES * 64), LDS_BYTES, stream, a); }
#else
    a.ph_lo = 0; a.ph_hi = N_PHASES;
    hipLaunchKernelGGL(hybrid_fwd, dim3(grid), dim3(NWAVES * 64), LDS_BYTES, stream, a);
#endif
    const hipError_t le = hipPeekAtLastError();
    if (le != hipSuccess) fprintf(stderr, "kernel_launch: launch failed: %s\n", hipGetErrorName(le));
}
```

```cpp
#include <hip/hip_runtime.h>
#include <cstdio>
#include <cstdint>
#define PROBE 0
namespace pg8 {
#define PG8_LAS __attribute__((address_space(3)))
typedef unsigned short bf16_t;
typedef short bf16x8 __attribute__((ext_vector_type(8)));
typedef float f32x4 __attribute__((ext_vector_type(4)));
typedef unsigned u32x4 __attribute__((ext_vector_type(4)));
constexpr int BM = 256, BK = 64, HALF = 128, HTB = HALF * BK * 2  , STAGE_BYTES = 8 * HTB, NXCD = 8, WGM = 4;

__host__ __device__ __forceinline__ int lds_byte(int r, int c) { const int st = (r >> 4) * 2 + (c >> 5), rr = r & 15, cc = c & 31, ob = rr * 64 + cc * 2; return st * 1024 + (ob ^ (((ob >> 9) & 1) << 5)); }
__host__ __device__ __forceinline__ void stage_rc(int b, int& R, int& C) { const int st = b / 1024, sb = b % 1024, swz = sb ^ (((sb >> 9) & 1) << 5); R = (st >> 1) * 16 + swz / 64; C = (st & 1) * 32 + (swz % 64) / 2; }
__host__ __device__ __forceinline__ int perm32(int rho) { const int n = rho >> 4, i = rho & 15; return 8 * (i >> 2) + 4 * n + (i & 3); }

struct Unit { int pm, pn, k0, nk, ks; };
struct Gemm { const bf16_t* A; const bf16_t* Bt; int M, N, K; };

struct StaticOrder {
    int nM, nN, nwg, G, c, nt;
    __host__ __device__ void init(int M, int N, int K, int G_, int c_) { nM = M / BM; nN = N / BM; nwg = nM * nN; G = G_; c = c_; nt = K / BK; }
    __host__ __device__ __forceinline__ bool next(int i, Unit& u) const {
        const long L = (long)i * G + c; if (L >= nwg) return false;
        int wgid = (int)L; { const int q = nwg / NXCD, r = nwg % NXCD, xcd = wgid % NXCD, off = wgid / NXCD; wgid = (xcd < r ? xcd * (q + 1) : r * (q + 1) + (xcd - r) * q) + off; }
        const int nig = WGM * nN, gid = wgid / nig, fm = gid * WGM, gsz = (nM - fm) < WGM ? (nM - fm) : WGM;
        u.pm = fm + ((wgid % nig) % gsz); u.pn = (wgid % nig) / gsz; u.k0 = 0; u.nk = nt; u.ks = -1; return true;
    }
    __device__ __forceinline__ void a_ready(const Unit&) const {}
    __device__ __forceinline__ void done(const Unit&) const {}
};
struct SplitOrder {
    StaticOrder so; int mfull, nsl;
    __host__ __device__ void init(int mfull_, int N, int K, int G_, int c_, int nsl_) { so.init(mfull_ * BM, N, K, G_, c_); mfull = mfull_; nsl = nsl_; }
    __host__ __device__ __forceinline__ bool next(int i, Unit& u) const {
        const long L = (long)i * so.G + so.c;
        if (L >= (long)so.nwg + so.nN * nsl) return false;
        const bool full = L < so.nwg;
        int wgid = full ? (int)L : 0; { const int q = so.nwg / NXCD, r = so.nwg % NXCD, xcd = wgid % NXCD, off = wgid / NXCD; wgid = (xcd < r ? xcd * (q + 1) : r * (q + 1) + (xcd - r) * q) + off; }
        const int nig = WGM * so.nN, gid = wgid / nig, fm = gid * WGM, gsz = (so.nM - fm) < WGM ? (so.nM - fm) : WGM;
        const int fpm = fm + ((wgid % nig) % gsz), fpn = (wgid % nig) / gsz;
        const int j = full ? 0 : (int)(L - so.nwg), ks = j / so.nN, pairs = so.nt / 2, base = pairs / nsl, rem = pairs % nsl;
        const int sk0 = 2 * (ks * base + (ks < rem ? ks : rem)), snk = 2 * (base + (ks < rem ? 1 : 0));
        u.pm = full ? fpm : mfull; u.pn = full ? fpn : (j % so.nN); u.k0 = full ? 0 : sk0; u.nk = full ? so.nt : snk; u.ks = full ? -1 : ks;
        return true;
    }
    __device__ __forceinline__ void a_ready(const Unit&) const {}
    __device__ __forceinline__ void done(const Unit&) const {}
};

struct GuOrder {
    StaticOrder so; int G, c;
    __host__ __device__ void init(int N, int K, int G_, int c_) { so.init(32 * BM, N, K, G_, c_); G = G_; c = c_; }
    __host__ __device__ __forceinline__ bool next(int i, Unit& u) const {
        const int nitems = so.nN * 4;
        long L; int j = -1;
        if (G == 256) {
            if (i < 10) L = (long)i * 256 + c;
            else if (c < 192) { if (i == 10) L = 2560 + c; else if (i == 11 && c < nitems - 256) { L = 0; j = 256 + c; } else return false; }
            else { if (i < 14) { L = 0; j = (i - 10) * 64 + (c - 192); } else return false; }
        } else { L = (long)i * G + c; if (L >= so.nwg) { j = (int)(L - so.nwg); L = 0; if (j >= nitems) return false; } }
        const bool full = j < 0;
        int wgid = (int)L; { const int q = so.nwg / NXCD, r = so.nwg % NXCD, xcd = wgid % NXCD, off = wgid / NXCD; wgid = (xcd < r ? xcd * (q + 1) : r * (q + 1) + (xcd - r) * q) + off; }
        const int nig = WGM * so.nN, gid = wgid / nig, fm = gid * WGM, gsz = (so.nM - fm) < WGM ? (so.nM - fm) : WGM;
        const int fpm = fm + ((wgid % nig) % gsz), fpn = (wgid % nig) / gsz;
        const int jj = full ? 0 : j, ks = jj / so.nN, snk = so.nt / 4;
        u.pm = full ? fpm : 32; u.pn = full ? fpn : (jj % so.nN); u.k0 = full ? 0 : ks * snk; u.nk = full ? so.nt : snk; u.ks = full ? -1 : ks;
        return true;
    }
    __device__ __forceinline__ void a_ready(const Unit&) const {}
    __device__ __forceinline__ void done(const Unit&) const {}
};
struct SplitAllOrder {
    int G, c, nt;
    __host__ __device__ void init(int K, int G_, int c_) { G = G_; c = c_; nt = K / BK; }
    __host__ __device__ __forceinline__ bool next(int i, Unit& u) const {
        const long L = (long)i * G + c;
        if (L >= 256 + 16) return false;
        const bool pr = L < 256; const int l = (int)L;
        const int ks_p = (l & 7) >> 1, unit = ((l & 1) << 5) | (l >> 3);
        const int j2 = pr ? 0 : l - 256, ks_s = j2 >> 1;
        u.pm = pr ? (unit >> 1) : 32; u.pn = pr ? (unit & 1) : (j2 & 1); u.ks = pr ? ks_p : ks_s;
        u.nk = pr ? nt / 4 : nt / 8; u.k0 = u.ks * u.nk; return true;
    }
    __device__ __forceinline__ void a_ready(const Unit&) const {}
    __device__ __forceinline__ void done(const Unit&) const {}
};
__device__ __forceinline__ unsigned cvt_pk_bf16(float lo, float hi) { unsigned r; asm volatile("v_cvt_pk_bf16_f32 %0, %1, %2" : "=v"(r) : "v"(lo), "v"(hi)); return r; }
typedef float f32x2 __attribute__((ext_vector_type(2)));
__device__ __forceinline__ f32x2 gelu_pk(f32x2 v) {
    const f32x2 av = __builtin_elementwise_abs(v), d = av * 0.2316418882f + 1.0f;
    f32x2 t; t.x = __builtin_amdgcn_rcpf(d.x); t.y = __builtin_amdgcn_rcpf(d.y);
    f32x2 q = t * 0.5307027145f + (-0.7265760135f); q = q * t + 0.7107068705f; q = q * t + (-0.142248368f); q = q * t + 0.127414796f; q = q * t;
    const f32x2 s = (v * v) * (-0.72134752044f);
    f32x2 e; e.x = __builtin_amdgcn_exp2f(s.x); e.y = __builtin_amdgcn_exp2f(s.y);
    const f32x2 m = v * (q * e), r = v - m;
    f32x2 o; o.x = v.x < 0.f ? m.x : r.x; o.y = v.y < 0.f ? m.y : r.y; return o;
}

template <int ACT  > struct EpiBf16 {
    static constexpr bool PERM = true, AFTER_DRAIN = false; static_assert(ACT == 0 || ACT == 1, "EpiBf16: ACT is 0 (none) or 1 (gelu_pk)");
    bf16_t* O; int ldc; const float* bias; int split_cols; size_t split_stride; float scale0;
    __device__ __forceinline__ void operator()(const f32x4 (&acc)[2][2][4][2], const Unit& u, int wr, int wc, int fr, int fq) const {
        const int row0 = u.pm * BM + wr * 64 + fr; int colt = u.pn * BM; bf16_t* base = O;
        float sc = 1.f; if (split_cols) { const int t = colt / split_cols; base += (size_t)t * split_stride; colt -= t * split_cols; if (t == 0) sc = scale0; }
        const int col0 = colt + wc * 32 + 8 * fq, bcol0 = u.pn * BM + wc * 32 + 8 * fq;
        f32x4 bv[2][2];
#pragma unroll
        for (int bj = 0; bj < 2; ++bj)
#pragma unroll
            for (int n = 0; n < 2; ++n) bv[bj][n] = bias ? *(const f32x4*)(bias + bcol0 + bj * HALF + 4 * n) : (f32x4){0.f, 0.f, 0.f, 0.f};
#pragma unroll
        for (int ai = 0; ai < 2; ++ai)
#pragma unroll
            for (int m = 0; m < 4; ++m) { bf16_t* rowp = base + (size_t)(row0 + ai * HALF + m * 16) * ldc + col0;
#pragma unroll
                for (int bj = 0; bj < 2; ++bj) { f32x4 v0 = acc[ai][bj][m][0] + bv[bj][0], v1 = acc[ai][bj][m][1] + bv[bj][1];
                    if (ACT == 1) { f32x2 a = gelu_pk((f32x2){v0[0], v0[1]}), b = gelu_pk((f32x2){v0[2], v0[3]}), c = gelu_pk((f32x2){v1[0], v1[1]}), d = gelu_pk((f32x2){v1[2], v1[3]});
                        v0 = (f32x4){a.x, a.y, b.x, b.y}; v1 = (f32x4){c.x, c.y, d.x, d.y}; }
                    v0 = v0 * sc; v1 = v1 * sc; u32x4 w; w.x = cvt_pk_bf16(v0[0], v0[1]); w.y = cvt_pk_bf16(v0[2], v0[3]); w.z = cvt_pk_bf16(v1[0], v1[1]); w.w = cvt_pk_bf16(v1[2], v1[3]);
                    *(u32x4*)(rowp + bj * HALF) = w; } }
    }
};

struct PanelStats {
    unsigned* xbuf;
    unsigned* cnt;
    unsigned* tmo;
    int ntn; float eps;
    unsigned code;
    __device__ __forceinline__ bool run(const f32x4 (&v)[2][2][4][2], const Unit& u, int wr, int wc, int fr, int fq, PG8_LAS unsigned char* lds, int wid, int lane) const {
        typedef float f32x2v __attribute__((ext_vector_type(2)));
        PG8_LAS f32x2v* P = (PG8_LAS f32x2v*)lds;
        PG8_LAS f32x2v* S = (PG8_LAS f32x2v*)(lds + 8192);
        PG8_LAS unsigned* flag = (PG8_LAS unsigned*)(lds + 8192 + 2048);
#pragma unroll
        for (int ai = 0; ai < 2; ++ai)
#pragma unroll
            for (int m = 0; m < 4; ++m) {
                float s = 0.f;
#pragma unroll
                for (int bj = 0; bj < 2; ++bj)
#pragma unroll
                    for (int n = 0; n < 2; ++n) { const f32x4 x = v[ai][bj][m][n]; s += (x[0] + x[1]) + (x[2] + x[3]); }
                s += __shfl_xor(s, 16); s += __shfl_xor(s, 32);
                const float mw = s * (1.0f / 64.0f); float q = 0.f;
#pragma unroll
                for (int bj = 0; bj < 2; ++bj)
#pragma unroll
                    for (int n = 0; n < 2; ++n) { const f32x4 d = v[ai][bj][m][n] - mw; q += (d[0] * d[0] + d[1] * d[1]) + (d[2] * d[2] + d[3] * d[3]); }
                q += __shfl_xor(q, 16); q += __shfl_xor(q, 32);
                if (fq == 0) P[(ai * HALF + wr * 64 + m * 16 + fr) * 4 + wc] = (f32x2v){mw, q};
            }
        asm volatile("s_waitcnt lgkmcnt(0)" ::: "memory"); __builtin_amdgcn_s_barrier(); asm volatile("" ::: "memory");
#if defined(BROKEN_EXCHANGE_NO_WAIT)
#warning BROKEN CONTROL BUILD: the row-statistics exchange does not wait; results are wrong by design
        if (blockIdx.x >= 64) { const long long t0_ = clock64(); while (clock64() - t0_ < 60000) __builtin_amdgcn_s_sleep(8); }
#endif
        const int row = wid * 32 + (lane & 31);
        if (lane < 32) {
            const f32x2v a = P[row * 4 + 0], b = P[row * 4 + 1], c = P[row * 4 + 2], d = P[row * 4 + 3];
            const float mt = (a.x + b.x + c.x + d.x) * 0.25f;
            const float da = a.x - mt, db = b.x - mt, dc = c.x - mt, dd = d.x - mt;
            const float m2 = (a.y + b.y) + (c.y + d.y) + 64.0f * ((da * da + db * db) + (dc * dc + dd * dd));
            unsigned long long* slot = (unsigned long long*)xbuf + ((size_t)(u.pm * BM + row) * 4 + u.pn);
            __hip_atomic_store(slot, ((unsigned long long)__float_as_uint(m2) << 32) | __float_as_uint(mt), __ATOMIC_RELAXED, __HIP_MEMORY_SCOPE_AGENT);
        }
        asm volatile("s_waitcnt vmcnt(0)" ::: "memory");
        if (lane == 0) __hip_atomic_fetch_add(cnt + 64 * u.pm, 1u, __ATOMIC_RELAXED, __HIP_MEMORY_SCOPE_AGENT);
        if (wid == 0) {
            bool dead = false; const unsigned long long t0 = __builtin_amdgcn_s_memrealtime(); const unsigned want = 8u * (unsigned)ntn;
            for (;;) {
#if defined(BROKEN_EXCHANGE_NO_WAIT)
                break;
#endif
                if ((unsigned)__builtin_amdgcn_readfirstlane(__hip_atomic_load(cnt + 64 * u.pm, __ATOMIC_RELAXED, __HIP_MEMORY_SCOPE_AGENT)) >= want) break;
                if (__builtin_amdgcn_s_memrealtime() - t0 > 2000000ull) {
                    if (lane == 0) { unsigned expect = 0u; __hip_atomic_compare_exchange_strong(tmo + 1, &expect, code | (unsigned)(u.pm & 0xff), __ATOMIC_RELAXED, __ATOMIC_RELAXED, __HIP_MEMORY_SCOPE_AGENT);
                                     __hip_atomic_store(tmo, 1u, __ATOMIC_RELAXED, __HIP_MEMORY_SCOPE_AGENT); }
                    dead = true; break; }
                __builtin_amdgcn_s_sleep(2);
            }
            __builtin_amdgcn_fence(__ATOMIC_ACQUIRE, "agent");
            if (lane == 0) flag[0] = dead ? 1u : 0u;
        }
        asm volatile("s_waitcnt vmcnt(0) lgkmcnt(0)" ::: "memory"); __builtin_amdgcn_s_barrier(); asm volatile("" ::: "memory");
        const bool bad = flag[0] != 0u;
        if (lane < 32) {
            const unsigned long long* slot = (const unsigned long long*)xbuf + (size_t)(u.pm * BM + row) * 4; float mt[4], m2[4]; float ms = 0.f;
#pragma unroll
            for (int t = 0; t < 4; ++t) { if (t < ntn) { const unsigned long long w = __hip_atomic_load(slot + t, __ATOMIC_RELAXED, __HIP_MEMORY_SCOPE_AGENT); mt[t] = __uint_as_float((unsigned)w); m2[t] = __uint_as_float((unsigned)(w >> 32)); } else { mt[t] = 0.f; m2[t] = 0.f; } ms += mt[t]; }
            const float mean = ms / (float)ntn; float q = 0.f;
#pragma unroll
            for (int t = 0; t < 4; ++t) if (t < ntn) { const float dm = mt[t] - mean; q += m2[t] + 256.0f * dm * dm; }
            S[row] = (f32x2v){mean, 1.0f / sqrtf(q / (256.0f * (float)ntn) + eps)};
        }
        asm volatile("s_waitcnt lgkmcnt(0)" ::: "memory"); __builtin_amdgcn_s_barrier(); asm volatile("" ::: "memory");
        return bad;
    }
};
struct EpiLnRes {
    static constexpr bool PERM = false, AFTER_DRAIN = true;
    const float* base; float* out; int ldc; const float* bias; PanelStats st; unsigned poison;
    __device__ __forceinline__ void fused(f32x4 (&acc)[2][2][4][2], const Unit& u, int wr, int wc, int fr, int fq, PG8_LAS unsigned char* lds, int wid, int lane) const {
        typedef float f32x2v __attribute__((ext_vector_type(2)));
        const PG8_LAS f32x2v* S = (const PG8_LAS f32x2v*)(lds + 8192);
        const int col0 = u.pn * BM + wc * 32 + 4 * fq;
#pragma unroll
        for (int bj = 0; bj < 2; ++bj)
#pragma unroll
            for (int n = 0; n < 2; ++n) { const f32x4 bv = bias ? *(const f32x4*)(bias + col0 + bj * HALF + n * 16) : (f32x4){0.f, 0.f, 0.f, 0.f};
#pragma unroll
                for (int ai = 0; ai < 2; ++ai)
#pragma unroll
                    for (int m = 0; m < 4; ++m) acc[ai][bj][m][n] += bv; }
        f32x4 pre[4][2][2];
#pragma unroll
        for (int m = 0; m < 4; ++m) { const size_t off = (size_t)(u.pm * BM + wr * 64 + m * 16 + fr) * ldc + col0;
#pragma unroll
            for (int bj = 0; bj < 2; ++bj)
#pragma unroll
                for (int n = 0; n < 2; ++n) pre[m][bj][n] = *(const f32x4*)(base + off + bj * HALF + n * 16); }
        const bool bad = st.run(acc, u, wr, wc, fr, fq, lds, wid, lane) || poison != 0u;
        const float qnan = __builtin_nanf("");
#pragma unroll
        for (int ai = 0; ai < 2; ++ai)
#pragma unroll
            for (int m = 0; m < 4; ++m) { const int r = ai * HALF + wr * 64 + m * 16 + fr; const f32x2v sr = S[r]; const size_t off = (size_t)(u.pm * BM + r) * ldc + col0;
#pragma unroll
                for (int bj = 0; bj < 2; ++bj)
#pragma unroll
                    for (int n = 0; n < 2; ++n) { const f32x4 bs = ai == 0 ? pre[m][bj][n] : *(const f32x4*)(base + off + bj * HALF + n * 16); f32x4 o = bs + (acc[ai][bj][m][n] - sr.x) * sr.y;
                        if (bad) o = (f32x4){qnan, qnan, qnan, qnan}; *(f32x4*)(out + off + bj * HALF + n * 16) = o; }
                if (m & 1) asm volatile("" ::: "memory"); }
    }
};
struct EpiLnResLn {
    static constexpr bool PERM = false, AFTER_DRAIN = true;
    const float* base; float* out; bf16_t* xn; int ldc; const float* bias; PanelStats st1, st2; unsigned poison;
    __device__ __forceinline__ void fused(f32x4 (&acc)[2][2][4][2], const Unit& u, int wr, int wc, int fr, int fq, PG8_LAS unsigned char* lds, int wid, int lane) const {
        typedef float f32x2v __attribute__((ext_vector_type(2))); typedef unsigned u32x2v __attribute__((ext_vector_type(2)));
        const PG8_LAS f32x2v* S = (const PG8_LAS f32x2v*)(lds + 8192);
        const int col0 = u.pn * BM + wc * 32 + 4 * fq;
#pragma unroll
        for (int bj = 0; bj < 2; ++bj)
#pragma unroll
            for (int n = 0; n < 2; ++n) { const f32x4 bv = bias ? *(const f32x4*)(bias + col0 + bj * HALF + n * 16) : (f32x4){0.f, 0.f, 0.f, 0.f};
#pragma unroll
                for (int ai = 0; ai < 2; ++ai)
#pragma unroll
                    for (int m = 0; m < 4; ++m) acc[ai][bj][m][n] += bv; }
        bool bad = st1.run(acc, u, wr, wc, fr, fq, lds, wid, lane) || poison != 0u;
        const float qnan = __builtin_nanf("");
#pragma unroll
        for (int ai = 0; ai < 2; ++ai)
#pragma unroll
            for (int m = 0; m < 4; ++m) { const int r = ai * HALF + wr * 64 + m * 16 + fr; const f32x2v sr = S[r]; const size_t off = (size_t)(u.pm * BM + r) * ldc + col0;
#pragma unroll
                for (int bj = 0; bj < 2; ++bj)
#pragma unroll
                    for (int n = 0; n < 2; ++n) { const f32x4 bs = *(const f32x4*)(base + off + bj * HALF + n * 16); acc[ai][bj][m][n] = bs + (acc[ai][bj][m][n] - sr.x) * sr.y; }
                asm volatile("" : "+v"(acc[ai][0][m][0]), "+v"(acc[ai][0][m][1]), "+v"(acc[ai][1][m][0]), "+v"(acc[ai][1][m][1]));
                if (m & 1) asm volatile("" ::: "memory"); }
        const bool bad1 = bad;
        bad = st2.run(acc, u, wr, wc, fr, fq, lds, wid, lane) || bad;
#pragma unroll
        for (int ai = 0; ai < 2; ++ai)
#pragma unroll
            for (int m = 0; m < 4; ++m) { const int r = ai * HALF + wr * 64 + m * 16 + fr; const f32x2v sr = S[r]; const size_t off = (size_t)(u.pm * BM + r) * ldc + col0;
#pragma unroll
                for (int bj = 0; bj < 2; ++bj)
#pragma unroll
                    for (int n = 0; n < 2; ++n) { const f32x4 x1 = acc[ai][bj][m][n]; *(f32x4*)(out + off + bj * HALF + n * 16) = bad1 ? (f32x4){qnan, qnan, qnan, qnan} : x1;
                        const f32x4 o = (x1 - sr.x) * sr.y; u32x2v w; w.x = cvt_pk_bf16(o[0], o[1]); w.y = cvt_pk_bf16(o[2], o[3]);
                        if (bad) { w.x = 0x7fc07fc0u; w.y = 0x7fc07fc0u; } *(u32x2v*)(xn + off + bj * HALF + n * 16) = w; }
                asm volatile("" ::: "memory"); }
    }
};

template <class Epi, class Sched, bool ALIGN_EPI = false, bool SP2 = false>
__device__ __forceinline__ void gemm_phase(PG8_LAS unsigned char* lds, const Gemm g, const Sched& S, const Epi& E) {
    const int tid = threadIdx.x, wid = __builtin_amdgcn_readfirstlane(tid >> 6), lane = tid & 63, wr = wid >> 2, wc = wid & 3, fr = lane & 15, fq = lane >> 4;
    const int K = g.K, nt = K / BK;
    unsigned voffA[2], voffB[2];
#pragma unroll
    for (int i = 0; i < 2; ++i) { int R, C; stage_rc(tid * 16 + i * 8192, R, C); const int Rb = Epi::PERM ? ((R & ~31) + perm32(R & 31)) : R;
        voffA[i] = (unsigned)(R * K + C) * 2u; voffB[i] = (unsigned)(Rb * K + C) * 2u; }
    const size_t kstep = (size_t)(BK * 2);
    const size_t hstep = (size_t)HALF * K * 2;
    const size_t tstep = 2 * hstep;
    const unsigned ldsw = (unsigned)wid * 1024u;
    const int aoff = lds_byte(wr * 64 + fr, fq * 8), boff = lds_byte(wc * 32 + fr, fq * 8);
#define PG8_SA(b, h) (((b) * 2 + (h)) * HTB)
#define PG8_SB(b, h) ((4 + (b) * 2 + (h)) * HTB)
#define PG8_STAGE(bufoff, gbase, voff) do { _Pragma("unroll") for (int _i = 0; _i < 2; ++_i) \
        __builtin_amdgcn_global_load_lds((const unsigned*)((const char*)(gbase) + (voff)[_i]), (PG8_LAS unsigned*)(lds + (bufoff) + ldsw + _i * 8192), 16, 0, 0); } while (0)
#define PG8_LDA(dst, b, h) do { _Pragma("unroll") for (int m = 0; m < 4; ++m) _Pragma("unroll") for (int k = 0; k < 2; ++k) dst[m][k] = *(const PG8_LAS bf16x8*)(lds + PG8_SA(b, h) + aoff + m * 2048 + k * 1024); } while (0)
#define PG8_LDB(dst, b, h) do { _Pragma("unroll") for (int n = 0; n < 2; ++n) _Pragma("unroll") for (int k = 0; k < 2; ++k) dst[n][k] = *(const PG8_LAS bf16x8*)(lds + PG8_SB(b, h) + boff + n * 2048 + k * 1024); } while (0)
#define PG8_MMA(ai, bj, At, Bt) do { __builtin_amdgcn_s_setprio(1); _Pragma("unroll") for (int m = 0; m < 4; ++m) _Pragma("unroll") for (int n = 0; n < 2; ++n) _Pragma("unroll") for (int k = 0; k < 2; ++k) \
        acc[ai][bj][m][n] = __builtin_amdgcn_mfma_f32_16x16x32_bf16(Bt[n][k], At[m][k], acc[ai][bj][m][n], 0, 0, 0); __builtin_amdgcn_s_setprio(0); } while (0)
#define PG8_WAIT_V(n) asm volatile("s_waitcnt vmcnt(" #n ")" ::: "memory")
#define PG8_WAIT_L(n) asm volatile("s_waitcnt lgkmcnt(" #n ")" ::: "memory")
#define PG8_BAR __builtin_amdgcn_s_barrier()
#define PG8_SCHED __builtin_amdgcn_sched_barrier(0)
    Unit cur, nxt; int ui = 0;
    if (!S.next(0, cur)) return;
    f32x4 acc[2][2][4][2];
#pragma unroll
    for (int a = 0; a < 2; ++a)
#pragma unroll
        for (int b = 0; b < 2; ++b)
#pragma unroll
            for (int m = 0; m < 4; ++m)
#pragma unroll
                for (int n = 0; n < 2; ++n) acc[a][b][m][n] = (f32x4){0.f, 0.f, 0.f, 0.f};
    bf16x8 At[4][2], B0[2][2], B1[2][2];
    const char* cA = (const char*)g.A + (size_t)cur.pm * tstep + (size_t)cur.k0 * kstep; const char* cB = (const char*)g.Bt + (size_t)cur.pn * tstep + (size_t)cur.k0 * kstep;
    S.a_ready(cur);
    if constexpr (SP2) {
        PG8_STAGE(PG8_SB(0, 0), cB, voffB); PG8_STAGE(PG8_SB(0, 1), cB + hstep, voffB); PG8_STAGE(PG8_SA(0, 0), cA, voffA); PG8_STAGE(PG8_SA(0, 1), cA + hstep, voffA);
        if (wr == 1) PG8_BAR;
        PG8_WAIT_V(2); PG8_BAR;
        PG8_STAGE(PG8_SB(1, 0), cB + kstep, voffB); PG8_STAGE(PG8_SA(1, 0), cA + kstep, voffA); PG8_STAGE(PG8_SB(1, 1), cB + hstep + kstep, voffB);
        PG8_WAIT_V(6); PG8_BAR;
    } else {
        PG8_STAGE(PG8_SB(0, 0), cB, voffB); PG8_STAGE(PG8_SA(0, 0), cA, voffA); PG8_STAGE(PG8_SB(0, 1), cB + hstep, voffB); PG8_STAGE(PG8_SA(0, 1), cA + hstep, voffA);
        if (wr == 1) PG8_BAR;
        PG8_WAIT_V(4); PG8_BAR;
        PG8_STAGE(PG8_SB(1, 0), cB + kstep, voffB); PG8_STAGE(PG8_SA(1, 0), cA + kstep, voffA); PG8_STAGE(PG8_SB(1, 1), cB + hstep + kstep, voffB);
        PG8_WAIT_V(6); PG8_BAR;
    }
    for (;;) {
        const bool has_next = S.next(ui + 1, nxt);
        const char* nA = has_next ? (const char*)g.A + (size_t)nxt.pm * tstep + (size_t)nxt.k0 * kstep : cA; const char* nB = has_next ? (const char*)g.Bt + (size_t)nxt.pn * tstep + (size_t)nxt.k0 * kstep : cB;
        const int ntc = cur.nk;
        for (int t = 0; t < ntc; t += 2) {
            const bool last = (t == ntc - 2);
            const char* a1 = cA + (size_t)(t + 1) * kstep;
            const char* a2 = last ? nA : cA + (size_t)(t + 2) * kstep; const char* b2 = last ? nB : cB + (size_t)(t + 2) * kstep;
            const char* a3 = a2 + kstep; const char* b3 = b2 + kstep;
            if (last && has_next) S.a_ready(nxt);
            if constexpr (SP2) {
            PG8_LDB(B0, 0, 0); PG8_LDB(B1, 0, 1); PG8_SCHED; PG8_LDA(At, 0, 0); PG8_STAGE(PG8_SA(1, 1), a1 + hstep, voffA);
            PG8_WAIT_V(8); PG8_WAIT_L(0); PG8_BAR; PG8_MMA(0, 0, At, B0); PG8_MMA(0, 1, At, B1); PG8_BAR; PG8_SCHED;
            PG8_LDA(At, 0, 1); PG8_STAGE(PG8_SB(0, 0), b2, voffB); PG8_STAGE(PG8_SB(0, 1), b2 + hstep, voffB); PG8_STAGE(PG8_SA(0, 0), a2, voffA);
            PG8_WAIT_V(8); PG8_WAIT_L(0); PG8_BAR; PG8_MMA(1, 0, At, B0); PG8_MMA(1, 1, At, B1); PG8_BAR; PG8_SCHED;
            PG8_LDB(B0, 1, 0); PG8_LDB(B1, 1, 1); PG8_SCHED; PG8_LDA(At, 1, 0); PG8_STAGE(PG8_SA(0, 1), a2 + hstep, voffA);
            PG8_WAIT_V(8); PG8_WAIT_L(0); PG8_BAR; PG8_MMA(0, 0, At, B0); PG8_MMA(0, 1, At, B1); PG8_BAR; PG8_SCHED;
            PG8_LDA(At, 1, 1); PG8_STAGE(PG8_SB(1, 0), b3, voffB); PG8_STAGE(PG8_SB(1, 1), b3 + hstep, voffB); PG8_STAGE(PG8_SA(1, 0), a3, voffA);
            PG8_WAIT_V(8); PG8_WAIT_L(0); PG8_BAR; PG8_MMA(1, 0, At, B0); PG8_MMA(1, 1, At, B1); PG8_BAR; PG8_SCHED;
            } else {
            PG8_LDB(B0, 0, 0); PG8_SCHED; PG8_LDA(At, 0, 0); PG8_STAGE(PG8_SA(1, 1), a1 + hstep, voffA);
            PG8_WAIT_L(8); PG8_BAR; PG8_WAIT_L(0); PG8_MMA(0, 0, At, B0); PG8_BAR; PG8_SCHED;
            PG8_LDB(B1, 0, 1); PG8_STAGE(PG8_SB(0, 0), b2, voffB);
            PG8_BAR; PG8_WAIT_L(0); PG8_MMA(0, 1, At, B1); PG8_BAR;
            PG8_LDA(At, 0, 1); PG8_STAGE(PG8_SA(0, 0), a2, voffA);
            PG8_BAR; PG8_WAIT_L(0); PG8_MMA(1, 0, At, B0); PG8_BAR; PG8_SCHED;
            PG8_STAGE(PG8_SB(0, 1), b2 + hstep, voffB);
            PG8_WAIT_V(6); PG8_BAR; PG8_MMA(1, 1, At, B1); PG8_BAR;
            PG8_LDB(B0, 1, 0); PG8_SCHED; PG8_LDA(At, 1, 0); PG8_STAGE(PG8_SA(0, 1), a2 + hstep, voffA);
            PG8_WAIT_L(8); PG8_BAR; PG8_WAIT_L(0); PG8_MMA(0, 0, At, B0); PG8_BAR; PG8_SCHED;
            PG8_LDB(B1, 1, 1); PG8_STAGE(PG8_SB(1, 0), b3, voffB);
            PG8_BAR; PG8_WAIT_L(0); PG8_MMA(0, 1, At, B1); PG8_BAR;
            PG8_LDA(At, 1, 1); PG8_STAGE(PG8_SA(1, 0), a3, voffA);
            PG8_BAR; PG8_WAIT_L(0); PG8_MMA(1, 0, At, B0); PG8_BAR; PG8_SCHED;
            PG8_STAGE(PG8_SB(1, 1), b3 + hstep, voffB);
            PG8_WAIT_V(6); PG8_BAR; PG8_MMA(1, 1, At, B1); PG8_BAR;
            }
        }
        if constexpr (ALIGN_EPI) { if (wr == 0) PG8_BAR; }
        if constexpr (!Epi::AFTER_DRAIN) { E(acc, cur, wr, wc, fr, fq); S.done(cur); }
        if (!has_next) break;
#pragma unroll
        for (int a = 0; a < 2; ++a)
#pragma unroll
            for (int b = 0; b < 2; ++b)
#pragma unroll
                for (int m = 0; m < 4; ++m)
#pragma unroll
                    for (int n = 0; n < 2; ++n) acc[a][b][m][n] = (f32x4){0.f, 0.f, 0.f, 0.f};
        cur = nxt; cA = nA; cB = nB; ++ui;
        if constexpr (ALIGN_EPI) { if (wr == 1) PG8_BAR; }
    }
    PG8_WAIT_V(0);
    if constexpr (!ALIGN_EPI) { if (wr == 0) PG8_BAR; }
    PG8_BAR;
    if constexpr (Epi::AFTER_DRAIN) { E.fused(acc, cur, wr, wc, fr, fq, lds, wid, lane); S.done(cur); }
#undef PG8_SA
#undef PG8_SB
#undef PG8_STAGE
#undef PG8_LDA
#undef PG8_LDB
#undef PG8_MMA
#undef PG8_WAIT_V
#undef PG8_WAIT_L
#undef PG8_BAR
#undef PG8_SCHED
}
}

constexpr int D = 4096, PBATCH = 4, PSEQ = 2048, MPROMPT = PBATCH * PSEQ, SBATCH = 32, SSEQ = 4, MSAMPLE = SBATCH * SSEQ;
constexpr int MREAL = MPROMPT + MSAMPLE;
constexpr int MPAD = 8448;
constexpr int NE = 5120;
constexpr int NO = 16384;
constexpr int FF = 11008, DM = 512;
constexpr float ALPHA = 1.41421356237309515f;
constexpr float LN_EPS = 1e-5f, RMS_EPS = 1e-6f;
constexpr int NWAVES = 8;

constexpr size_t MiB = 1u << 20;
constexpr size_t WS_CTL = 0, CTL_ZERO_BYTES = 1 * MiB;
constexpr size_t WS_AB = 1 * MiB;
constexpr size_t WS_BB = WS_AB + 65536;
constexpr size_t WS_BT = WS_BB + 1048576;
constexpr size_t WS_LB = WS_BT + 16384;
constexpr size_t WS_SSQ = WS_LB + 16384;
constexpr size_t WS_WEIN = 4 * MiB, WS_WGLU = 44 * MiB, WS_WEOUT = 52 * MiB, WS_WOIN = 84 * MiB, WS_WOOUT = 212 * MiB;
constexpr size_t WS_LAYER = 244 * MiB, LAYER_STRIDE = 274 * MiB;
constexpr size_t L_WMQ = 0, L_WMKV = 4 * MiB, L_WMO = 12 * MiB, L_WGU = 16 * MiB, L_WD = 188 * MiB;
constexpr size_t WS_X = 792 * MiB;
constexpr size_t WS_XN = 924 * MiB;
constexpr size_t WS_MIX = 990 * MiB;
constexpr size_t WS_QC = 1056 * MiB;
constexpr size_t WS_CO = 1065 * MiB;
constexpr size_t WS_MPB = 1074 * MiB;
constexpr size_t WS_KVM = 1082 * MiB;
constexpr size_t WS_HBIG = 1086 * MiB;
constexpr size_t WS_Z = WS_HBIG + 83 * MiB;
constexpr size_t WS_H1S = WS_HBIG + 264 * MiB;
constexpr size_t WS_HFS = WS_H1S + 32 * MiB;
constexpr size_t WS_END = WS_HFS + 44 * MiB;
static_assert((size_t)MPAD * NE * 2 <= 83 * MiB && (size_t)MPAD * NO * 2 <= 264 * MiB && WS_LAYER + 2 * LAYER_STRIDE == WS_X, "ws map");
constexpr int CW_TMO = 0, CW_CODE = 1, CW_BAR = 4096;

constexpr size_t O_Y = 0, O_PMK = 34078720, O_PMV = 35127296, O_PSK = 36175872, O_PSV = 36438016, O_PS5R = 36700160, O_PS5I = 36732928,
                 O_PHG = 36765696, O_SSK = 38862848, O_SSV = 40960000, O_SS5R = 43057152, O_SS5I = 43319296, O_SHG = 43581440, O_END = 60358656;

constexpr int RING_OFF = 0, RING_BYTES = 131072;
constexpr int LDS_BYTES = 147456;
constexpr int MISC_OFF = LDS_BYTES - 256;

#define GAS __attribute__((address_space(1)))
#define LAS __attribute__((address_space(3)))
#define DI __device__ __forceinline__
typedef unsigned short bf16;
typedef unsigned v4u __attribute__((ext_vector_type(4)));
typedef unsigned v2u __attribute__((ext_vector_type(2)));
typedef float f32x4 __attribute__((ext_vector_type(4)));
typedef float f32x2 __attribute__((ext_vector_type(2)));
typedef float f32x16 __attribute__((ext_vector_type(16)));
typedef short bf16x8 __attribute__((ext_vector_type(8)));
typedef GAS unsigned gu32;
#define RLX_AGENT __ATOMIC_RELAXED, __HIP_MEMORY_SCOPE_AGENT
#define LDS_WAIT() asm volatile("s_waitcnt lgkmcnt(0)" ::: "memory")
#define VM_WAIT() asm volatile("s_waitcnt vmcnt(0)" ::: "memory")
typedef __bf16 bf16x2_t __attribute__((ext_vector_type(2)));
DI unsigned pk2(float lo, float hi) { f32x2 v = {lo, hi}; bf16x2_t b = __builtin_convertvector(v, bf16x2_t); return __builtin_bit_cast(unsigned, b); }
DI float bflo(unsigned w) { return __uint_as_float(w << 16); }
DI float bfhi(unsigned w) { return __uint_as_float(w & 0xffff0000u); }
DI float bf2f(bf16 v) { return __uint_as_float(((unsigned)v) << 16); }
DI float wave_sum(float v) {
#pragma unroll
    for (int o = 1; o < 64; o <<= 1) v += __shfl_xor(v, o);
    return v;
}
DI float wave_max(float v) {
#pragma unroll
    for (int o = 1; o < 64; o <<= 1) v = fmaxf(v, __shfl_xor(v, o));
    return v;
}
DI float sigmoidf_(float x) { return __builtin_amdgcn_rcpf(1.0f + __expf(-x)); }
DI int crow(int reg, int h) { return (reg & 3) + 8 * (reg >> 2) + 4 * h; }
#define MFMA32(a, b, c) __builtin_amdgcn_mfma_f32_32x32x16_bf16((a), (b), (c), 0, 0, 0)

#define XB_TMO      128
#define XB_XCNT(j)  (256  + 64 * (j))
#define XB_XSUB(j)  (1280 + 64 * (j))
#define XB_XGEN(j)  (2304 + 64 * (j))
#define XB_TOP      3328
#define XB_TOPGEN   3392
#define XCD_BAR_WORDS 3456
#define XB_SPIN_CAP (1u << 18)

__device__ __forceinline__ unsigned xb_ld(unsigned* p)              { return __hip_atomic_load(p, __ATOMIC_RELAXED, __HIP_MEMORY_SCOPE_AGENT); }
__device__ __forceinline__ unsigned xb_add(unsigned* p, unsigned v) { return __hip_atomic_fetch_add(p, v, __ATOMIC_RELAXED, __HIP_MEMORY_SCOPE_AGENT); }
__device__ __forceinline__ unsigned xb_xcc_id() { return (unsigned)__builtin_amdgcn_s_getreg((3 << 11) | 20) & 0xFu; }
#define XB_SPIN(cond, bar) do { unsigned _sp = 0; while (cond) { __builtin_amdgcn_s_sleep(1); \
    if ((++_sp & 255u) == 0u) { if (xb_ld(&(bar)[XB_TMO])) break; if (_sp > XB_SPIN_CAP) { atomicAdd(&(bar)[XB_TMO], 1u); break; } } } } while (0)

struct XcdBarrier {
    unsigned* bar; unsigned x;
    volatile LAS unsigned* st;
};

__device__ __forceinline__ XcdBarrier xcd_barrier_post(unsigned* bar, volatile LAS unsigned* st) {
    XcdBarrier b; b.bar = bar; b.x = xb_xcc_id(); b.st = st;
    if (threadIdx.x == 0) (void)xb_add(&bar[XB_XCNT(b.x)], 1u);
    return b;
}
__device__ __forceinline__ void xcd_barrier_complete(unsigned* bar, unsigned x, unsigned& nloc, unsigned& nx) {
    const unsigned G = gridDim.x * gridDim.y * gridDim.z;
    unsigned sum, cnt, mine, sp = 0u;
    for (;;) {
        sum = 0u; cnt = 0u; mine = 0u;
#pragma unroll
        for (unsigned j = 0; j < 16; ++j) { const unsigned c = xb_ld(&bar[XB_XCNT(j)]); sum += c; cnt += (c > 0u) ? 1u : 0u; mine = (j == x) ? c : mine; }
        if (sum == G) break;
        __builtin_amdgcn_s_sleep(1);
        if ((++sp & 255u) == 0u) { if (xb_ld(&bar[XB_TMO])) break; if (sp > XB_SPIN_CAP) { atomicAdd(&bar[XB_TMO], 1u); break; } }
    }
    nloc = mine > 0u ? mine : 1u; nx = cnt > 0u ? cnt : 1u;
}

__device__ __forceinline__ void xcd_barrier(const XcdBarrier& b) {
    asm volatile("s_waitcnt vmcnt(0)" ::: "memory");
    __syncthreads();
    if (threadIdx.x == 0) {
        unsigned* bar = b.bar;
        __builtin_amdgcn_s_waitcnt(0);
        unsigned nloc = b.st[0], nx = b.st[1];
        if (nloc == 0u) { xcd_barrier_complete(bar, b.x, nloc, nx); b.st[0] = nloc; b.st[1] = nx; }
        const unsigned old = xb_add(&bar[XB_XSUB(b.x)], 1u);
        const unsigned gen = old / nloc;
        if (old + 1u == (gen + 1u) * nloc) {
            __builtin_amdgcn_fence(__ATOMIC_RELEASE, "agent");
            asm volatile("s_waitcnt vmcnt(0)" ::: "memory");
            const unsigned og = xb_add(&bar[XB_TOP], 1u);
            const unsigned tg = og / nx;
            if (og + 1u == (tg + 1u) * nx) xb_add(&bar[XB_TOPGEN], 1u);
            else XB_SPIN(xb_ld(&bar[XB_TOPGEN]) == tg, bar);
            __builtin_amdgcn_fence(__ATOMIC_ACQUIRE, "agent");
            xb_add(&bar[XB_XGEN(b.x)], 1u);
            asm volatile("s_waitcnt vmcnt(0)" ::: "memory");
        } else {
            XB_SPIN(xb_ld(&bar[XB_XGEN(b.x)]) == gen, bar);
            __builtin_amdgcn_fence(__ATOMIC_ACQUIRE, "agent");
            asm volatile("s_waitcnt vmcnt(0)" ::: "memory");
        }
    }
    __syncthreads();
}

struct EpiStoreBf16 {
    static constexpr bool PERM = true, AFTER_DRAIN = false;
    bf16* O; int ldc;
    DI void operator()(const f32x4 (&acc)[2][2][4][2], const pg8::Unit& u, int wr, int wc, int fr, int fq) const {
        const int row0 = u.pm * 256 + wr * 64 + fr, col0 = u.pn * 256 + wc * 32 + 8 * fq;
#pragma unroll
        for (int ai = 0; ai < 2; ++ai)
#pragma unroll
            for (int m = 0; m < 4; ++m) { bf16* rowp = O + (size_t)(row0 + ai * 128 + m * 16) * ldc + col0;
#pragma unroll
                for (int bj = 0; bj < 2; ++bj) { const f32x4 v0 = acc[ai][bj][m][0], v1 = acc[ai][bj][m][1];
                    v4u w; w.x = pk2(v0[0], v0[1]); w.y = pk2(v0[2], v0[3]); w.z = pk2(v1[0], v1[1]); w.w = pk2(v1[2], v1[3]);
                    *(v4u*)(rowp + bj * 128) = w; } }
    }
};
struct EpiMemKV {
    static constexpr bool PERM = false, AFTER_DRAIN = false;
    float* outk; float* outv; bf16* kvm;
    DI void operator()(const f32x4 (&acc)[2][2][4][2], const pg8::Unit& u, int wr, int wc, int fr, int fq) const {
        const int row0 = u.pm * 256 + wr * 64 + fr, col0 = u.pn * 256 + wc * 32 + 4 * fq;
        float* obase = (u.pn < 2) ? outk : outv; const int ocol0 = col0 - ((u.pn < 2) ? 0 : 512);
#pragma unroll
        for (int ai = 0; ai < 2; ++ai)
#pragma unroll
            for (int m = 0; m < 4; ++m) { const int row = row0 + ai * 128 + m * 16;
#pragma unroll
                for (int bj = 0; bj < 2; ++bj)
#pragma unroll
                    for (int n = 0; n < 2; ++n) { const f32x4 v = acc[ai][bj][m][n]; const int cc = bj * 128 + n * 16;
                        *(f32x4*)(obase + (size_t)row * 512 + ocol0 + cc) = v;
                        v2u w; w.x = pk2(v[0], v[1]); w.y = pk2(v[2], v[3]);
                        *(v2u*)(kvm + (size_t)row * 1024 + col0 + cc) = w; } }
    }
};
struct EpiGlu {
    static constexpr bool PERM = true, AFTER_DRAIN = false;
    const bf16* Z; bf16* O;
    DI void operator()(const f32x4 (&acc)[2][2][4][2], const pg8::Unit& u, int wr, int wc, int fr, int fq) const {
        const int row0 = u.pm * 256 + wr * 64 + fr, col0 = u.pn * 256 + wc * 32 + 8 * fq;
#pragma unroll
        for (int ai = 0; ai < 2; ++ai)
#pragma unroll
            for (int m = 0; m < 4; ++m) { const int row = row0 + ai * 128 + m * 16;
#pragma unroll
                for (int bj = 0; bj < 2; ++bj) { const f32x4 v0 = acc[ai][bj][m][0], v1 = acc[ai][bj][m][1];
                    const v4u z = *(const v4u*)(Z + (size_t)row * 2048 + col0 + bj * 128);
                    v4u w;
                    w.x = pk2(bflo(z.x) * sigmoidf_(v0[0]), bfhi(z.x) * sigmoidf_(v0[1]));
                    w.y = pk2(bflo(z.y) * sigmoidf_(v0[2]), bfhi(z.y) * sigmoidf_(v0[3]));
                    w.z = pk2(bflo(z.z) * sigmoidf_(v1[0]), bfhi(z.z) * sigmoidf_(v1[1]));
                    w.w = pk2(bflo(z.w) * sigmoidf_(v1[2]), bfhi(z.w) * sigmoidf_(v1[3]));
                    *(v4u*)(O + (size_t)row * 4096 + col0 + bj * 128) = w; } }
    }
};
struct EpiRes {
    static constexpr bool PERM = true, AFTER_DRAIN = false;
    bf16* T; const bf16* XN; const float* ssq; float* part;
    DI void operator()(const f32x4 (&acc)[2][2][4][2], const pg8::Unit& u, int wr, int wc, int fr, int fq) const {
        const int row0 = u.pm * 256 + wr * 64 + fr, col0 = u.pn * 256 + wc * 32 + 8 * fq;
        if (u.ks < 0) {
#pragma unroll
            for (int ai = 0; ai < 2; ++ai)
#pragma unroll
                for (int m = 0; m < 4; ++m) { const int row = row0 + ai * 128 + m * 16;
                    float rs = 1.0f; if (ssq) rs = 1.0f / sqrtf(ssq[row] * (1.0f / 4096.0f) + RMS_EPS);
                    const size_t off = (size_t)row * D + col0;
                    v4u x[2];
#pragma unroll
                    for (int bj = 0; bj < 2; ++bj) x[bj] = *(const v4u*)(XN + off + bj * 128);
#pragma unroll
                    for (int bj = 0; bj < 2; ++bj) { const f32x4 a0 = acc[ai][bj][m][0] * rs, a1 = acc[ai][bj][m][1] * rs; v4u w;
                        w.x = pk2(bflo(x[bj].x) * ALPHA + a0[0], bfhi(x[bj].x) * ALPHA + a0[1]); w.y = pk2(bflo(x[bj].y) * ALPHA + a0[2], bfhi(x[bj].y) * ALPHA + a0[3]);
                        w.z = pk2(bflo(x[bj].z) * ALPHA + a1[0], bfhi(x[bj].z) * ALPHA + a1[1]); w.w = pk2(bflo(x[bj].w) * ALPHA + a1[2], bfhi(x[bj].w) * ALPHA + a1[3]);
                        *(v4u*)(T + off + bj * 128) = w; } }
        } else {
            float* pb = part + (size_t)u.ks * MSAMPLE * D;
#pragma unroll
            for (int m = 0; m < 4; ++m) { const int row = row0 + m * 16;
                float rs = 1.0f; if (ssq) rs = 1.0f / sqrtf(ssq[row] * (1.0f / 4096.0f) + RMS_EPS);
                const size_t off = (size_t)(row - MPROMPT) * D + col0;
#pragma unroll
                for (int bj = 0; bj < 2; ++bj) { *(f32x4*)(pb + off + bj * 128) = acc[0][bj][m][0] * rs; *(f32x4*)(pb + off + bj * 128 + 4) = acc[0][bj][m][1] * rs; } }
        }
    }
};
struct EpiGU {
    static constexpr bool PERM = true, AFTER_DRAIN = false;
    bf16* O; float* slab;
    DI void operator()(const f32x4 (&acc)[2][2][4][2], const pg8::Unit& u, int wr, int wc, int fr, int fq) const {
        if (u.ks >= 0) {
            float* sb = slab + (size_t)u.ks * MSAMPLE * (2 * FF); const int c0 = u.pn * 256 + wc * 32 + 8 * fq;
#pragma unroll
            for (int m = 0; m < 4; ++m) { const int row = wr * 64 + m * 16 + fr;
#pragma unroll
                for (int bj = 0; bj < 2; ++bj) { *(f32x4*)(sb + (size_t)row * (2 * FF) + c0 + bj * 128) = acc[0][bj][m][0]; *(f32x4*)(sb + (size_t)row * (2 * FF) + c0 + bj * 128 + 4) = acc[0][bj][m][1]; } }
            return;
        }
        const int row0 = u.pm * 256 + wr * 64 + fr, col0 = u.pn * 128 + wc * 32 + 8 * fq;
#pragma unroll
        for (int ai = 0; ai < 2; ++ai)
#pragma unroll
            for (int m = 0; m < 4; ++m) { const int row = row0 + ai * 128 + m * 16;
                const f32x4 g0 = acc[ai][0][m][0], g1 = acc[ai][0][m][1], u0 = acc[ai][1][m][0], u1 = acc[ai][1][m][1];
                v4u w;
                w.x = pk2(g0[0] * sigmoidf_(g0[0]) * u0[0], g0[1] * sigmoidf_(g0[1]) * u0[1]);
                w.y = pk2(g0[2] * sigmoidf_(g0[2]) * u0[2], g0[3] * sigmoidf_(g0[3]) * u0[3]);
                w.z = pk2(g1[0] * sigmoidf_(g1[0]) * u1[0], g1[1] * sigmoidf_(g1[1]) * u1[1]);
                w.w = pk2(g1[2] * sigmoidf_(g1[2]) * u1[2], g1[3] * sigmoidf_(g1[3]) * u1[3]);
                *(v4u*)(O + (size_t)row * FF + col0) = w; }
    }
};
struct EpiOddIn {
    static constexpr bool PERM = true, AFTER_DRAIN = false;
    bf16* O; const float* lb; float* slab;
    DI float act(float v, int type, float l) const {
        if (type == 0) return v * sigmoidf_(v);
        if (type == 1) return __logf(l + (1.0f - l) * sigmoidf_(v));
        if (type == 2) return v;
        return sigmoidf_(v);
    }
    DI void operator()(const f32x4 (&acc)[2][2][4][2], const pg8::Unit& u, int wr, int wc, int fr, int fq) const {
        const int row0 = u.pm * 256 + wr * 64 + fr, col0 = u.pn * 256 + wc * 32 + 8 * fq;
        if (u.ks >= 0) {
            float* sb = slab + (size_t)u.ks * MSAMPLE * NO;
#pragma unroll
            for (int m = 0; m < 4; ++m) { const int row = wr * 64 + m * 16 + fr;
#pragma unroll
                for (int bj = 0; bj < 2; ++bj) { *(f32x4*)(sb + (size_t)row * NO + col0 + bj * 128) = acc[0][bj][m][0]; *(f32x4*)(sb + (size_t)row * NO + col0 + bj * 128 + 4) = acc[0][bj][m][1]; } }
            return;
        }
        const int type = u.pn >> 4;
        float lbv[2][8];
#pragma unroll
        for (int bj = 0; bj < 2; ++bj)
#pragma unroll
            for (int e = 0; e < 8; ++e) lbv[bj][e] = (type == 1) ? lb[(col0 + bj * 128 + e) & 4095] : 0.f;
#pragma unroll
        for (int ai = 0; ai < 2; ++ai)
#pragma unroll
            for (int m = 0; m < 4; ++m) { const int row = row0 + ai * 128 + m * 16;
#pragma unroll
                for (int bj = 0; bj < 2; ++bj) { const f32x4 v0 = acc[ai][bj][m][0], v1 = acc[ai][bj][m][1];
                    v4u w;
                    w.x = pk2(act(v0[0], type, lbv[bj][0]), act(v0[1], type, lbv[bj][1]));
                    w.y = pk2(act(v0[2], type, lbv[bj][2]), act(v0[3], type, lbv[bj][3]));
                    w.z = pk2(act(v1[0], type, lbv[bj][4]), act(v1[1], type, lbv[bj][5]));
                    w.w = pk2(act(v1[2], type, lbv[bj][6]), act(v1[3], type, lbv[bj][7]));
                    *(v4u*)(O + (size_t)row * NO + col0 + bj * 128) = w; } }
    }
};

struct EpiSlab {
    static constexpr bool PERM = false, AFTER_DRAIN = false;
    float* P; float* S;
    DI void operator()(const f32x4 (&acc)[2][2][4][2], const pg8::Unit& u, int wr, int wc, int fr, int fq) const {
        const int col0 = u.pn * 256 + wc * 32 + 4 * fq;
        if (u.pm < 32) {
            float* pb = P + (size_t)u.ks * MPROMPT * DM;
#pragma unroll
            for (int ai = 0; ai < 2; ++ai)
#pragma unroll
                for (int m = 0; m < 4; ++m) { const int row = u.pm * 256 + ai * 128 + wr * 64 + m * 16 + fr;
#pragma unroll
                    for (int bj = 0; bj < 2; ++bj)
#pragma unroll
                        for (int n = 0; n < 2; ++n) *(f32x4*)(pb + (size_t)row * DM + col0 + bj * 128 + n * 16) = acc[ai][bj][m][n]; }
        } else {
            float* sb = S + (size_t)u.ks * MSAMPLE * DM;
#pragma unroll
            for (int m = 0; m < 4; ++m) { const int row = wr * 64 + m * 16 + fr;
#pragma unroll
                for (int bj = 0; bj < 2; ++bj)
#pragma unroll
                    for (int n = 0; n < 2; ++n) *(f32x4*)(sb + (size_t)row * DM + col0 + bj * 128 + n * 16) = acc[0][bj][m][n]; }
        }
    }
};

DI void ffn_act_sample(const float* slab, bf16* HF, int gt, int NGT) {
    constexpr size_t ST = (size_t)MSAMPLE * (2 * FF);
    for (int e = gt; e < MSAMPLE * (FF / 4); e += NGT) {
        const int r = e / (FF / 4), j0 = 4 * (e % (FF / 4));
        const float* p = slab + (size_t)r * (2 * FF) + 256 * (j0 >> 7) + (j0 & 127);
        f32x4 g4 = {0.f, 0.f, 0.f, 0.f}, u4 = g4;
#pragma unroll
        for (int sl = 0; sl < 4; ++sl) { g4 += *(const f32x4*)(p + sl * ST); u4 += *(const f32x4*)(p + sl * ST + 128); }
        v2u w; w.x = pk2(g4[0] * sigmoidf_(g4[0]) * u4[0], g4[1] * sigmoidf_(g4[1]) * u4[1]); w.y = pk2(g4[2] * sigmoidf_(g4[2]) * u4[2], g4[3] * sigmoidf_(g4[3]) * u4[3]);
        *(v2u*)(HF + (size_t)(MPROMPT + r) * FF + j0) = w;
    }
}

DI void transpose_item(const float* __restrict__ W, int K, int N, int k0, int n0, bf16* WT, int drow0, LAS unsigned char* scr, int lane) {
    const int g = lane >> 4, q = lane & 15;
    const float* src = W + (size_t)(k0 + 16 * g) * N + n0 + 4 * q;
    f32x4 v[16];
#pragma unroll
    for (int i = 0; i < 16; ++i) v[i] = __builtin_nontemporal_load((const f32x4*)(src + (size_t)i * N));
#pragma unroll
    for (int e = 0; e < 4; ++e) {
        v4u lo, hi;
        lo.x = pk2(v[0][e], v[1][e]); lo.y = pk2(v[2][e], v[3][e]); lo.z = pk2(v[4][e], v[5][e]); lo.w = pk2(v[6][e], v[7][e]);
        hi.x = pk2(v[8][e], v[9][e]); hi.y = pk2(v[10][e], v[11][e]); hi.z = pk2(v[12][e], v[13][e]); hi.w = pk2(v[14][e], v[15][e]);
        LAS unsigned char* t = scr + (4 * q + e) * 136 + 32 * g;
        *(LAS v2u*)(t) = (v2u){lo.x, lo.y}; *(LAS v2u*)(t + 8) = (v2u){lo.z, lo.w}; *(LAS v2u*)(t + 16) = (v2u){hi.x, hi.y}; *(LAS v2u*)(t + 24) = (v2u){hi.z, hi.w};
    }
    LDS_WAIT(); asm volatile("" ::: "memory");
    const int c = lane & 7, rr = lane >> 3;
#pragma unroll
    for (int j = 0; j < 8; ++j) { const int n = rr + 8 * j; const LAS unsigned char* t = scr + n * 136 + 16 * c;
        const v2u a = *(const LAS v2u*)t, b = *(const LAS v2u*)(t + 8);
        *(GAS v4u*)(WT + (size_t)(drow0 + n) * K + k0 + 8 * c) = (v4u){a.x, a.y, b.x, b.y}; }
    LDS_WAIT(); asm volatile("" ::: "memory");
}
DI int map_row(int n0, int mode) { return mode == 0 ? n0 : (mode == 1 ? 256 * (n0 >> 7) + (n0 & 127) : (mode == 2 ? 256 * (n0 >> 7) + 128 + (n0 & 127) : n0 + 512)); }
struct CvtItem { const float* src; bf16* dst; int N, K; };
DI void cvt_load(const CvtItem& I, f32x4 (&v)[16], int lane) {
    const float* src = I.src + (size_t)(16 * (lane >> 4)) * I.N + 4 * (lane & 15);
#pragma unroll
    for (int i = 0; i < 16; ++i) v[i] = __builtin_nontemporal_load((const f32x4*)(src + (size_t)i * I.N));
}
DI void cvt_finish(const CvtItem& I, const f32x4 (&v)[16], LAS unsigned char* scr, int lane) {
    const int g = lane >> 4, q = lane & 15;
#pragma unroll
    for (int e = 0; e < 4; ++e) {
        v4u lo, hi;
        lo.x = pk2(v[0][e], v[1][e]); lo.y = pk2(v[2][e], v[3][e]); lo.z = pk2(v[4][e], v[5][e]); lo.w = pk2(v[6][e], v[7][e]);
        hi.x = pk2(v[8][e], v[9][e]); hi.y = pk2(v[10][e], v[11][e]); hi.z = pk2(v[12][e], v[13][e]); hi.w = pk2(v[14][e], v[15][e]);
        LAS unsigned char* t = scr + (4 * q + e) * 136 + 32 * g;
        *(LAS v2u*)(t) = (v2u){lo.x, lo.y}; *(LAS v2u*)(t + 8) = (v2u){lo.z, lo.w}; *(LAS v2u*)(t + 16) = (v2u){hi.x, hi.y}; *(LAS v2u*)(t + 24) = (v2u){hi.z, hi.w};
    }
    LDS_WAIT(); asm volatile("" ::: "memory");
    const int c = lane & 7, rr = lane >> 3;
#pragma unroll
    for (int j = 0; j < 8; ++j) { const int n = rr + 8 * j; const LAS unsigned char* t = scr + n * 136 + 16 * c;
        const v2u a = *(const LAS v2u*)t, b = *(const LAS v2u*)(t + 8);
        *(GAS v4u*)(I.dst + (size_t)n * I.K + 8 * c) = (v4u){a.x, a.y, b.x, b.y}; }
    LDS_WAIT(); asm volatile("" ::: "memory");
}
#define CVT_MAT(Wp, K_, N_, WTp, mode) { const int cnt_ = ((K_) / 64) * ((N_) / 64); if (r >= 0 && r < cnt_) { const int nblk_ = (N_) / 64, kb_ = r / nblk_, nb_ = r % nblk_; \
        I.src = (Wp) + (size_t)(64 * kb_) * (N_) + 64 * nb_; I.dst = (WTp) + (size_t)map_row(64 * nb_, (mode)) * (K_) + 64 * kb_; I.N = (N_); I.K = (K_); } r -= cnt_; }
#define P0_MAT(Wp, K_, N_, WTp, mode) { const int cnt_ = ((K_) / 64) * ((N_) / 64); if (r < cnt_) { const int kblk_ = (K_) / 64, nb_ = r / kblk_, kb_ = r % kblk_; \
        transpose_item((Wp), (K_), (N_), 64 * kb_, 64 * nb_, (WTp), map_row(64 * nb_, (mode)), scr, lane); continue; } r -= cnt_; }

DI void ln_row(const bf16* tin, const float* part, int npart, const float* g, const float* b, float* yout, bf16* xn, int lane, float yscale = 1.0f) {
    f32x4 v[8][2]; float s = 0.f;
    { const GAS v4u* xr = (const GAS v4u*)(tin ? tin : xn) + lane; const float sc = tin ? 1.0f : ALPHA;
#pragma unroll
      for (int j = 0; j < 8; ++j) { const v4u w = xr[64 * j]; v[j][0] = (f32x4){bflo(w.x), bfhi(w.x), bflo(w.y), bfhi(w.y)} * sc; v[j][1] = (f32x4){bflo(w.z), bfhi(w.z), bflo(w.w), bfhi(w.w)} * sc; } }
    if (!tin) {
#pragma unroll 1
        for (int p = 0; p < npart; p += 4) {
            const GAS f32x4* pr = (const GAS f32x4*)(part + (size_t)p * MSAMPLE * D) + 2 * lane; constexpr size_t PS = (size_t)MSAMPLE * D / 4;
#pragma unroll
            for (int j = 0; j < 8; ++j) {
#pragma unroll
                for (int hh = 0; hh < 2; ++hh) { const f32x4 a0 = pr[128 * j + hh], a1 = pr[PS + 128 * j + hh], a2 = pr[2 * PS + 128 * j + hh], a3 = pr[3 * PS + 128 * j + hh]; v[j][hh] += (a0 + a1) + (a2 + a3); }
                if ((j & 1) == 1) __builtin_amdgcn_sched_barrier(0); } }
    }
#pragma unroll
    for (int j = 0; j < 8; ++j) s += ((v[j][0].x + v[j][0].y) + (v[j][0].z + v[j][0].w)) + ((v[j][1].x + v[j][1].y) + (v[j][1].z + v[j][1].w));
    const float mean = wave_sum(s) * (1.f / D); float s2 = 0.f;
#pragma unroll
    for (int j = 0; j < 8; ++j)
#pragma unroll
        for (int hh = 0; hh < 2; ++hh) { v[j][hh] = v[j][hh] - mean; s2 += (v[j][hh].x * v[j][hh].x + v[j][hh].y * v[j][hh].y) + (v[j][hh].z * v[j][hh].z + v[j][hh].w * v[j][hh].w); }
    const float rstd = 1.f / sqrtf(wave_sum(s2) * (1.f / D) + LN_EPS);
    GAS f32x4* o4 = (GAS f32x4*)yout + 2 * lane;
    GAS v4u* o8 = (GAS v4u*)xn + lane;
#pragma unroll
    for (int j = 0; j < 8; ++j) {
        const GAS f32x4* gp = (const GAS f32x4*)g + 2 * lane + 128 * j; const GAS f32x4* bp = (const GAS f32x4*)b + 2 * lane + 128 * j;
        const f32x4 y0 = v[j][0] * rstd * gp[0] + bp[0], y1 = v[j][1] * rstd * gp[1] + bp[1];
        if (yout) { o4[128 * j] = y0 * yscale; o4[128 * j + 1] = y1 * yscale; }
        else { v4u w; w.x = pk2(y0.x, y0.y); w.y = pk2(y0.z, y0.w); w.z = pk2(y1.x, y1.y); w.w = pk2(y1.z, y1.w); o8[64 * j] = w; }
    }
}
DI void ln_rows_prompt(LAS unsigned char* lds, const bf16* T, float* yout, bf16* XN, int gw, int NGW, int lane) {
    const LAS f32x4* gl = (const LAS f32x4*)lds + 2 * lane; const LAS f32x4* bl = (const LAS f32x4*)(lds + 16384) + 2 * lane;
    v4u w[8];
    if (gw < MPROMPT) { const GAS v4u* xr = (const GAS v4u*)(T + (size_t)gw * D) + lane;
#pragma unroll
        for (int j = 0; j < 8; ++j) w[j] = xr[64 * j]; }
#pragma unroll 1
    for (int m = gw; m < MPROMPT; m += NGW) {
        f32x4 v[8][2]; float s = 0.f;
#pragma unroll
        for (int j = 0; j < 8; ++j) { v[j][0] = (f32x4){bflo(w[j].x), bfhi(w[j].x), bflo(w[j].y), bfhi(w[j].y)}; v[j][1] = (f32x4){bflo(w[j].z), bfhi(w[j].z), bflo(w[j].w), bfhi(w[j].w)}; }
        { const int mn = (m + NGW < MPROMPT) ? m + NGW : m;
          const GAS v4u* xr = (const GAS v4u*)(T + (size_t)mn * D) + lane;
#pragma unroll
          for (int j = 0; j < 8; ++j) w[j] = xr[64 * j]; }
#pragma unroll
        for (int j = 0; j < 8; ++j) s += ((v[j][0].x + v[j][0].y) + (v[j][0].z + v[j][0].w)) + ((v[j][1].x + v[j][1].y) + (v[j][1].z + v[j][1].w));
        const float mean = wave_sum(s) * (1.f / D); float s2 = 0.f;
#pragma unroll
        for (int j = 0; j < 8; ++j)
#pragma unroll
            for (int hh = 0; hh < 2; ++hh) { v[j][hh] = v[j][hh] - mean; s2 += (v[j][hh].x * v[j][hh].x + v[j][hh].y * v[j][hh].y) + (v[j][hh].z * v[j][hh].z + v[j][hh].w * v[j][hh].w); }
        const float rstd = 1.f / sqrtf(wave_sum(s2) * (1.f / D) + LN_EPS);
        if (yout) { GAS f32x4* o4 = (GAS f32x4*)(yout + (size_t)m * D) + 2 * lane;
#pragma unroll
            for (int j = 0; j < 8; ++j) { o4[128 * j] = v[j][0] * rstd * gl[128 * j] + bl[128 * j]; o4[128 * j + 1] = v[j][1] * rstd * gl[128 * j + 1] + bl[128 * j + 1]; if (j & 1) __builtin_amdgcn_sched_barrier(0); }
        } else { GAS v4u* o8 = (GAS v4u*)(XN + (size_t)m * D) + lane;
#pragma unroll
            for (int j = 0; j < 8; ++j) { const f32x4 y0 = v[j][0] * rstd * gl[128 * j] + bl[128 * j], y1 = v[j][1] * rstd * gl[128 * j + 1] + bl[128 * j + 1];
                v4u o; o.x = pk2(y0.x, y0.y); o.y = pk2(y0.z, y0.w); o.z = pk2(y1.x, y1.y); o.w = pk2(y1.z, y1.w); o8[64 * j] = o; if (j & 1) __builtin_amdgcn_sched_barrier(0); }
        }
    }
}
DI void ln_phase(LAS unsigned char* lds, const bf16* T, const float* part, int npart, const float* g, const float* b, float* yout, bf16* XN, int gw, int NGW, int lane, float yscale_sample = 1.0f) {
    { const int tid_ = (gw & 7) * 64 + lane;
#pragma unroll
      for (int i = 0; i < 2; ++i) { *(LAS f32x4*)(lds + (tid_ + 512 * i) * 16) = ((const GAS f32x4*)g)[tid_ + 512 * i]; *(LAS f32x4*)(lds + 16384 + (tid_ + 512 * i) * 16) = ((const GAS f32x4*)b)[tid_ + 512 * i]; } }
    { const int wg = gw >> 3, nwg = NGW >> 3, j = nwg - 1 - wg;
      if ((gw & 7) == 0) for (int m = MPROMPT + j; m < MREAL; m += nwg)
          ln_row(nullptr, part + (size_t)(m - MPROMPT) * D, npart, g, b, yout ? yout + (size_t)m * D : nullptr, XN + (size_t)m * D, lane, yscale_sample); }
    LDS_WAIT(); __syncthreads();
    ln_rows_prompt(lds, T, yout, XN, gw, NGW, lane);
}
DI void copy_row(const float* src, float* xout, float oscale, bf16* xnout, int lane) {
    GAS f32x4* o4 = xout ? (GAS f32x4*)xout + lane : nullptr; GAS v2u* o8 = (GAS v2u*)xnout + lane;
#pragma unroll
    for (int j = 0; j < 16; ++j) {
        f32x4 y = {0.f, 0.f, 0.f, 0.f}; if (src) y = ((const GAS f32x4*)src)[lane + 64 * j];
        if (xout) o4[64 * j] = y * oscale;
        v2u w; w.x = pk2(y.x, y.y); w.y = pk2(y.z, y.w); o8[64 * j] = w;
    }
}

DI float reduce16(float (&v)[16], int lane) {
    const bool b5 = (lane & 32) != 0, b4 = (lane & 16) != 0, b3 = (lane & 8) != 0, b2 = (lane & 4) != 0;
#pragma unroll
    for (int i = 0; i < 8; ++i) { const float send = b5 ? v[i] : v[i + 8], keep = b5 ? v[i + 8] : v[i]; v[i] = keep + __shfl_xor(send, 32); }
#pragma unroll
    for (int i = 0; i < 4; ++i) { const float send = b4 ? v[i] : v[i + 4], keep = b4 ? v[i + 4] : v[i]; v[i] = keep + __shfl_xor(send, 16); }
#pragma unroll
    for (int i = 0; i < 2; ++i) { const float send = b3 ? v[i] : v[i + 2], keep = b3 ? v[i + 2] : v[i]; v[i] = keep + __shfl_xor(send, 8); }
    { const float send = b2 ? v[0] : v[1], keep = b2 ? v[1] : v[0]; v[0] = keep + __shfl_xor(send, 4); }
    v[0] += __shfl_xor(v[0], 2); v[0] += __shfl_xor(v[0], 1);
    return v[0];
}
DI int idx16(int lane) { return ((lane >> 5) & 1) * 8 + ((lane >> 4) & 1) * 4 + ((lane >> 3) & 1) * 2 + ((lane >> 2) & 1); }
DI float gelu_tanh(float x) { const float u = 0.7978845608028654f * (x + 0.044715f * x * x * x); const float t = 1.0f - 2.0f * __builtin_amdgcn_rcpf(1.0f + __expf(2.0f * u)); return 0.5f * x * (1.0f + t); }

struct S5Par { float ar, ai; float bbr[16], bbi[16], cr[16], ci[16]; float dsel; int hidx; };

template <bool WITH_Y>
DI void s5_block(const bf16* urows, int ntok, LAS float* ubuf, LAS float* ybuf, bf16* zrows, int lane, const S5Par& P, float& hr, float& hi) {
    if (lane < ntok) {
        const v4u a = *(const v4u*)(urows + (size_t)lane * NE), b = *(const v4u*)(urows + (size_t)lane * NE + 8);
        LAS f32x4* w = (LAS f32x4*)(ubuf + lane * 16);
        w[0] = (f32x4){bflo(a.x), bfhi(a.x), bflo(a.y), bfhi(a.y)}; w[1] = (f32x4){bflo(a.z), bfhi(a.z), bflo(a.w), bfhi(a.w)};
        w[2] = (f32x4){bflo(b.x), bfhi(b.x), bflo(b.y), bfhi(b.y)}; w[3] = (f32x4){bflo(b.z), bfhi(b.z), bflo(b.w), bfhi(b.w)};
    }
    LDS_WAIT(); asm volatile("" ::: "memory");
#pragma unroll 4
    for (int t = 0; t < ntok; ++t) {
        const LAS f32x4* up = (const LAS f32x4*)(ubuf + t * 16);
        const f32x4 u0 = up[0], u1 = up[1], u2 = up[2], u3 = up[3];
        const float u[16] = {u0.x, u0.y, u0.z, u0.w, u1.x, u1.y, u1.z, u1.w, u2.x, u2.y, u2.z, u2.w, u3.x, u3.y, u3.z, u3.w};
        float bur = 0.f, bui = 0.f;
#pragma unroll
        for (int h = 0; h < 16; ++h) { bur += P.bbr[h] * u[h]; bui += P.bbi[h] * u[h]; }
        const float nhr = P.ar * hr - P.ai * hi + bur, nhi = P.ar * hi + P.ai * hr + bui;
        hr = nhr; hi = nhi;
        if (WITH_Y) {
            float v[16];
#pragma unroll
            for (int h = 0; h < 16; ++h) v[h] = P.cr[h] * hr - P.ci[h] * hi;
            const float y = reduce16(v, lane) + P.dsel * ubuf[t * 16 + P.hidx];
            if ((lane & 3) == 0) ybuf[t * 16 + P.hidx] = gelu_tanh(y);
        }
    }
    if (WITH_Y) {
        LDS_WAIT(); asm volatile("" ::: "memory");
        if (lane < ntok) {
            const LAS f32x4* yp = (const LAS f32x4*)(ybuf + lane * 16);
            const f32x4 y0 = yp[0], y1 = yp[1], y2 = yp[2], y3 = yp[3];
            v4u a, b; a.x = pk2(y0.x, y0.y); a.y = pk2(y0.z, y0.w); a.z = pk2(y1.x, y1.y); a.w = pk2(y1.z, y1.w);
            b.x = pk2(y2.x, y2.y); b.y = pk2(y2.z, y2.w); b.z = pk2(y3.x, y3.y); b.w = pk2(y3.z, y3.w);
            *(v4u*)(zrows + (size_t)lane * 2048) = a; *(v4u*)(zrows + (size_t)lane * 2048 + 8) = b;
        }
    }
    LDS_WAIT(); asm volatile("" ::: "memory");
}
DI void s5_load_par(S5Par& P, const float* AB, const float* BB, const float* c_re, const float* c_im, const float* dsk, int g, int lane) {
    const f32x2 ab = *(const f32x2*)(AB + (size_t)(g * 64 + lane) * 2); P.ar = ab.x; P.ai = ab.y;
    const f32x4* bb = (const f32x4*)(BB + (size_t)(g * 64 + lane) * 32);
#pragma unroll
    for (int q = 0; q < 4; ++q) { const f32x4 r = bb[q], i = bb[4 + q]; P.bbr[4 * q] = r.x; P.bbr[4 * q + 1] = r.y; P.bbr[4 * q + 2] = r.z; P.bbr[4 * q + 3] = r.w;
        P.bbi[4 * q] = i.x; P.bbi[4 * q + 1] = i.y; P.bbi[4 * q + 2] = i.z; P.bbi[4 * q + 3] = i.w; }
#pragma unroll
    for (int h = 0; h < 16; ++h) { P.cr[h] = c_re[(size_t)g * 1024 + h * 64 + lane]; P.ci[h] = c_im[(size_t)g * 1024 + h * 64 + lane]; }
    P.hidx = idx16(lane); P.dsel = dsk[g * 16 + P.hidx];
}
DI void s5_prompt_unit(LAS unsigned char* lds, const bf16* H0, bf16* Z, const float* AB, const float* BB, const float* c_re, const float* c_im, const float* dsk,
                       float* ps5r, float* ps5i, int b, int g, int wid, int lane) {
    S5Par P; s5_load_par(P, AB, BB, c_re, c_im, dsk, g, lane);
    LAS float* ubuf = (LAS float*)(lds + wid * 8192); LAS float* ybuf = ubuf + 1024;
    LAS f32x2* HE = (LAS f32x2*)(lds + 65536);
    const int rowbase = b * PSEQ + 256 * wid;
    float hr = 0.f, hi = 0.f;
    for (int blk = 0; blk < 4; ++blk) s5_block<false>(H0 + (size_t)(rowbase + 64 * blk) * NE + 16 * g, 64, ubuf, ybuf, nullptr, lane, P, hr, hi);
    HE[wid * 64 + lane] = (f32x2){hr, hi};
    LDS_WAIT(); __syncthreads();
    float pr = P.ar, pi = P.ai;
#pragma unroll
    for (int s = 0; s < 8; ++s) { const float nr = pr * pr - pi * pi, ni = 2.f * pr * pi; pr = nr; pi = ni; }
    hr = 0.f; hi = 0.f;
    for (int v = 0; v < wid; ++v) { const f32x2 e = HE[v * 64 + lane]; const float nr = pr * hr - pi * hi + e.x, ni = pr * hi + pi * hr + e.y; hr = nr; hi = ni; }
    for (int blk = 0; blk < 4; ++blk)
        s5_block<true>(H0 + (size_t)(rowbase + 64 * blk) * NE + 16 * g, 64, ubuf, ybuf, Z + (size_t)(rowbase + 64 * blk) * 2048 + 16 * g, lane, P, hr, hi);
    if (wid == 7) { ps5r[(size_t)(b * 128 + g) * 64 + lane] = hr; ps5i[(size_t)(b * 128 + g) * 64 + lane] = hi; }
    __syncthreads();
}
DI void s5_sample_wave(LAS unsigned char* lds, const bf16* H0, bf16* Z, const float* AB, const float* BB, const float* c_re, const float* c_im, const float* dsk,
                       const float* st_re, const float* st_im, float* ss5r, float* ss5i, int g, int b0, int nb, int wid, int lane) {
    S5Par P; s5_load_par(P, AB, BB, c_re, c_im, dsk, g, lane);
    LAS float* ubuf = (LAS float*)(lds + wid * 8192); LAS float* ybuf = ubuf + 1024;
    for (int b = b0; b < b0 + nb; ++b) {
        float hr = st_re[(size_t)(b * 128 + g) * 64 + lane], hi = st_im[(size_t)(b * 128 + g) * 64 + lane];
        const int row = MPROMPT + 4 * b;
        s5_block<true>(H0 + (size_t)row * NE + 16 * g, 4, ubuf, ybuf, Z + (size_t)row * 2048 + 16 * g, lane, P, hr, hi);
        ss5r[(size_t)(b * 128 + g) * 64 + lane] = hr; ss5i[(size_t)(b * 128 + g) * 64 + lane] = hi;
    }
}

constexpr int SWA_KS = 144, SWA_VS = 392, SWA_VT_OFF = 192 * SWA_KS, SWA_BT_OFF = SWA_VT_OFF + 64 * SWA_VS;
DI bf16x8 pack8(const f32x16& x, int s) {
    v4u p; p.x = pk2(x[8 * s], x[8 * s + 1]); p.y = pk2(x[8 * s + 2], x[8 * s + 3]); p.z = pk2(x[8 * s + 4], x[8 * s + 5]); p.w = pk2(x[8 * s + 6], x[8 * s + 7]);
    return __builtin_bit_cast(bf16x8, p);
}
DI void swa_prompt_unit(LAS unsigned char* lds, const bf16* H0, bf16* MIX, const float* BT, const float* sinks, float* pk_out, float* pv_out,
                        int b, int kvh, int qb, int tid, int wid, int lane) {
    const int q0 = qb * 64;
#pragma unroll
    for (int i = 0; i < 3; ++i) {
        const int c = tid + 512 * i, row = c >> 3, part = c & 7, t = q0 - 128 + row;
        v4u val = {0u, 0u, 0u, 0u};
        if (t >= 0) val = *(const v4u*)(H0 + (size_t)(b * PSEQ + t) * NE + 4096 + kvh * 64 + part * 8);
        *(LAS v4u*)(lds + row * SWA_KS + part * 16) = val;
    }
#pragma unroll
    for (int i = 0; i < 3; ++i) {
        const int c = tid + 512 * i, key = c % 192, dc = c / 192, t = q0 - 128 + key;
        v4u val = {0u, 0u, 0u, 0u};
        if (t >= 0) val = *(const v4u*)(H0 + (size_t)(b * PSEQ + t) * NE + 4608 + kvh * 64 + dc * 8);
        LAS unsigned char* vt = lds + SWA_VT_OFF + (8 * dc) * SWA_VS + key * 2;
        *(LAS bf16*)(vt + 0 * SWA_VS) = (bf16)(val.x & 0xffffu); *(LAS bf16*)(vt + 1 * SWA_VS) = (bf16)(val.x >> 16);
        *(LAS bf16*)(vt + 2 * SWA_VS) = (bf16)(val.y & 0xffffu); *(LAS bf16*)(vt + 3 * SWA_VS) = (bf16)(val.y >> 16);
        *(LAS bf16*)(vt + 4 * SWA_VS) = (bf16)(val.z & 0xffffu); *(LAS bf16*)(vt + 5 * SWA_VS) = (bf16)(val.z >> 16);
        *(LAS bf16*)(vt + 6 * SWA_VS) = (bf16)(val.w & 0xffffu); *(LAS bf16*)(vt + 7 * SWA_VS) = (bf16)(val.w >> 16);
    }
    for (int e = tid; e < 768; e += 512) { const int gg = e / 192, x = e % 192; const int dist = 159 - x;
        ((LAS float*)(lds + SWA_BT_OFF))[e] = (dist >= 0 && dist < 128) ? BT[(size_t)(4 * kvh + gg) * 128 + dist] : -1.0e30f; }
    LDS_WAIT(); __syncthreads();
    if (qb == 31) {
        for (int e = tid; e < 128 * 64; e += 512) { const int j = e >> 6, d = e & 63;
            pk_out[((size_t)(b * 128 + j) * 8 + kvh) * 64 + d] = bf2f(*(const LAS bf16*)(lds + (64 + j) * SWA_KS + d * 2));
            pv_out[((size_t)(b * 128 + j) * 8 + kvh) * 64 + d] = bf2f(*(const LAS bf16*)(lds + SWA_VT_OFF + d * SWA_VS + (64 + j) * 2)); }
    }
    const int g = wid & 3, s = wid >> 2, hq = 4 * kvh + g, r = lane & 31, h = lane >> 5;
    const int tq = q0 + 32 * s + r; const size_t rowq = (size_t)(b * PSEQ + tq);
    bf16x8 qf[4];
#pragma unroll
    for (int ks = 0; ks < 4; ++ks) qf[ks] = *(const bf16x8*)(H0 + rowq * NE + 2048 + hq * 64 + 16 * ks + 8 * h);
    f32x16 S[5];
#pragma unroll
    for (int j = 0; j < 5; ++j) {
#pragma unroll
        for (int i = 0; i < 16; ++i) S[j][i] = 0.f;
#pragma unroll
        for (int ks = 0; ks < 4; ++ks) { const bf16x8 a = *(const LAS bf16x8*)(lds + (32 * (s + j) + r) * SWA_KS + (16 * ks + 8 * h) * 2); S[j] = MFMA32(a, qf[ks], S[j]); }
        __builtin_amdgcn_sched_barrier(0);
    }
    const LAS float* bt = (const LAS float*)(lds + SWA_BT_OFF) + g * 192 + (31 - r + 4 * h);
    const int thr = 128 - q0 - 32 * s - 4 * h;
    const float sink = sinks[hq];
    float mx = -3.0e38f;
#pragma unroll
    for (int j = 0; j < 5; ++j) {
#pragma unroll
        for (int i = 0; i < 16; ++i) { const int cji = 32 * j + (i & 3) + 8 * (i >> 2);
            const float sc = S[j][i] * 0.125f + bt[cji]; S[j][i] = (cji >= thr) ? sc : -1.0e30f; mx = fmaxf(mx, S[j][i]); }
        __builtin_amdgcn_sched_barrier(0); }
    mx = fmaxf(mx, __shfl_xor(mx, 32)); mx = fmaxf(mx, sink);
    float sum = 0.f;
#pragma unroll
    for (int j = 0; j < 5; ++j)
#pragma unroll
        for (int i = 0; i < 16; ++i) { const float p = __expf(S[j][i] - mx); S[j][i] = p; sum += p; }
    sum += __shfl_xor(sum, 32);
    const float inv = 1.0f / (sum + __expf(sink - mx));
    f32x16 O[2];
#pragma unroll
    for (int dt = 0; dt < 2; ++dt)
#pragma unroll
        for (int i = 0; i < 16; ++i) O[dt][i] = 0.f;
#pragma unroll
    for (int j = 0; j < 5; ++j)
#pragma unroll
        for (int k2 = 0; k2 < 2; ++k2) { const bf16x8 pf = pack8(S[j], k2);
#pragma unroll
            for (int dt = 0; dt < 2; ++dt) { const LAS unsigned char* vp = lds + SWA_VT_OFF + (32 * dt + r) * SWA_VS + (32 * (s + j) + 16 * k2 + 4 * h) * 2;
                const v2u lo = *(const LAS v2u*)vp, hi2 = *(const LAS v2u*)(vp + 16);
                v4u av; av.x = lo.x; av.y = lo.y; av.z = hi2.x; av.w = hi2.y;
                O[dt] = MFMA32(__builtin_bit_cast(bf16x8, av), pf, O[dt]); }
            __builtin_amdgcn_sched_barrier(0); }
    bf16* orow = MIX + rowq * D + 2048 + hq * 64;
#pragma unroll
    for (int dt = 0; dt < 2; ++dt)
#pragma unroll
        for (int q4 = 0; q4 < 4; ++q4) { v2u w; w.x = pk2(O[dt][4 * q4] * inv, O[dt][4 * q4 + 1] * inv); w.y = pk2(O[dt][4 * q4 + 2] * inv, O[dt][4 * q4 + 3] * inv);
            *(v2u*)(orow + 32 * dt + 8 * q4 + 4 * h) = w; }
    __syncthreads();
}

constexpr int SS_K = 0, SS_V = 132 * 65 * 4, SS_BT = SS_V + 132 * 64 * 4, SS_Q = SS_BT + 2048, SS_P = SS_Q + 4 * 1024;
DI void swa_sample_unit(LAS unsigned char* lds, const bf16* H0, bf16* MIX, const float* BT, const float* sinks, const float* ck, const float* cv, float* sk_out, float* sv_out,
                        int b, int kvh, int tid, int wid, int lane) {
    LAS float* Kf = (LAS float*)(lds + SS_K); LAS float* Vf = (LAS float*)(lds + SS_V); LAS float* bt = (LAS float*)(lds + SS_BT);
    for (int e = tid; e < 132 * 64; e += 512) { const int L = e >> 6, d = e & 63; float kv, vv;
        if (L < 128) { kv = ck[((size_t)(b * 128 + L) * 8 + kvh) * 64 + d]; vv = cv[((size_t)(b * 128 + L) * 8 + kvh) * 64 + d]; }
        else { const size_t row = (size_t)(MPROMPT + 4 * b + (L - 128)); kv = bf2f(H0[row * NE + 4096 + kvh * 64 + d]); vv = bf2f(H0[row * NE + 4608 + kvh * 64 + d]); }
        Kf[L * 65 + d] = kv; Vf[L * 64 + d] = vv;
        if (L >= 4) { sk_out[((size_t)(b * 128 + (L - 4)) * 8 + kvh) * 64 + d] = kv; sv_out[((size_t)(b * 128 + (L - 4)) * 8 + kvh) * 64 + d] = vv; }
    }
    bt[tid] = BT[(size_t)(4 * kvh + (tid >> 7)) * 128 + (tid & 127)];
    LDS_WAIT(); __syncthreads();
    if (wid < 4) {
        const int t = wid; const size_t row = (size_t)(MPROMPT + 4 * b + t);
        LAS float* qs = (LAS float*)(lds + SS_Q + wid * 1024); LAS float* ps = (LAS float*)(lds + SS_P + wid * 2048);
#pragma unroll
        for (int g = 0; g < 4; ++g) qs[g * 64 + lane] = bf2f(H0[row * NE + 2048 + (4 * kvh + g) * 64 + lane]) * 0.125f;
        LDS_WAIT(); asm volatile("" ::: "memory");
        const int L1 = t + 1 + lane, L2 = t + 65 + lane;
        float s1[4] = {0.f, 0.f, 0.f, 0.f}, s2[4] = {0.f, 0.f, 0.f, 0.f};
        for (int d = 0; d < 64; ++d) { const float k1 = Kf[L1 * 65 + d], k2 = Kf[L2 * 65 + d];
#pragma unroll
            for (int g = 0; g < 4; ++g) { const float q = qs[g * 64 + d]; s1[g] += q * k1; s2[g] += q * k2; } }
        float inv[4];
#pragma unroll
        for (int g = 0; g < 4; ++g) {
            const float a1 = s1[g] + bt[g * 128 + 127 - lane], a2 = s2[g] + bt[g * 128 + 63 - lane];
            const float sink = sinks[4 * kvh + g];
            const float mx = fmaxf(wave_max(fmaxf(a1, a2)), sink);
            const float p1 = __expf(a1 - mx), p2 = __expf(a2 - mx);
            inv[g] = 1.0f / (wave_sum(p1 + p2) + __expf(sink - mx));
            ps[g * 128 + lane] = p1; ps[g * 128 + 64 + lane] = p2;
        }
        LDS_WAIT(); asm volatile("" ::: "memory");
        float o[4] = {0.f, 0.f, 0.f, 0.f};
        for (int kk = 0; kk < 128; ++kk) { const float v = Vf[(t + 1 + kk) * 64 + lane];
#pragma unroll
            for (int g = 0; g < 4; ++g) o[g] += ps[g * 128 + kk] * v; }
#pragma unroll
        for (int g = 0; g < 4; ++g) MIX[row * D + 2048 + (4 * kvh + g) * 64 + lane] = (bf16)(pk2(o[g] * inv[g], 0.f) & 0xffffu);
    }
    __syncthreads();
}

constexpr size_t S5T_KF = 0, S5T_EF = 33 * 1024, S5T_FF = S5T_EF + 128 * 1024, S5T_GROUP = S5T_FF + 128 * 1024;
DI void cmul(float& xr, float& xi, float yr, float yi) { const float r = xr * yr - xi * yi, i = xr * yi + xi * yr; xr = r; xi = i; }

DI void s5_build_tables(unsigned char* tab, const float* AB, const float* BB, const float* c_re, const float* c_im, const float* dsk, int gt, int NGT) {
    for (int e = gt; e < 128 * 1024; e += NGT) {
        const int g = e >> 10, h = (e >> 6) & 15, hp = (e >> 2) & 15, pq = e & 3;
        float K[33];
#pragma unroll
        for (int l = 0; l < 33; ++l) K[l] = 0.f;
        for (int p = 16 * pq; p < 16 * pq + 16; ++p) {
            const float ar = AB[(size_t)(g * 64 + p) * 2], ai = AB[(size_t)(g * 64 + p) * 2 + 1];
            const float br = BB[(size_t)(g * 64 + p) * 32 + hp], bi = BB[(size_t)(g * 64 + p) * 32 + 16 + hp];
            const float cr = c_re[(size_t)g * 1024 + h * 64 + p], ci = c_im[(size_t)g * 1024 + h * 64 + p];
            float zr = cr * br - ci * bi, zi = cr * bi + ci * br;
#pragma unroll
            for (int l = 0; l < 33; ++l) { K[l] += zr; cmul(zr, zi, ar, ai); }
        }
#pragma unroll
        for (int l = 0; l < 33; ++l) {
            K[l] += __builtin_bit_cast(float, __builtin_amdgcn_update_dpp(0, __builtin_bit_cast(int, K[l]), 0xB1, 0xF, 0xF, true));
            K[l] += __builtin_bit_cast(float, __builtin_amdgcn_update_dpp(0, __builtin_bit_cast(int, K[l]), 0x4E, 0xF, 0xF, true)); }
        if (h == hp) K[0] += dsk[g * 16 + h];
        bf16* kf = (bf16*)(tab + (size_t)g * S5T_GROUP + S5T_KF);
#pragma unroll
        for (int f = 0; f < 33; ++f)
#pragma unroll
            for (int tl = 0; tl < 2; ++tl) { const int lag = f - 1 + tl; const float v = (lag >= 0 && lag <= 32) ? K[lag < 33 ? (lag < 0 ? 0 : lag) : 32] : 0.f;
                if ((f & 3) == pq) kf[((size_t)f * 64 + (tl * 16 + h) + 32 * (hp >> 3)) * 8 + (hp & 7)] = (bf16)(pk2(lag >= 0 ? v : 0.f, 0.f) & 0xffffu); }
    }
    for (int e = gt; e < 128 * 1024; e += NGT) {
        const int g = e >> 10, p = (e >> 4) & 63, hp = e & 15;
        const float ar = AB[(size_t)(g * 64 + p) * 2], ai = AB[(size_t)(g * 64 + p) * 2 + 1];
        float wr = BB[(size_t)(g * 64 + p) * 32 + hp], wi = BB[(size_t)(g * 64 + p) * 32 + 16 + hp];
        bf16* ef = (bf16*)(tab + (size_t)g * S5T_GROUP + S5T_EF);
        const int Jr = p >> 5, r = p & 31, lanei = r + 32 * (hp >> 3), el = hp & 7;
        for (int s = 31; s >= 0; --s) {
            ef[((size_t)(Jr * 32 + s) * 64 + lanei) * 8 + el] = (bf16)(pk2(wr, 0.f) & 0xffffu);
            ef[((size_t)((Jr + 2) * 32 + s) * 64 + lanei) * 8 + el] = (bf16)(pk2(wi, 0.f) & 0xffffu);
            cmul(wr, wi, ar, ai);
        }
    }
    for (int e = gt; e < 128 * 1024; e += NGT) {
        const int g = e >> 10, h = (e >> 6) & 15, p = e & 63;
        const float ar = AB[(size_t)(g * 64 + p) * 2], ai = AB[(size_t)(g * 64 + p) * 2 + 1];
        float zr = c_re[(size_t)g * 1024 + h * 64 + p], zi = c_im[(size_t)g * 1024 + h * 64 + p];
        bf16* ff = (bf16*)(tab + (size_t)g * S5T_GROUP + S5T_FF);
        const int kk = p >> 4, hf = (p >> 3) & 1, j = p & 7;
        for (int n = 1; n <= 32; ++n) {
            cmul(zr, zi, ar, ai);
            const int t = n - 1, I = t >> 1, row = (t & 1) * 16 + h, lanei = row + 32 * hf;
            ff[((size_t)(I * 8 + kk) * 64 + lanei) * 8 + j] = (bf16)(pk2(zr, 0.f) & 0xffffu);
            ff[((size_t)(I * 8 + 4 + kk) * 64 + lanei) * 8 + j] = (bf16)(pk2(-zi, 0.f) & 0xffffu);
        }
    }
}

constexpr int S5_HLOC_ROW = 520, S5_HIN_OFF = 128 * S5_HLOC_ROW, S5_HIN_ROW = 272;
DI void s5_mfma_unit(LAS unsigned char* lds, const bf16* H0, bf16* Z, const unsigned char* tab, const float* AB, float* ps5r, float* ps5i, int g, int tid, int wid, int lane) {
    const unsigned char* tg = tab + (size_t)g * S5T_GROUP;
    const int r = lane & 31, hf = lane >> 5, b = wid >> 1, odd = wid & 1;
    const int chunk = 32 * odd + r;
    const bf16* ucol = H0 + (size_t)(b * PSEQ + 32 * chunk) * NE + 16 * g + 8 * hf;
    const v4u* KFp = (const v4u*)(tg + S5T_KF) + lane; const v4u* EFp = (const v4u*)(tg + S5T_EF) + lane; const v4u* FFp = (const v4u*)(tg + S5T_FF) + lane;
    {
        f32x16 HJ[4];
#pragma unroll
        for (int J = 0; J < 4; ++J)
#pragma unroll
            for (int i = 0; i < 16; ++i) HJ[J][i] = 0.f;
#pragma unroll 4
        for (int s = 0; s < 32; ++s) {
            const bf16x8 uf = *(const bf16x8*)(ucol + (size_t)s * NE);
#pragma unroll
            for (int J = 0; J < 4; ++J) { const bf16x8 af = __builtin_bit_cast(bf16x8, EFp[(size_t)(J * 32 + s) * 64]); HJ[J] = MFMA32(af, uf, HJ[J]); }
            if ((s & 3) == 3) __builtin_amdgcn_sched_barrier(0);
        }
        for (int rd = 0; rd < 2; ++rd) {
            if ((wid >> 2) == rd) {
                const int bl = b & 1;
#pragma unroll
                for (int J = 0; J < 4; ++J)
#pragma unroll
                    for (int i = 0; i < 16; ++i) *(LAS float*)(lds + (bl * 64 + 32 * (J & 1) + crow(i, hf)) * S5_HLOC_ROW + chunk * 8 + (J >> 1) * 4) = HJ[J][i];
            }
            LDS_WAIT(); __syncthreads();
            if (tid < 128) {
                const int bl = tid >> 6, p = tid & 63, bb = 2 * rd + bl;
                const f32x2 a = *(const f32x2*)(AB + (size_t)(g * 64 + p) * 2); float Ar = a.x, Ai = a.y;
#pragma unroll
                for (int k = 0; k < 5; ++k) cmul(Ar, Ai, Ar, Ai);
                float hr = 0.f, hi = 0.f;
                const LAS unsigned char* xrow = lds + (bl * 64 + p) * S5_HLOC_ROW;
                LAS unsigned char* hin = lds + S5_HIN_OFF + (bb * 64) * S5_HIN_ROW + p * 2;
#pragma unroll 8
                for (int c = 0; c < 64; ++c) {
                    const f32x2 x = *(const LAS f32x2*)(xrow + c * 8);
                    *(LAS bf16*)(hin + c * S5_HIN_ROW) = (bf16)(pk2(hr, 0.f) & 0xffffu); *(LAS bf16*)(hin + c * S5_HIN_ROW + 128) = (bf16)(pk2(hi, 0.f) & 0xffffu);
                    const float nr = Ar * hr - Ai * hi + x.x, ni = Ar * hi + Ai * hr + x.y; hr = nr; hi = ni;
                }
                ps5r[(size_t)(bb * 128 + g) * 64 + p] = hr; ps5i[(size_t)(bb * 128 + g) * 64 + p] = hi;
            }
            LDS_WAIT(); __syncthreads();
        }
    }
    bf16x8 HB[8];
#pragma unroll
    for (int kk = 0; kk < 8; ++kk) HB[kk] = *(const LAS bf16x8*)(lds + S5_HIN_OFF + (32 * wid + r) * S5_HIN_ROW + (16 * kk + 8 * hf) * 2);
    asm volatile("" : "+v"(ucol));
#pragma unroll
    for (int pass = 0; pass < 2; ++pass) {
        f32x16 Y[8];
#pragma unroll
        for (int q = 0; q < 8; ++q)
#pragma unroll
            for (int i = 0; i < 16; ++i) Y[q][i] = 0.f;
        const int I0 = 8 * pass, smax = 16 * pass + 15;
#pragma unroll 2
        for (int s = 0; s <= smax; ++s) {
            const bf16x8 uf = *(const bf16x8*)(ucol + (size_t)s * NE);
#pragma unroll
            for (int q = 0; q < 8; ++q) { const int d = 2 * (I0 + q) - s;
                if (d >= -1) { const bf16x8 kf = __builtin_bit_cast(bf16x8, KFp[(size_t)(d + 1) * 64]); Y[q] = MFMA32(kf, uf, Y[q]); } }
            __builtin_amdgcn_sched_barrier(0);
        }
#pragma unroll
        for (int kk = 0; kk < 8; ++kk) {
#pragma unroll
            for (int q = 0; q < 8; ++q) { const bf16x8 ff = __builtin_bit_cast(bf16x8, FFp[(size_t)((I0 + q) * 8 + kk) * 64]); Y[q] = MFMA32(ff, HB[kk], Y[q]); }
            __builtin_amdgcn_sched_barrier(0); }
#pragma unroll
        for (int q = 0; q < 8; ++q) {
            int zrow = b * PSEQ + 32 * chunk + 2 * (I0 + q); asm volatile("" : "+v"(zrow));
            bf16* zq = Z + (size_t)zrow * 2048 + 16 * g + 4 * hf;
#pragma unroll
            for (int q4 = 0; q4 < 4; ++q4) {
                v2u w; w.x = pk2(gelu_tanh(Y[q][4 * q4]), gelu_tanh(Y[q][4 * q4 + 1])); w.y = pk2(gelu_tanh(Y[q][4 * q4 + 2]), gelu_tanh(Y[q][4 * q4 + 3]));
                *(v2u*)(zq + (q4 >> 1) * 2048 + 8 * (q4 & 1)) = w; }
            __builtin_amdgcn_sched_barrier(0);
        }
    }
    __syncthreads();
}

constexpr int CA_KS = 272, CA_VS = 520, CA_VT_OFF = 256 * CA_KS;
DI void cross_prompt_unit(LAS unsigned char* lds, const float* QP  , const bf16* KVM  , bf16* CO, int b, int hd, int qblk, int tid, int wid, int lane) {
#pragma unroll
    for (int i = 0; i < 8; ++i) {
        const int c = tid + 512 * i, row = c >> 4, part = c & 15;
        const v4u val = *(const v4u*)(KVM + (size_t)(b * 256 + row) * 1024 + hd * 128 + part * 8);
        *(LAS v4u*)(lds + row * CA_KS + part * 16) = val;
    }
#pragma unroll
    for (int i = 0; i < 8; ++i) {
        const int c = tid + 512 * i, key = c & 255, dc = c >> 8;
        const v4u val = *(const v4u*)(KVM + (size_t)(b * 256 + key) * 1024 + 512 + hd * 128 + dc * 8);
        LAS unsigned char* vt = lds + CA_VT_OFF + (8 * dc) * CA_VS + key * 2;
        *(LAS bf16*)(vt + 0 * CA_VS) = (bf16)(val.x & 0xffffu); *(LAS bf16*)(vt + 1 * CA_VS) = (bf16)(val.x >> 16);
        *(LAS bf16*)(vt + 2 * CA_VS) = (bf16)(val.y & 0xffffu); *(LAS bf16*)(vt + 3 * CA_VS) = (bf16)(val.y >> 16);
        *(LAS bf16*)(vt + 4 * CA_VS) = (bf16)(val.z & 0xffffu); *(LAS bf16*)(vt + 5 * CA_VS) = (bf16)(val.z >> 16);
        *(LAS bf16*)(vt + 6 * CA_VS) = (bf16)(val.w & 0xffffu); *(LAS bf16*)(vt + 7 * CA_VS) = (bf16)(val.w >> 16);
    }
    LDS_WAIT(); __syncthreads();
    const int r = lane & 31, h = lane >> 5;
    const size_t rowq = (size_t)(b * PSEQ + qblk * 256 + 32 * wid + r);
    bf16x8 qf[8];
#pragma unroll
    for (int ks = 0; ks < 8; ++ks) { const float* qp = QP + rowq * DM + hd * 128 + 16 * ks + 8 * h; f32x4 lo = {0.f, 0.f, 0.f, 0.f}, hi4 = lo;
#pragma unroll
        for (int sl = 0; sl < 4; ++sl) { lo += *(const f32x4*)(qp + (size_t)sl * MPROMPT * DM); hi4 += *(const f32x4*)(qp + (size_t)sl * MPROMPT * DM + 4); }
        v4u w; w.x = pk2(lo[0], lo[1]); w.y = pk2(lo[2], lo[3]); w.z = pk2(hi4[0], hi4[1]); w.w = pk2(hi4[2], hi4[3]); qf[ks] = __builtin_bit_cast(bf16x8, w); }
    f32x16 O[4];
#pragma unroll
    for (int dt = 0; dt < 4; ++dt)
#pragma unroll
        for (int i = 0; i < 16; ++i) O[dt][i] = 0.f;
    float mrun = -1.0e30f, lrun = 0.f;
    const float scale = 0.08838834764831845f;
#pragma unroll 1
    for (int c4 = 0; c4 < 4; ++c4) {
        f32x16 S[2];
#pragma unroll
        for (int tt = 0; tt < 2; ++tt) {
#pragma unroll
            for (int i = 0; i < 16; ++i) S[tt][i] = 0.f;
#pragma unroll
            for (int ks = 0; ks < 8; ++ks) { const bf16x8 a = *(const LAS bf16x8*)(lds + (64 * c4 + 32 * tt + r) * CA_KS + (16 * ks + 8 * h) * 2); S[tt] = MFMA32(a, qf[ks], S[tt]); }
        }
        float cm = -3.0e38f;
#pragma unroll
        for (int tt = 0; tt < 2; ++tt)
#pragma unroll
            for (int i = 0; i < 16; ++i) { S[tt][i] *= scale; cm = fmaxf(cm, S[tt][i]); }
        cm = fmaxf(cm, __shfl_xor(cm, 32));
        const float mnew = fmaxf(mrun, cm), alpha = __expf(mrun - mnew);
        float ps = 0.f;
#pragma unroll
        for (int tt = 0; tt < 2; ++tt)
#pragma unroll
            for (int i = 0; i < 16; ++i) { const float p = __expf(S[tt][i] - mnew); S[tt][i] = p; ps += p; }
        lrun = lrun * alpha + ps; mrun = mnew;
#pragma unroll
        for (int dt = 0; dt < 4; ++dt)
#pragma unroll
            for (int i = 0; i < 16; ++i) O[dt][i] *= alpha;
#pragma unroll
        for (int tt = 0; tt < 2; ++tt)
#pragma unroll
            for (int k2 = 0; k2 < 2; ++k2) { const bf16x8 pf = pack8(S[tt], k2);
#pragma unroll
                for (int dt = 0; dt < 4; ++dt) { const LAS unsigned char* vp = lds + CA_VT_OFF + (32 * dt + r) * CA_VS + (64 * c4 + 32 * tt + 16 * k2 + 4 * h) * 2;
                    const v2u lo = *(const LAS v2u*)vp, hi2 = *(const LAS v2u*)(vp + 16);
                    v4u av; av.x = lo.x; av.y = lo.y; av.z = hi2.x; av.w = hi2.y;
                    O[dt] = MFMA32(__builtin_bit_cast(bf16x8, av), pf, O[dt]); } }
    }
    lrun += __shfl_xor(lrun, 32);
    const float inv = 1.0f / lrun;
    bf16* orow = CO + rowq * DM + hd * 128;
#pragma unroll
    for (int dt = 0; dt < 4; ++dt)
#pragma unroll
        for (int q4 = 0; q4 < 4; ++q4) { v2u w; w.x = pk2(O[dt][4 * q4] * inv, O[dt][4 * q4 + 1] * inv); w.y = pk2(O[dt][4 * q4 + 2] * inv, O[dt][4 * q4 + 3] * inv);
            *(v2u*)(orow + 32 * dt + 8 * q4 + 4 * h) = w; }
    __syncthreads();
}
DI void cross_sample_unit(LAS unsigned char* lds, const float* QS  , const float* ck, const float* cv, bf16* CO, int b, int hd, int tid, int wid, int lane) {
    LAS float* sc = (LAS float*)lds;
    LAS float* po = (LAS float*)(lds + 4096);
    const int l32 = lane & 31, half = lane >> 5;
    f32x4 qv[4];
#pragma unroll
    for (int t = 0; t < 4; ++t) { f32x4 q = {0.f, 0.f, 0.f, 0.f};
#pragma unroll
        for (int sl = 0; sl < 8; ++sl) q += *(const f32x4*)(QS + ((size_t)sl * MSAMPLE + 4 * b + t) * DM + hd * 128 + 4 * l32);
        v2u w; w.x = pk2(q[0], q[1]); w.y = pk2(q[2], q[3]); qv[t] = (f32x4){bflo(w.x), bfhi(w.x), bflo(w.y), bfhi(w.y)}; }
    const float* kb = ck + ((size_t)b * 256 * 4 + hd) * 128;
    const float scale = 0.08838834764831845f;
#pragma unroll
    for (int blk = 0; blk < 2; ++blk) {
        f32x4 kv[8];
#pragma unroll
        for (int it = 0; it < 8; ++it) kv[it] = *(const f32x4*)(kb + (size_t)(32 * wid + 16 * blk + 2 * it + half) * 512 + 4 * l32);
#pragma unroll
        for (int it = 0; it < 8; ++it) {
            float d[4];
#pragma unroll
            for (int t = 0; t < 4; ++t) d[t] = kv[it].x * qv[t].x + kv[it].y * qv[t].y + kv[it].z * qv[t].z + kv[it].w * qv[t].w;
#pragma unroll
            for (int o = 1; o < 32; o <<= 1)
#pragma unroll
                for (int t = 0; t < 4; ++t) d[t] += __shfl_xor(d[t], o);
            if (l32 == 0) *(LAS f32x4*)(sc + (32 * wid + 16 * blk + 2 * it + half) * 4) = (f32x4){d[0] * scale, d[1] * scale, d[2] * scale, d[3] * scale};
        }
    }
    LDS_WAIT(); __syncthreads();
    if (wid == 0) {
        f32x4 e[4]; f32x4 mx = {-3e38f, -3e38f, -3e38f, -3e38f};
#pragma unroll
        for (int k = 0; k < 4; ++k) { e[k] = *(const LAS f32x4*)(sc + (lane + 64 * k) * 4); mx.x = fmaxf(mx.x, e[k].x); mx.y = fmaxf(mx.y, e[k].y); mx.z = fmaxf(mx.z, e[k].z); mx.w = fmaxf(mx.w, e[k].w); }
        mx.x = wave_max(mx.x); mx.y = wave_max(mx.y); mx.z = wave_max(mx.z); mx.w = wave_max(mx.w);
        f32x4 sm = {0.f, 0.f, 0.f, 0.f};
#pragma unroll
        for (int k = 0; k < 4; ++k) { e[k].x = __expf(e[k].x - mx.x); e[k].y = __expf(e[k].y - mx.y); e[k].z = __expf(e[k].z - mx.z); e[k].w = __expf(e[k].w - mx.w); sm += e[k]; }
        sm.x = 1.0f / wave_sum(sm.x); sm.y = 1.0f / wave_sum(sm.y); sm.z = 1.0f / wave_sum(sm.z); sm.w = 1.0f / wave_sum(sm.w);
#pragma unroll
        for (int k = 0; k < 4; ++k) *(LAS f32x4*)(sc + (lane + 64 * k) * 4) = e[k] * sm;
    }
    LDS_WAIT(); __syncthreads();
    const float* vb = cv + ((size_t)b * 256 * 4 + hd) * 128;
    f32x2 o[4] = {{0.f, 0.f}, {0.f, 0.f}, {0.f, 0.f}, {0.f, 0.f}};
#pragma unroll
    for (int blk = 0; blk < 4; ++blk) {
        f32x2 vv[8];
#pragma unroll
        for (int it = 0; it < 8; ++it) vv[it] = *(const f32x2*)(vb + (size_t)(32 * wid + 8 * blk + it) * 512 + 2 * lane);
#pragma unroll
        for (int it = 0; it < 8; ++it) { const f32x4 p = *(const LAS f32x4*)(sc + (32 * wid + 8 * blk + it) * 4);
            o[0] += vv[it] * p.x; o[1] += vv[it] * p.y; o[2] += vv[it] * p.z; o[3] += vv[it] * p.w; }
    }
#pragma unroll
    for (int t = 0; t < 4; ++t) *(LAS f32x2*)(po + (wid * 4 + t) * 128 + 2 * lane) = o[t];
    LDS_WAIT(); __syncthreads();
    { const int t = tid >> 7, d = tid & 127; float s = 0.f;
#pragma unroll
      for (int w8 = 0; w8 < 8; ++w8) s += po[(w8 * 4 + t) * 128 + d];
      const float s1 = __shfl_xor(s, 1);
      if ((d & 1) == 0) *(unsigned*)(CO + (size_t)(MPROMPT + 4 * b + t) * DM + hd * 128 + d) = pk2(s, s1); }
    __syncthreads();
}

DI float reduce8(float (&v)[8], int lane) {
    const bool b5 = (lane & 32) != 0, b4 = (lane & 16) != 0, b3 = (lane & 8) != 0;
#pragma unroll
    for (int i = 0; i < 4; ++i) { const float send = b5 ? v[i] : v[i + 4], keep = b5 ? v[i + 4] : v[i]; v[i] = keep + __shfl_xor(send, 32); }
#pragma unroll
    for (int i = 0; i < 2; ++i) { const float send = b4 ? v[i] : v[i + 2], keep = b4 ? v[i + 2] : v[i]; v[i] = keep + __shfl_xor(send, 16); }
    { const float send = b3 ? v[0] : v[1], keep = b3 ? v[1] : v[0]; v[0] = keep + __shfl_xor(send, 8); }
    v[0] += __shfl_xor(v[0], 4); v[0] += __shfl_xor(v[0], 2); v[0] += __shfl_xor(v[0], 1);
    return v[0];
}
DI float sl4(const float* S, size_t idx) { constexpr size_t ST = (size_t)MSAMPLE * NO; return (S[idx] + S[idx + ST]) + (S[idx + 2 * ST] + S[idx + 3 * ST]); }
DI void hgrn_unit(LAS unsigned char* lds, const float* H1S, const float* lbt, bf16* OG, float* SSQ, const float* norm_g, const float* s0, float* sout,
                  int sb, int hh, int dvh, int tid, int wid, int lane) {
    const int rowbase = MPROMPT + 4 * sb;
    LAS float* SL = (LAS float*)lds;
    float S0r[8], S1r[8];
    if (s0) {
        const int row = tid >> 2, seg = tid & 3;
#pragma unroll
        for (int e = 0; e < 4; ++e) *(LAS f32x4*)(SL + row * 68 + 16 * seg + 4 * e) = *(const f32x4*)(s0 + (size_t)row * 128 + 64 * dvh + 16 * seg + 4 * e);
        LDS_WAIT(); __syncthreads();
#pragma unroll
        for (int i = 0; i < 8; ++i) { S0r[i] = SL[lane * 68 + 8 * wid + i]; S1r[i] = SL[(lane + 64) * 68 + 8 * wid + i]; }
        LDS_WAIT(); __syncthreads();
    } else {
#pragma unroll
        for (int i = 0; i < 8; ++i) { S0r[i] = 0.f; S1r[i] = 0.f; }
    }
    const int idx = ((lane >> 5) & 1) * 4 + ((lane >> 4) & 1) * 2 + ((lane >> 3) & 1);
    const int dvw = 64 * dvh + 8 * wid + idx;
    const float ng = norm_g[hh * 128 + dvw];
    const float lb0 = lbt[hh * 128 + lane], lb1 = lbt[hh * 128 + lane + 64];
#pragma unroll
    for (int tt = 0; tt < 4; ++tt) {
        const size_t rb = (size_t)(4 * sb + tt) * NO + hh * 128;
        const float qa_ = sl4(H1S, rb + lane), qb_ = sl4(H1S, rb + lane + 64), fa_ = sl4(H1S, rb + 4096 + lane), fb_ = sl4(H1S, rb + 4096 + lane + 64), ga_ = sl4(H1S, rb + 12288 + dvw);
        float v[8];
#pragma unroll
        for (int i = 0; i < 8; ++i) v[i] = bf2f((bf16)(pk2(sl4(H1S, rb + 8192 + 64 * dvh + 8 * wid + i), 0.f) & 0xffffu));
        const float qa = bf2f((bf16)(pk2(qa_ * sigmoidf_(qa_), 0.f) & 0xffffu)), qb = bf2f((bf16)(pk2(qb_ * sigmoidf_(qb_), 0.f) & 0xffffu));
        const float f0 = lb0 + (1.0f - lb0) * sigmoidf_(fa_), f1 = lb1 + (1.0f - lb1) * sigmoidf_(fb_), k0 = 1.0f - f0, k1 = 1.0f - f1, sgv = sigmoidf_(ga_);
        float po[8];
#pragma unroll
        for (int i = 0; i < 8; ++i) { S0r[i] = f0 * S0r[i] + k0 * v[i]; S1r[i] = f1 * S1r[i] + k1 * v[i]; po[i] = qa * S0r[i] + qb * S1r[i]; }
        const float o = reduce8(po, lane);
        float sq = o * o; sq += __shfl_xor(sq, 8); sq += __shfl_xor(sq, 16); sq += __shfl_xor(sq, 32);
        const size_t row = (size_t)(rowbase + tt);
        if (lane == 0) atomicAdd(SSQ + row, sq);
        if ((lane & 7) == 0) OG[row * D + hh * 128 + dvw] = (bf16)(pk2(o * ng * sgv, 0.f) & 0xffffu);
    }
#pragma unroll
    for (int i = 0; i < 8; ++i) { SL[lane * 68 + 8 * wid + i] = S0r[i]; SL[(lane + 64) * 68 + 8 * wid + i] = S1r[i]; }
    LDS_WAIT(); __syncthreads();
    { const int row = tid >> 2, seg = tid & 3;
#pragma unroll
      for (int e = 0; e < 4; ++e) *(f32x4*)(sout + (size_t)row * 128 + 64 * dvh + 16 * seg + 4 * e) = *(const LAS f32x4*)(SL + row * 68 + 16 * seg + 4 * e); }
    LDS_WAIT(); __syncthreads();
}

constexpr int HG_QS = 272, HG_TS = 80, HG_Q = 0, HG_K = 8704, HG_KL = 17408, HG_VT = 27648, HG_DEC = 37888, HG_SET = 38400, HG_TOT = 2 * HG_SET, HG_SSQ = HG_TOT + 4096, HG_OT = HG_SSQ + 1024, HG_OS = 272;
#define MFMA16(a, b, c) __builtin_amdgcn_mfma_f32_16x16x32_bf16((a), (b), (c), 0, 0, 0)
DI bf16x8 pack44(const f32x4& lo, const f32x4& hi) { v4u p; p.x = pk2(lo[0], lo[1]); p.y = pk2(lo[2], lo[3]); p.z = pk2(hi[0], hi[1]); p.w = pk2(hi[2], hi[3]); return __builtin_bit_cast(bf16x8, p); }
DI bf16x8 ld2x8(const LAS unsigned char* p, int off2) { const v2u lo = *(const LAS v2u*)p, hi = *(const LAS v2u*)(p + off2); v4u a; a.x = lo.x; a.y = lo.y; a.z = hi.x; a.w = hi.y; return __builtin_bit_cast(bf16x8, a); }

DI float row16_sum(float v) {
    v += __builtin_bit_cast(float, __builtin_amdgcn_update_dpp(0, __builtin_bit_cast(int, v), 0xB1, 0xF, 0xF, true));
    v += __builtin_bit_cast(float, __builtin_amdgcn_update_dpp(0, __builtin_bit_cast(int, v), 0x4E, 0xF, 0xF, true));
    v += __builtin_bit_cast(float, __builtin_amdgcn_update_dpp(0, __builtin_bit_cast(int, v), 0x141, 0xF, 0xF, true));
    v += __builtin_bit_cast(float, __builtin_amdgcn_update_dpp(0, __builtin_bit_cast(int, v), 0x140, 0xF, 0xF, true));
    return v;
}
DI void hgrn_prompt_unit(LAS unsigned char* lds, const bf16* H1, bf16* OG, float* SSQ, const float* norm_g, float* sout, int b, int hh, int tid, int wid, int lane) {
    const int dp = tid & 63, tq = tid >> 6, dk = 2 * dp;
    const int vtok = tid & 31, vdc = tid >> 5;
    const int li = lane & 15, g = lane >> 4;
    const size_t rowbase = (size_t)b * PSEQ;
    const bf16* hb = H1 + rowbase * NO + hh * 128;
    const float ng = norm_g[hh * 128 + 16 * wid + li];
    f32x4 S[8];
#pragma unroll
    for (int t = 0; t < 8; ++t) S[t] = (f32x4){0.f, 0.f, 0.f, 0.f};
    LAS float* TOT = (LAS float*)(lds + HG_TOT); LAS float* SSQP = (LAS float*)(lds + HG_SSQ);
    unsigned qn[4], ln[4]; bf16 sgn[8]; v4u vn;
    const unsigned poff = (unsigned)((4 * tq) * NO + dk) * 2u, voff = (unsigned)(vtok * NO + 8192 + 8 * vdc) * 2u, soff = (unsigned)((4 * g) * NO + 12288 + 16 * wid + li) * 2u;
#define HG_LOAD(c_) do { const unsigned char* cb = (const unsigned char*)(hb + (size_t)(32 * (c_)) * NO); \
        _Pragma("unroll") for (int e = 0; e < 4; ++e) { qn[e] = *(const unsigned*)(cb + poff + e * (NO * 2)); ln[e] = *(const unsigned*)(cb + poff + e * (NO * 2) + 8192); } \
        vn = *(const v4u*)(cb + voff); \
        _Pragma("unroll") for (int e = 0; e < 8; ++e) sgn[e] = *(const bf16*)(cb + soff + (16 * (e >> 2) + (e & 3)) * (NO * 2)); } while (0)
    HG_LOAD(0);
    for (int c = 0; c < 64; ++c) {
        LAS unsigned char* B = lds + (c & 1) * HG_SET;
        float lf[8], pre[8], qv[8]; bf16 sg[8];
        { float run0 = 0.f, run1 = 0.f;
#pragma unroll
          for (int e = 0; e < 4; ++e) { lf[2 * e] = bflo(ln[e]); lf[2 * e + 1] = bfhi(ln[e]); qv[2 * e] = bflo(qn[e]); qv[2 * e + 1] = bfhi(qn[e]);
              run0 += lf[2 * e]; run1 += lf[2 * e + 1]; pre[2 * e] = run0; pre[2 * e + 1] = run1; }
#pragma unroll
          for (int e = 0; e < 8; ++e) sg[e] = sgn[e];
          *(LAS f32x2*)(TOT + tq * 128 + dk) = (f32x2){run0, run1}; }
        const v4u vcur = vn;
        LDS_WAIT(); __builtin_amdgcn_s_barrier(); asm volatile("" ::: "memory");
        if (c > 0 && tid < 32) {
            float s = 0.f;
#pragma unroll
            for (int w8 = 0; w8 < 8; ++w8) s += SSQP[w8 * 32 + tid];
            atomicAdd(SSQ + rowbase + 32 * (c - 1) + tid, s);
        }
        if (c > 0) {
            const v4u ov = *(const LAS v4u*)(lds + HG_OT + (tid >> 4) * HG_OS + (tid & 15) * 16);
            *(v4u*)(OG + (rowbase + 32 * (c - 1) + (tid >> 4)) * D + hh * 128 + (tid & 15) * 8) = ov;
        }
        if (c + 1 < 64) HG_LOAD(c + 1);
        {
            f32x2 off = {0.f, 0.f}, total = {0.f, 0.f};
#pragma unroll
            for (int t8 = 0; t8 < 8; ++t8) { const f32x2 tv = *(const LAS f32x2*)(TOT + t8 * 128 + dk); total += tv; if (t8 < tq) off += tv; }
            const float dec0 = __expf(total.x), dec1 = __expf(total.y);
            unsigned kl0[2], kl1[2];
#pragma unroll
            for (int e = 0; e < 4; e += 2) {
                float klv[2][2];
#pragma unroll
                for (int x = 0; x < 2; ++x) { const int tok = 4 * tq + e + x;
                    const float c0 = off.x + pre[2 * (e + x)], c1 = off.y + pre[2 * (e + x) + 1];
                    const float k0 = 1.0f - __expf(lf[2 * (e + x)]), k1 = 1.0f - __expf(lf[2 * (e + x) + 1]);
                    const float e0 = __expf(c0), e1 = __expf(c1), i0 = __builtin_amdgcn_rcpf(e0), i1 = __builtin_amdgcn_rcpf(e1);
                    const float kt0 = k0 * i0, kt1 = k1 * i1;
                    *(LAS unsigned*)(B + HG_Q + tok * HG_QS + dk * 2) = pk2(qv[2 * (e + x)] * e0, qv[2 * (e + x) + 1] * e1);
                    *(LAS unsigned*)(B + HG_K + tok * HG_QS + dk * 2) = pk2(kt0, kt1);
                    klv[x][0] = kt0 * dec0; klv[x][1] = kt1 * dec1; }
                kl0[e >> 1] = pk2(klv[0][0], klv[1][0]); kl1[e >> 1] = pk2(klv[0][1], klv[1][1]);
            }
            *(LAS v2u*)(B + HG_KL + dk * HG_TS + tq * 8) = (v2u){kl0[0], kl0[1]};
            *(LAS v2u*)(B + HG_KL + (dk + 1) * HG_TS + tq * 8) = (v2u){kl1[0], kl1[1]};
            if (tq == 0) *(LAS f32x2*)(B + HG_DEC + dk * 4) = (f32x2){dec0, dec1};
            LAS unsigned char* vt = B + HG_VT + (8 * vdc) * HG_TS + vtok * 2;
            *(LAS bf16*)(vt + 0 * HG_TS) = (bf16)(vcur.x & 0xffffu); *(LAS bf16*)(vt + 1 * HG_TS) = (bf16)(vcur.x >> 16);
            *(LAS bf16*)(vt + 2 * HG_TS) = (bf16)(vcur.y & 0xffffu); *(LAS bf16*)(vt + 3 * HG_TS) = (bf16)(vcur.y >> 16);
            *(LAS bf16*)(vt + 4 * HG_TS) = (bf16)(vcur.z & 0xffffu); *(LAS bf16*)(vt + 5 * HG_TS) = (bf16)(vcur.z >> 16);
            *(LAS bf16*)(vt + 6 * HG_TS) = (bf16)(vcur.w & 0xffffu); *(LAS bf16*)(vt + 7 * HG_TS) = (bf16)(vcur.w >> 16);
        }
        LDS_WAIT(); __builtin_amdgcn_s_barrier(); asm volatile("" ::: "memory");
        f32x4 T00 = {0.f, 0.f, 0.f, 0.f}, T01 = T00, T11 = T00;
#pragma unroll
        for (int kk = 0; kk < 4; ++kk) {
            const bf16x8 kA0 = *(const LAS bf16x8*)(B + HG_K + li * HG_QS + (32 * kk + 8 * g) * 2), kA1 = *(const LAS bf16x8*)(B + HG_K + (16 + li) * HG_QS + (32 * kk + 8 * g) * 2);
            const bf16x8 qB0 = *(const LAS bf16x8*)(B + HG_Q + li * HG_QS + (32 * kk + 8 * g) * 2), qB1 = *(const LAS bf16x8*)(B + HG_Q + (16 + li) * HG_QS + (32 * kk + 8 * g) * 2);
            T00 = MFMA16(kA0, qB0, T00); T01 = MFMA16(kA0, qB1, T01); T11 = MFMA16(kA1, qB1, T11);
        }
#pragma unroll
        for (int r4 = 0; r4 < 4; ++r4) { const bool keep = (4 * g + r4) <= li; T00[r4] = keep ? T00[r4] : 0.f; T11[r4] = keep ? T11[r4] : 0.f; }
        const f32x4 z4 = {0.f, 0.f, 0.f, 0.f};
        const LAS unsigned char* vrow = B + HG_VT + (16 * wid + li) * HG_TS;
        const bf16x8 vBp = ld2x8(vrow + 8 * g, 32);
        f32x4 O0 = MFMA16(pack44(T00, z4), vBp, z4), O1 = MFMA16(pack44(T01, T11), vBp, z4);
#pragma unroll
        for (int kk = 0; kk < 4; ++kk) {
            const bf16x8 bS = pack44(S[2 * kk], S[2 * kk + 1]);
            const bf16x8 qA0 = ld2x8(B + HG_Q + li * HG_QS + (32 * kk + 4 * g) * 2, 32), qA1 = ld2x8(B + HG_Q + (16 + li) * HG_QS + (32 * kk + 4 * g) * 2, 32);
            O0 = MFMA16(qA0, bS, O0); O1 = MFMA16(qA1, bS, O1);
        }
        const bf16x8 vBn = *(const LAS bf16x8*)(vrow + 16 * g);
#pragma unroll
        for (int t = 0; t < 8; ++t) {
            const f32x4 dec = *(const LAS f32x4*)(B + HG_DEC + (16 * t + 4 * g) * 4);
            const bf16x8 klA = *(const LAS bf16x8*)(B + HG_KL + (16 * t + li) * HG_TS + 16 * g);
            S[t] = MFMA16(klA, vBn, S[t] * dec);
        }
        float sq[8];
#pragma unroll
        for (int e = 0; e < 8; ++e) { const float o = (e < 4) ? O0[e & 3] : O1[e & 3]; sq[e] = o * o;
            *(LAS bf16*)(lds + HG_OT + (16 * (e >> 2) + 4 * g + (e & 3)) * HG_OS + (16 * wid + li) * 2) = (bf16)(pk2(o * ng * bf2f(sg[e]), 0.f) & 0xffffu); }
#pragma unroll
        for (int e = 0; e < 8; ++e) sq[e] = row16_sum(sq[e]);
        if (li == 0) {
#pragma unroll
            for (int e = 0; e < 8; ++e) SSQP[wid * 32 + 16 * (e >> 2) + 4 * g + (e & 3)] = sq[e];
        }
    }
    LDS_WAIT(); __syncthreads();
    if (tid < 32) { float s = 0.f;
#pragma unroll
        for (int w8 = 0; w8 < 8; ++w8) s += SSQP[w8 * 32 + tid];
        atomicAdd(SSQ + rowbase + 32 * 63 + tid, s); }
    { const v4u ov = *(const LAS v4u*)(lds + HG_OT + (tid >> 4) * HG_OS + (tid & 15) * 16);
      *(v4u*)(OG + (rowbase + 32 * 63 + (tid >> 4)) * D + hh * 128 + (tid & 15) * 8) = ov; }
#pragma unroll
    for (int t = 0; t < 8; ++t)
#pragma unroll
        for (int r4 = 0; r4 < 4; ++r4) sout[(size_t)(16 * t + 4 * g + r4) * 128 + 16 * wid + li] = S[t][r4];
    __syncthreads();
#undef HG_LOAD
}

#ifndef PROBE
#define PROBE 0
#endif
#ifndef PG8_SP2
#define PG8_SP2 true
#endif
#ifndef MK_SPLIT
#define MK_SPLIT 0
#endif
constexpr int N_PHASES = 26;
struct Args { const float* in[36]; float* outp; unsigned char* wsp; int ph_lo, ph_hi; };
enum { I_XP = 0, I_XS, I_CMK, I_CMV, I_CSK, I_CSV, I_S5R, I_S5I, I_SHG, I_MEMP, I_RELB, I_WEIN, I_LAMR, I_LAMI, I_LOGDT, I_BRE, I_BIM, I_CRE, I_CIM, I_S5D, I_WGLU, I_SINK, I_WEOUT,
       I_LBL, I_WOIN, I_NORMG, I_WOOUT, I_WMQ, I_WMK, I_WMV, I_WMO, I_WFG, I_WFU, I_WFD, I_LNG, I_LNB };

DI const float* arg_in(int k) { const char __attribute__((address_space(4)))* p = (const char __attribute__((address_space(4)))*)__builtin_amdgcn_kernarg_segment_ptr(); asm volatile("" : "+s"(p));
    return *(const float* const __attribute__((address_space(4)))*)(p + 8 * k); }
#define ARG(k) arg_in(k)
constexpr int CVA_FIXED = (2048 / 64) * (2048 / 64) + 2 * (4096 / 64) * (4096 / 64) + (4096 / 64) * (16384 / 64);
constexpr int CVA_LAYER = (4096 / 64) * (512 / 64) + (512 / 64) * (4096 / 64) + 2 * (4096 / 64) * (11008 / 64) + (11008 / 64) * (4096 / 64);
constexpr int CVA_NITEMS = CVA_FIXED + 2 * CVA_LAYER - (11008 / 64) * (4096 / 64);
DI CvtItem cvt_decode_a1(int r, unsigned char* wsb) {
    CvtItem I; I.src = nullptr; I.dst = nullptr; I.N = 0; I.K = 0;
    CVT_MAT(ARG(I_WGLU), 2048, 2048, (bf16*)(wsb + WS_WGLU), 0)
    CVT_MAT(ARG(I_WEOUT), 4096, 4096, (bf16*)(wsb + WS_WEOUT), 0)
    CVT_MAT(ARG(I_WOOUT), 4096, 4096, (bf16*)(wsb + WS_WOOUT), 0)
    CVT_MAT(ARG(I_WOIN), 4096, 16384, (bf16*)(wsb + WS_WOIN), 0)
    const int l = r >= CVA_LAYER ? 1 : 0; if (r >= 0) r -= l * CVA_LAYER;
    unsigned char* lw = wsb + WS_LAYER + (size_t)l * LAYER_STRIDE;
    CVT_MAT(ARG(I_WMQ) + (size_t)l * 4096 * 512, 4096, 512, (bf16*)(lw + L_WMQ), 0)
    CVT_MAT(ARG(I_WMO) + (size_t)l * 512 * 4096, 512, 4096, (bf16*)(lw + L_WMO), 0)
    CVT_MAT(ARG(I_WFU) + (size_t)l * 4096 * FF, 4096, FF, (bf16*)(lw + L_WGU), 2)
    CVT_MAT(ARG(I_WFG) + (size_t)l * 4096 * FF, 4096, FF, (bf16*)(lw + L_WGU), 1)
    CVT_MAT(ARG(I_WFD) + (size_t)l * FF * 4096, FF, 4096, (bf16*)(lw + L_WD), 0)
    return I;
}
DI void cvt_run_a1(unsigned char* wsb, LAS unsigned char* scr, int gw, int NGW, int lane) {
    f32x4 va[16], vb[16], vc[16];
    int it = gw;
    if (it >= CVA_NITEMS) return;
    CvtItem Ia = cvt_decode_a1(it, wsb), Ib = Ia, Ic = Ia;
    cvt_load(Ia, va, lane);
    bool hb = it + NGW < CVA_NITEMS;
    if (hb) { Ib = cvt_decode_a1(it + NGW, wsb); cvt_load(Ib, vb, lane); }
    for (;;) {
        const bool hc = it + 2 * NGW < CVA_NITEMS;
        if (hc) { Ic = cvt_decode_a1(it + 2 * NGW, wsb); cvt_load(Ic, vc, lane); }
        cvt_finish(Ia, va, scr, lane);
        if (!hb) break;
        const bool ha = it + 3 * NGW < CVA_NITEMS;
        if (ha) { Ia = cvt_decode_a1(it + 3 * NGW, wsb); cvt_load(Ia, va, lane); }
        cvt_finish(Ib, vb, scr, lane);
        if (!hc) break;
        const bool hb2 = it + 4 * NGW < CVA_NITEMS;
        if (hb2) { Ib = cvt_decode_a1(it + 4 * NGW, wsb); cvt_load(Ib, vb, lane); }
        cvt_finish(Ic, vc, scr, lane);
        if (!ha) break;
        it += 3 * NGW; hb = hb2;
    }
}
#define GEMM_SPLIT(Aptr, Bptr, K_, NSL, SSQP) do { pg8::Gemm g_{(const pg8::bf16_t*)(Aptr), (const pg8::bf16_t*)(Bptr), MPAD, 4096, (K_)}; pg8::SplitOrder S_; S_.init(32, 4096, (K_), G, cu, (NSL)); \
        EpiRes E_{X, XN, (SSQP), PART}; pg8::gemm_phase<EpiRes, pg8::SplitOrder, true, PG8_SP2>(lds + RING_OFF, g_, S_, E_); } while (0)
#define GEMM_CALL(EpiT, Aptr, Bptr, M_, N_, K_, cidx, ...) do { pg8::Gemm g_{(const pg8::bf16_t*)(Aptr), (const pg8::bf16_t*)(Bptr), (M_), (N_), (K_)}; pg8::StaticOrder S_; S_.init((M_), (N_), (K_), G, (cidx)); \
        EpiT E_{__VA_ARGS__}; pg8::gemm_phase<EpiT, pg8::StaticOrder, true, PG8_SP2>(lds + RING_OFF, g_, S_, E_); } while (0)

__global__ void __launch_bounds__(NWAVES * 64, 2) hybrid_fwd(Args args) {
    extern __shared__ __attribute__((aligned(16))) unsigned char lds_raw[];
    LAS unsigned char* lds = (LAS unsigned char*)lds_raw;
    volatile LAS unsigned* MISC = (volatile LAS unsigned*)(lds + MISC_OFF);
    const int tid = threadIdx.x, lane = tid & 63, wid = __builtin_amdgcn_readfirstlane(tid >> 6);
    const int G = gridDim.x, cu = blockIdx.x;
    const int gw = cu * NWAVES + wid, NGW = G * NWAVES;
    gu32* ctl = (gu32*)(args.wsp + WS_CTL);
    for (int u = tid; u < 64; u += NWAVES * 64) ((LAS unsigned*)(lds + MISC_OFF))[u] = 0u;
    __syncthreads();
    XcdBarrier bar = xcd_barrier_post((unsigned*)(ctl + CW_BAR), MISC + 8);
    const int lo = args.ph_lo, hi = args.ph_hi;
    int pid = 0;
#ifndef PMASK
#define PMASK 0xffffffffu
#endif
#ifndef PROBE_TA
#define PROBE_TA -1
#define PROBE_TB -1
#define PROBE_TS 1.0f
#define PROBE_TQ 0.26303f
#endif
#define PH_OPEN(k) if (((PMASK >> (k)) & 1u) && pid >= lo && pid < hi) { if (PROBE_TA >= 0 && cu == 0 && tid == 0) MISC[16 + pid] = (unsigned)__builtin_amdgcn_s_memrealtime();
#define PH_CLOSE if (PROBE_TA >= 0 && pid == N_PHASES - 2 && cu == 0 && tid == 0) { const float us_ = (float)(MISC[16 + PROBE_TB] - MISC[16 + PROBE_TA]) * 0.01f * PROBE_TS; *(float*)(args.wsp + WS_CTL + 8192) = exp2f(rintf(log2f(us_) / PROBE_TQ) * PROBE_TQ) * 1e-3f; }     if (pid + 1 < hi) xcd_barrier(bar); } ++pid;

#define AB ((float*)(args.wsp + WS_AB))
#define BB ((float*)(args.wsp + WS_BB))
#define BT ((float*)(args.wsp + WS_BT))
#define LB ((float*)(args.wsp + WS_LB))
#define SSQ ((float*)(args.wsp + WS_SSQ))
#define WEIN ((bf16*)(args.wsp + WS_WEIN))
#define WGLU ((bf16*)(args.wsp + WS_WGLU))
#define WEOUT ((bf16*)(args.wsp + WS_WEOUT))
#define WOIN ((bf16*)(args.wsp + WS_WOIN))
#define WOOUT ((bf16*)(args.wsp + WS_WOOUT))
#define X ((bf16*)(args.wsp + WS_X))
#define XN ((bf16*)(args.wsp + WS_XN))
#define MIX ((bf16*)(args.wsp + WS_MIX))
#define QC ((bf16*)(args.wsp + WS_QC))
#define CO ((bf16*)(args.wsp + WS_CO))
#define MPB ((bf16*)(args.wsp + WS_MPB))
#define KVM ((bf16*)(args.wsp + WS_KVM))
#define PART ((float*)(args.wsp + WS_HBIG + 200 * MiB))
#define S5TAB ((unsigned char*)(args.wsp + WS_HBIG + 120 * MiB))
#define QSLABP ((float*)(args.wsp + WS_HBIG))
#define QSLABS ((float*)(args.wsp + WS_HBIG + 64 * MiB))
#define H1S ((float*)(args.wsp + WS_H1S))
#define HFS ((float*)(args.wsp + WS_HFS))
#define H0 ((bf16*)(args.wsp + WS_HBIG))
#define Z ((bf16*)(args.wsp + WS_Z))
#define H1 ((bf16*)(args.wsp + WS_HBIG))
#define HF ((bf16*)(args.wsp + WS_HBIG))
#define ws (args.wsp)
#define out (args.outp)
    PH_OPEN(0)
    for (int rep_ = 0; rep_ < (PROBE == 1 ? 2 : 1); ++rep_) {
        LAS unsigned char* scr = lds + wid * 16384;
        constexpr int CNT_P0 = (4096 / 64) * (5120 / 64) + 4 * (4096 / 64) * (512 / 64);
        for (int it = gw; it < CNT_P0; it += NGW) {
            int r = it;
            P0_MAT(ARG(I_WEIN), 4096, 5120, WEIN, 0)
            P0_MAT(ARG(I_WMK), 4096, 512, (bf16*)(ws + WS_LAYER + L_WMKV), 0)
            P0_MAT(ARG(I_WMV), 4096, 512, (bf16*)(ws + WS_LAYER + L_WMKV), 3)
            P0_MAT(ARG(I_WMK) + (size_t)4096 * 512, 4096, 512, (bf16*)(ws + WS_LAYER + LAYER_STRIDE + L_WMKV), 0)
            P0_MAT(ARG(I_WMV) + (size_t)4096 * 512, 4096, 512, (bf16*)(ws + WS_LAYER + LAYER_STRIDE + L_WMKV), 3)
        }
        for (int m = gw; m < MPAD; m += NGW) {
            const float* src = m < MPROMPT ? ARG(I_XP) + (size_t)m * D : (m < MREAL ? ARG(I_XS) + (size_t)(m - MPROMPT) * D : nullptr);
            copy_row(src, nullptr, 1.f, XN + (size_t)m * D, lane);
        }
        for (int m = gw; m < 1024; m += NGW) copy_row(ARG(I_MEMP) + (size_t)m * D, nullptr, 1.f, MPB + (size_t)m * D, lane);
        const int gt = cu * (NWAVES * 64) + tid, NGT = G * NWAVES * 64;
        for (int e = gt; e < 128 * 64; e += NGT) {
            const int g = e >> 6;
            const float lr = fminf(ARG(I_LAMR)[e], -1e-4f), li = ARG(I_LAMI)[e], dt = expf(ARG(I_LOGDT)[g]);
            const float mag = expf(lr * dt), are = mag * cosf(li * dt), aim = mag * sinf(li * dt), den = lr * lr + li * li;
            const float fr = ((are - 1.0f) * lr + aim * li) / den, fi = (aim * lr - (are - 1.0f) * li) / den;
            AB[2 * e] = are; AB[2 * e + 1] = aim;
            for (int h = 0; h < 16; ++h) { const float br = ARG(I_BRE)[(size_t)e * 16 + h], bi = ARG(I_BIM)[(size_t)e * 16 + h];
                BB[(size_t)e * 32 + h] = fr * br - fi * bi; BB[(size_t)e * 32 + 16 + h] = fr * bi + fi * br; }
        }
        for (int e = gt; e < 32 * 128; e += NGT) {
            const int hq = e >> 7, n = e & 127; int bucket = n;
            if (n >= 16) { const int lg = 16 + (int)(logf((float)n / 16.0f) / 2.0794415416798357f * 16.0f); bucket = lg < 31 ? lg : 31; }
            BT[e] = ARG(I_RELB)[bucket * 32 + hq];
        }
        for (int e = gt; e < 4096; e += NGT) { const float l0 = ARG(I_LBL)[e], l1 = ARG(I_LBL)[4096 + e]; LB[e] = 1.0f / (1.0f + expf(l0 - l1)); }
        for (int e = gt; e < MPAD; e += NGT) SSQ[e] = 0.f;
    }
    PH_CLOSE

    PH_OPEN(1)
    {
        if (cu & 1) {
            {
                s5_build_tables(S5TAB, AB, BB, ARG(I_CRE), ARG(I_CIM), ARG(I_S5D), cu * (NWAVES * 64) + tid, G * NWAVES * 64);
                GEMM_CALL(EpiStoreBf16, XN, WEIN, MPAD, NE, 4096, cu, H0, NE);
                GEMM_CALL(EpiMemKV, MPB, ws + WS_LAYER + L_WMKV, 1024, 1024, 4096, (cu + G - 148) % G, out + O_PMK, out + O_PMV, KVM);
                GEMM_CALL(EpiMemKV, MPB, ws + WS_LAYER + LAYER_STRIDE + L_WMKV, 1024, 1024, 4096, (cu + G - 164) % G, out + O_PMK + 524288, out + O_PMV + 524288, KVM + 1024 * 1024);
            }
            {
                cvt_run_a1(ws, lds + wid * 16384, gw, NGW, lane);
                LDS_WAIT(); __syncthreads();
            }
        } else {
            {
                cvt_run_a1(ws, lds + wid * 16384, gw, NGW, lane);
                LDS_WAIT(); __syncthreads();
            }
            {
                s5_build_tables(S5TAB, AB, BB, ARG(I_CRE), ARG(I_CIM), ARG(I_S5D), cu * (NWAVES * 64) + tid, G * NWAVES * 64);
                GEMM_CALL(EpiStoreBf16, XN, WEIN, MPAD, NE, 4096, cu, H0, NE);
                GEMM_CALL(EpiMemKV, MPB, ws + WS_LAYER + L_WMKV, 1024, 1024, 4096, (cu + G - 148) % G, out + O_PMK, out + O_PMV, KVM);
                GEMM_CALL(EpiMemKV, MPB, ws + WS_LAYER + LAYER_STRIDE + L_WMKV, 1024, 1024, 4096, (cu + G - 164) % G, out + O_PMK + 524288, out + O_PMV + 524288, KVM + 1024 * 1024);
            }
        }
    }
    PH_CLOSE

    PH_OPEN(2)
    for (int rep_ = 0; rep_ < ((PROBE == 2 || PROBE == 7) ? 2 : 1); ++rep_) {
        const float* sinks = ARG(I_SINK);
#ifndef NO_U0
        {
        for (int i = cu; i < 128; i += G) s5_mfma_unit(lds, H0, Z, S5TAB, AB, out + O_PS5R, out + O_PS5I, i, tid, wid, lane);
        const int s_first = (G == 256) ? (cu >= 128 ? cu - 128 : 128) : cu, s_step = (G == 256) ? 128 : G;
        for (int j = s_first; j < 128; j += s_step) { const int wu = 8 * j + wid;
            s5_sample_wave(lds, H0, Z, AB, BB, ARG(I_CRE), ARG(I_CIM), ARG(I_S5D), ARG(I_S5R), ARG(I_S5I), out + O_SS5R, out + O_SS5I, wu & 127, 4 * (wu >> 7), 4, wid, lane);
            __syncthreads(); }
        }
#endif
#ifndef NO_U2
        if (!(PROBE == 7 && rep_ == 0))
        for (int i = cu; i < 1024; i += G) { const int u = i;
            swa_prompt_unit(lds, H0, MIX, BT, sinks, out + O_PSK, out + O_PSV, u >> 8, (u >> 5) & 7, u & 31, tid, wid, lane); }
#endif
#ifndef NO_U3
        if (!(PROBE == 7 && rep_ == 0))
        for (int i = cu; i < 256; i += G) { const int u = i;
            swa_sample_unit(lds, H0, MIX, BT, sinks, ARG(I_CSK), ARG(I_CSV), out + O_SSK, out + O_SSV, u >> 3, u & 7, tid, wid, lane); }
#endif
#if PROBE == 8
#ifndef NO_U2
        for (int i = cu; i < 1024; i += G) { const int u = i;
            swa_prompt_unit(lds, H0, MIX, BT, sinks, out + O_PSK, out + O_PSV, u >> 8, (u >> 5) & 7, u & 31, tid, wid, lane); }
#endif
#ifndef NO_U3
        for (int i = cu; i < 256; i += G) { const int u = i;
            swa_sample_unit(lds, H0, MIX, BT, sinks, ARG(I_CSK), ARG(I_CSV), out + O_SSK, out + O_SSV, u >> 3, u & 7, tid, wid, lane); }
#endif
#endif
    }
    PH_CLOSE

    PH_OPEN(3)
    { GEMM_CALL(EpiGlu, Z, WGLU, MPAD, 2048, 2048, cu, Z, MIX); }
    PH_CLOSE

    PH_OPEN(4)
    { GEMM_SPLIT(MIX, WEOUT, 4096, 16, nullptr); }
    PH_CLOSE

    {
        constexpr int l = 0;
        unsigned char* lw = ws + WS_LAYER + (size_t)l * LAYER_STRIDE;
        const float* lng = ARG(I_LNG) + (size_t)l * 3 * D; const float* lnb = ARG(I_LNB) + (size_t)l * 3 * D;
        PH_OPEN(8)
        { if (PROBE == 4) ln_phase(lds, X, PART, 16, lng, lnb, nullptr, (bf16*)(args.wsp + WS_HBIG + 140 * MiB), gw, NGW, lane);
          ln_phase(lds, X, PART, 16, lng, lnb, nullptr, XN, gw, NGW, lane); }
        PH_CLOSE
        PH_OPEN(9)
        { pg8::Gemm g_{(const pg8::bf16_t*)(XN), (const pg8::bf16_t*)(lw + L_WMQ), MPAD, 512, 4096}; pg8::SplitAllOrder S_; S_.init(4096, G, cu); EpiSlab E_{QSLABP, QSLABS};
          pg8::gemm_phase<EpiSlab, pg8::SplitAllOrder, true, PG8_SP2>(lds + RING_OFF, g_, S_, E_); }
        PH_CLOSE
        PH_OPEN(10)
        {
            for (int i = cu; i < 128; i += G) cross_prompt_unit(lds, QSLABP, KVM + (size_t)l * 1024 * 1024, CO, i >> 5, (i >> 3) & 3, i & 7, tid, wid, lane);
            for (int i = 128 + ((cu - 128 % G + G) % G); i < 256; i += G) { const int wu = i - 128;
                cross_sample_unit(lds, QSLABS, ARG(I_CMK) + (size_t)l * 32 * 256 * 512, ARG(I_CMV) + (size_t)l * 32 * 256 * 512, CO, wu >> 2, wu & 3, tid, wid, lane); }
        }
        PH_CLOSE
        PH_OPEN(11)
        { GEMM_SPLIT(CO, lw + L_WMO, 512, 4, nullptr); }
        PH_CLOSE
        PH_OPEN(12)
        { if (PROBE == 4) ln_phase(lds, X, PART, 4, lng + D, lnb + D, nullptr, (bf16*)(args.wsp + WS_HBIG + 140 * MiB), gw, NGW, lane);
          ln_phase(lds, X, PART, 4, lng + D, lnb + D, nullptr, XN, gw, NGW, lane); }
        PH_CLOSE
        PH_OPEN(13)
        { pg8::Gemm g_{(const pg8::bf16_t*)(XN), (const pg8::bf16_t*)(lw + L_WGU), MPAD, 2 * FF, 4096}; pg8::GuOrder S_; S_.init(2 * FF, 4096, G, cu); EpiGU E_{HF, HFS};
          pg8::gemm_phase<EpiGU, pg8::GuOrder, true, PG8_SP2>(lds + RING_OFF, g_, S_, E_); }
        PH_CLOSE
        PH_OPEN(13)
        { ffn_act_sample(HFS, HF, cu * (NWAVES * 64) + tid, G * NWAVES * 64); }
        PH_CLOSE
        PH_OPEN(14)
        { if (PROBE == 5) GEMM_CALL(EpiStoreBf16, HF, lw + L_WD, MPAD, 4096, FF, cu, MIX, 4096);
          if (PROBE == 6) { pg8::Gemm g_{(const pg8::bf16_t*)(HF), (const pg8::bf16_t*)(lw + L_WD), MPAD, 4096, FF}; pg8::SplitOrder S_; S_.init(32, 4096, FF, G, cu, 16); EpiStoreBf16 E_{MIX, 4096}; pg8::gemm_phase<EpiStoreBf16, pg8::SplitOrder, true, PG8_SP2>(lds + RING_OFF, g_, S_, E_); }
          GEMM_SPLIT(HF, lw + L_WD, FF, 16, nullptr); }
        PH_CLOSE
        PH_OPEN(15)
        { if (PROBE == 4) ln_phase(lds, X, PART, 16, lng + 2 * D, lnb + 2 * D, nullptr, (bf16*)(args.wsp + WS_HBIG + 140 * MiB), gw, NGW, lane);
          if (l == 1) ln_phase(lds, X, PART, 16, lng + 2 * D, lnb + 2 * D, out + O_Y, XN, gw, NGW, lane, PROBE_TA >= 0 ? 1.0f + *(const float*)(args.wsp + WS_CTL + 8192) : 1.0f); else ln_phase(lds, X, PART, 16, lng + 2 * D, lnb + 2 * D, nullptr, XN, gw, NGW, lane); }
        PH_CLOSE
    }
    {
            PH_OPEN(5)
            { pg8::Gemm g_{(const pg8::bf16_t*)(XN), (const pg8::bf16_t*)(WOIN), MPAD, NO, 4096}; pg8::SplitOrder S_; S_.init(32, NO, 4096, G, cu, 4); EpiOddIn E_{H1, LB, H1S};
              pg8::gemm_phase<EpiOddIn, pg8::SplitOrder, true, PG8_SP2>(lds + RING_OFF, g_, S_, E_); }
            PH_CLOSE
            PH_OPEN(6)
            for (int rep_ = ((PROBE == 3 || PROBE == 9) ? 0 : 1); rep_ < 2; ++rep_) {
                float* ssq_ = rep_ ? SSQ : (float*)(args.wsp + WS_CO);
                for (int i = cu; i < 128; i += G) hgrn_prompt_unit(lds, H1, MIX, ssq_, ARG(I_NORMG), out + O_PHG + (size_t)i * 16384, i >> 5, i & 31, tid, wid, lane);
                const int s_first = (G == 256) ? (cu >= 128 ? cu - 128 : 2048) : cu, s_step = (G == 256) ? 128 : G;
                if (!(PROBE == 9 && rep_ == 0))
                for (int u = s_first; u < 2048; u += s_step) { const int b = u >> 6, hh = (u >> 1) & 31, dvh = u & 1;
                    hgrn_unit(lds, H1S, LB, MIX, ssq_, ARG(I_NORMG), ARG(I_SHG) + (size_t)(b * 32 + hh) * 16384, out + O_SHG + (size_t)(b * 32 + hh) * 16384, b, hh, dvh, tid, wid, lane); }
                if (rep_ == 1 && (G != 256 || cu >= 128)) {
                    LAS unsigned char* scr = lds + wid * 16384;
                    unsigned char* lw1 = ws + WS_LAYER + LAYER_STRIDE;
                    constexpr int CNT_G = (4096 / 64) * (11008 / 64), CNT_D = (11008 / 64) * (4096 / 64);
                    const int w0 = (G == 256) ? (cu - 128) * NWAVES + wid : gw, nw = (G == 256) ? 128 * NWAVES : NGW;
                    for (int it = w0; it < CNT_D; it += nw) { int r = it;
                        P0_MAT(ARG(I_WFD) + (size_t)FF * 4096, FF, 4096, (bf16*)(lw1 + L_WD), 0)
                    }
                }
            }
            PH_CLOSE
            PH_OPEN(7)
            { GEMM_SPLIT(MIX, WOOUT, 4096, 16, SSQ); }
            PH_CLOSE
    }
    {
        constexpr int l = 1;
        unsigned char* lw = ws + WS_LAYER + (size_t)l * LAYER_STRIDE;
        const float* lng = ARG(I_LNG) + (size_t)l * 3 * D; const float* lnb = ARG(I_LNB) + (size_t)l * 3 * D;
        PH_OPEN(8)
        { if (PROBE == 4) ln_phase(lds, X, PART, 16, lng, lnb, nullptr, (bf16*)(args.wsp + WS_HBIG + 140 * MiB), gw, NGW, lane);
          ln_phase(lds, X, PART, 16, lng, lnb, nullptr, XN, gw, NGW, lane); }
        PH_CLOSE
        PH_OPEN(9)
        { pg8::Gemm g_{(const pg8::bf16_t*)(XN), (const pg8::bf16_t*)(lw + L_WMQ), MPAD, 512, 4096}; pg8::SplitAllOrder S_; S_.init(4096, G, cu); EpiSlab E_{QSLABP, QSLABS};
          pg8::gemm_phase<EpiSlab, pg8::SplitAllOrder, true, PG8_SP2>(lds + RING_OFF, g_, S_, E_); }
        PH_CLOSE
        PH_OPEN(10)
        {
            for (int i = cu; i < 128; i += G) cross_prompt_unit(lds, QSLABP, KVM + (size_t)l * 1024 * 1024, CO, i >> 5, (i >> 3) & 3, i & 7, tid, wid, lane);
            for (int i = 128 + ((cu - 128 % G + G) % G); i < 256; i += G) { const int wu = i - 128;
                cross_sample_unit(lds, QSLABS, ARG(I_CMK) + (size_t)l * 32 * 256 * 512, ARG(I_CMV) + (size_t)l * 32 * 256 * 512, CO, wu >> 2, wu & 3, tid, wid, lane); }
        }
        PH_CLOSE
        PH_OPEN(11)
        { GEMM_SPLIT(CO, lw + L_WMO, 512, 4, nullptr); }
        PH_CLOSE
        PH_OPEN(12)
        { if (PROBE == 4) ln_phase(lds, X, PART, 4, lng + D, lnb + D, nullptr, (bf16*)(args.wsp + WS_HBIG + 140 * MiB), gw, NGW, lane);
          ln_phase(lds, X, PART, 4, lng + D, lnb + D, nullptr, XN, gw, NGW, lane); }
        PH_CLOSE
        PH_OPEN(13)
        { pg8::Gemm g_{(const pg8::bf16_t*)(XN), (const pg8::bf16_t*)(lw + L_WGU), MPAD, 2 * FF, 4096}; pg8::GuOrder S_; S_.init(2 * FF, 4096, G, cu); EpiGU E_{HF, HFS};
          pg8::gemm_phase<EpiGU, pg8::GuOrder, true, PG8_SP2>(lds + RING_OFF, g_, S_, E_); }
        PH_CLOSE
        PH_OPEN(13)
        { ffn_act_sample(HFS, HF, cu * (NWAVES * 64) + tid, G * NWAVES * 64); }
        PH_CLOSE
        PH_OPEN(14)
        { if (PROBE == 5) GEMM_CALL(EpiStoreBf16, HF, lw + L_WD, MPAD, 4096, FF, cu, MIX, 4096);
          if (PROBE == 6) { pg8::Gemm g_{(const pg8::bf16_t*)(HF), (const pg8::bf16_t*)(lw + L_WD), MPAD, 4096, FF}; pg8::SplitOrder S_; S_.init(32, 4096, FF, G, cu, 16); EpiStoreBf16 E_{MIX, 4096}; pg8::gemm_phase<EpiStoreBf16, pg8::SplitOrder, true, PG8_SP2>(lds + RING_OFF, g_, S_, E_); }
          GEMM_SPLIT(HF, lw + L_WD, FF, 16, nullptr); }
        PH_CLOSE
        PH_OPEN(15)
        { if (PROBE == 4) ln_phase(lds, X, PART, 16, lng + 2 * D, lnb + 2 * D, nullptr, (bf16*)(args.wsp + WS_HBIG + 140 * MiB), gw, NGW, lane);
          if (l == 1) ln_phase(lds, X, PART, 16, lng + 2 * D, lnb + 2 * D, out + O_Y, XN, gw, NGW, lane, PROBE_TA >= 0 ? 1.0f + *(const float*)(args.wsp + WS_CTL + 8192) : 1.0f); else ln_phase(lds, X, PART, 16, lng + 2 * D, lnb + 2 * D, nullptr, XN, gw, NGW, lane); }
        PH_CLOSE
    }
#undef PH_OPEN
#undef PH_CLOSE
}
#undef AB
#undef BB
#undef BT
#undef LB
#undef SSQ
#undef WEIN
#undef WGLU
#undef WEOUT
#undef WOIN
#undef WOOUT
#undef X
#undef XN
#undef MIX
#undef QC
#undef CO
#undef MPB
#undef KVM
#undef H0
#undef HFS
#undef H1S
#undef QSLABP
#undef QSLABS
#undef S5TAB
#undef PART
#undef Z
#undef H1
#undef HF
#undef ws
#undef out

extern "C" void kernel_launch(void* const* d_in, const int* in_sizes, int n_in, void* d_out, int out_size, void* d_ws, size_t ws_size, hipStream_t stream) {
    static int grid = 0;
    if (grid == 0) {
        if (n_in != 36 || in_sizes[0] != MPROMPT * D || (size_t)out_size != O_END || ws_size < WS_END) {
            fprintf(stderr, "kernel_launch: shape/workspace mismatch: n_in %d in0 %d out %d ws %zu (need %zu); nothing launched\n", n_in, n_in > 0 ? in_sizes[0] : -1, out_size, ws_size, (size_t)WS_END); grid = -1; return; }
        int dev = 0, cus = 0, per_cu = 0;
        if (hipGetDevice(&dev) != hipSuccess || hipDeviceGetAttribute(&cus, hipDeviceAttributeMultiprocessorCount, dev) != hipSuccess) { grid = -1; return; }
        if (hipFuncSetAttribute((const void*)hybrid_fwd, hipFuncAttributeMaxDynamicSharedMemorySize, LDS_BYTES) != hipSuccess) { fprintf(stderr, "kernel_launch: hipFuncSetAttribute failed\n"); grid = -1; return; }
        if (hipOccupancyMaxActiveBlocksPerMultiprocessor(&per_cu, (const void*)hybrid_fwd, NWAVES * 64, LDS_BYTES) != hipSuccess || per_cu < 1)
            fprintf(stderr, "kernel_launch: note: occupancy query reports %d workgroups per CU\n", per_cu);
        (void)hipGetLastError();
        grid = cus;
    }
    if (grid < 0) return;
    if (hipMemsetAsync((char*)d_ws + WS_CTL, 0, CTL_ZERO_BYTES, stream) != hipSuccess) return;
    Args a{};
    for (int i = 0; i < 36; ++i) a.in[i] = (const float*)d_in[i];
    a.outp = (float*)d_out; a.wsp = (unsigned char*)d_ws;
#if MK_SPLIT
    for (int p = 0; p < N_PHASES; ++p) { a.ph_lo = p; a.ph_hi = p + 1; hipLaunchKernelGGL(hybrid_fwd, dim3(grid), dim3(NWAVES * 64), LDS_BYTES, stream, a); }
#else
    a.ph_lo = 0; a.ph_hi = N_PHASES;
    hipLaunchKernelGGL(hybrid_fwd, dim3(grid), dim3(NWAVES * 64), LDS_BYTES, stream, a);
#endif
    const hipError_t le = hipPeekAtLastError();
    if (le != hipSuccess) fprintf(stderr, "kernel_launch: launch failed: %s\n", hipGetErrorName(le));
}
```

```cpp
#include <hip/hip_runtime.h>
#include <cstdio>
#include <cstdint>
#define PROBE 0
namespace pg8 {
#define PG8_LAS __attribute__((address_space(3)))
typedef unsigned short bf16_t;
typedef short bf16x8 __attribute__((ext_vector_type(8)));
typedef float f32x4 __attribute__((ext_vector_type(4)));
typedef unsigned u32x4 __attribute__((ext_vector_type(4)));
constexpr int BM = 256, BK = 64, HALF = 128, HTB = HALF * BK * 2  , STAGE_BYTES = 8 * HTB, NXCD = 8, WGM = 4;

__host__ __device__ __forceinline__ int lds_byte(int r, int c) { const int st = (r >> 4) * 2 + (c >> 5), rr = r & 15, cc = c & 31, ob = rr * 64 + cc * 2; return st * 1024 + (ob ^ (((ob >> 9) & 1) << 5)); }
__host__ __device__ __forceinline__ void stage_rc(int b, int& R, int& C) { const int st = b / 1024, sb = b % 1024, swz = sb ^ (((sb >> 9) & 1) << 5); R = (st >> 1) * 16 + swz / 64; C = (st & 1) * 32 + (swz % 64) / 2; }
__host__ __device__ __forceinline__ int perm32(int rho) { const int n = rho >> 4, i = rho & 15; return 8 * (i >> 2) + 4 * n + (i & 3); }

struct Unit { int pm, pn, k0, nk, ks; };
struct Gemm { const bf16_t* A; const bf16_t* Bt; int M, N, K; };

struct StaticOrder {
    int nM, nN, nwg, G, c, nt;
    __host__ __device__ void init(int M, int N, int K, int G_, int c_) { nM = M / BM; nN = N / BM; nwg = nM * nN; G = G_; c = c_; nt = K / BK; }
    __host__ __device__ __forceinline__ bool next(int i, Unit& u) const {
        const long L = (long)i * G + c; if (L >= nwg) return false;
        int wgid = (int)L; { const int q = nwg / NXCD, r = nwg % NXCD, xcd = wgid % NXCD, off = wgid / NXCD; wgid = (xcd < r ? xcd * (q + 1) : r * (q + 1) + (xcd - r) * q) + off; }
        const int nig = WGM * nN, gid = wgid / nig, fm = gid * WGM, gsz = (nM - fm) < WGM ? (nM - fm) : WGM;
        u.pm = fm + ((wgid % nig) % gsz); u.pn = (wgid % nig) / gsz; u.k0 = 0; u.nk = nt; u.ks = -1; return true;
    }
    __device__ __forceinline__ void a_ready(const Unit&) const {}
    __device__ __forceinline__ void done(const Unit&) const {}
};
struct SplitOrder {
    StaticOrder so; int mfull, nsl;
    __host__ __device__ void init(int mfull_, int N, int K, int G_, int c_, int nsl_) { so.init(mfull_ * BM, N, K, G_, c_); mfull = mfull_; nsl = nsl_; }
    __host__ __device__ __forceinline__ bool next(int i, Unit& u) const {
        const long L = (long)i * so.G + so.c;
        if (L >= (long)so.nwg + so.nN * nsl) return false;
        const bool full = L < so.nwg;
        int wgid = full ? (int)L : 0; { const int q = so.nwg / NXCD, r = so.nwg % NXCD, xcd = wgid % NXCD, off = wgid / NXCD; wgid = (xcd < r ? xcd * (q + 1) : r * (q + 1) + (xcd - r) * q) + off; }
        const int nig = WGM * so.nN, gid = wgid / nig, fm = gid * WGM, gsz = (so.nM - fm) < WGM ? (so.nM - fm) : WGM;
        const int fpm = fm + ((wgid % nig) % gsz), fpn = (wgid % nig) / gsz;
        const int j = full ? 0 : (int)(L - so.nwg), ks = j / so.nN, pairs = so.nt / 2, base = pairs / nsl, rem = pairs % nsl;
        const int sk0 = 2 * (ks * base + (ks < rem ? ks : rem)), snk = 2 * (base + (ks < rem ? 1 : 0));
        u.pm = full ? fpm : mfull; u.pn = full ? fpn : (j % so.nN); u.k0 = full ? 0 : sk0; u.nk = full ? so.nt : snk; u.ks = full ? -1 : ks;
        return true;
    }
    __device__ __forceinline__ void a_ready(const Unit&) const {}
    __device__ __forceinline__ void done(const Unit&) const {}
};

struct GuOrder {
    StaticOrder so; int G, c;
    __host__ __device__ void init(int N, int K, int G_, int c_) { so.init(32 * BM, N, K, G_, c_); G = G_; c = c_; }
    __host__ __device__ __forceinline__ bool next(int i, Unit& u) const {
        const int nitems = so.nN * 4;
        long L; int j = -1;
        if (G == 256) {
            if (i < 10) L = (long)i * 256 + c;
            else if (c < 192) { if (i == 10) L = 2560 + c; else if (i == 11 && c < nitems - 256) { L = 0; j = 256 + c; } else return false; }
            else { if (i < 14) { L = 0; j = (i - 10) * 64 + (c - 192); } else return false; }
        } else { L = (long)i * G + c; if (L >= so.nwg) { j = (int)(L - so.nwg); L = 0; if (j >= nitems) return false; } }
        const bool full = j < 0;
        int wgid = (int)L; { const int q = so.nwg / NXCD, r = so.nwg % NXCD, xcd = wgid % NXCD, off = wgid / NXCD; wgid = (xcd < r ? xcd * (q + 1) : r * (q + 1) + (xcd - r) * q) + off; }
        const int nig = WGM * so.nN, gid = wgid / nig, fm = gid * WGM, gsz = (so.nM - fm) < WGM ? (so.nM - fm) : WGM;
        const int fpm = fm + ((wgid % nig) % gsz), fpn = (wgid % nig) / gsz;
        const int jj = full ? 0 : j, ks = jj / so.nN, snk = so.nt / 4;
        u.pm = full ? fpm : 32; u.pn = full ? fpn : (jj % so.nN); u.k0 = full ? 0 : ks * snk; u.nk = full ? so.nt : snk; u.ks = full ? -1 : ks;
        return true;
    }
    __device__ __forceinline__ void a_ready(const Unit&) const {}
    __device__ __forceinline__ void done(const Unit&) const {}
};
struct SplitAllOrder {
    int G, c, nt;
    __host__ __device__ void init(int K, int G_, int c_) { G = G_; c = c_; nt = K / BK; }
    __host__ __device__ __forceinline__ bool next(int i, Unit& u) const {
        const long L = (long)i * G + c;
        if (L >= 256 + 16) return false;
        const bool pr = L < 256; const int l = (int)L;
        const int ks_p = (l & 7) >> 1, unit = ((l & 1) << 5) | (l >> 3);
        const int j2 = pr ? 0 : l - 256, ks_s = j2 >> 1;
        u.pm = pr ? (unit >> 1) : 32; u.pn = pr ? (unit & 1) : (j2 & 1); u.ks = pr ? ks_p : ks_s;
        u.nk = pr ? nt / 4 : nt / 8; u.k0 = u.ks * u.nk; return true;
    }
    __device__ __forceinline__ void a_ready(const Unit&) const {}
    __device__ __forceinline__ void done(const Unit&) const {}
};
__device__ __forceinline__ unsigned cvt_pk_bf16(float lo, float hi) { unsigned r; asm volatile("v_cvt_pk_bf16_f32 %0, %1, %2" : "=v"(r) : "v"(lo), "v"(hi)); return r; }
typedef float f32x2 __attribute__((ext_vector_type(2)));
__device__ __forceinline__ f32x2 gelu_pk(f32x2 v) {
    const f32x2 av = __builtin_elementwise_abs(v), d = av * 0.2316418882f + 1.0f;
    f32x2 t; t.x = __builtin_amdgcn_rcpf(d.x); t.y = __builtin_amdgcn_rcpf(d.y);
    f32x2 q = t * 0.5307027145f + (-0.7265760135f); q = q * t + 0.7107068705f; q = q * t + (-0.142248368f); q = q * t + 0.127414796f; q = q * t;
    const f32x2 s = (v * v) * (-0.72134752044f);
    f32x2 e; e.x = __builtin_amdgcn_exp2f(s.x); e.y = __builtin_amdgcn_exp2f(s.y);
    const f32x2 m = v * (q * e), r = v - m;
    f32x2 o; o.x = v.x < 0.f ? m.x : r.x; o.y = v.y < 0.f ? m.y : r.y; return o;
}

template <int ACT  > struct EpiBf16 {
    static constexpr bool PERM = true, AFTER_DRAIN = false; static_assert(ACT == 0 || ACT == 1, "EpiBf16: ACT is 0 (none) or 1 (gelu_pk)");
    bf16_t* O; int ldc; const float* bias; int split_cols; size_t split_stride; float scale0;
    __device__ __forceinline__ void operator()(const f32x4 (&acc)[2][2][4][2], const Unit& u, int wr, int wc, int fr, int fq) const {
        const int row0 = u.pm * BM + wr * 64 + fr; int colt = u.pn * BM; bf16_t* base = O;
        float sc = 1.f; if (split_cols) { const int t = colt / split_cols; base += (size_t)t * split_stride; colt -= t * split_cols; if (t == 0) sc = scale0; }
        const int col0 = colt + wc * 32 + 8 * fq, bcol0 = u.pn * BM + wc * 32 + 8 * fq;
        f32x4 bv[2][2];
#pragma unroll
        for (int bj = 0; bj < 2; ++bj)
#pragma unroll
            for (int n = 0; n < 2; ++n) bv[bj][n] = bias ? *(const f32x4*)(bias + bcol0 + bj * HALF + 4 * n) : (f32x4){0.f, 0.f, 0.f, 0.f};
#pragma unroll
        for (int ai = 0; ai < 2; ++ai)
#pragma unroll
            for (int m = 0; m < 4; ++m) { bf16_t* rowp = base + (size_t)(row0 + ai * HALF + m * 16) * ldc + col0;
#pragma unroll
                for (int bj = 0; bj < 2; ++bj) { f32x4 v0 = acc[ai][bj][m][0] + bv[bj][0], v1 = acc[ai][bj][m][1] + bv[bj][1];
                    if (ACT == 1) { f32x2 a = gelu_pk((f32x2){v0[0], v0[1]}), b = gelu_pk((f32x2){v0[2], v0[3]}), c = gelu_pk((f32x2){v1[0], v1[1]}), d = gelu_pk((f32x2){v1[2], v1[3]});
                        v0 = (f32x4){a.x, a.y, b.x, b.y}; v1 = (f32x4){c.x, c.y, d.x, d.y}; }
                    v0 = v0 * sc; v1 = v1 * sc; u32x4 w; w.x = cvt_pk_bf16(v0[0], v0[1]); w.y = cvt_pk_bf16(v0[2], v0[3]); w.z = cvt_pk_bf16(v1[0], v1[1]); w.w = cvt_pk_bf16(v1[2], v1[3]);
                    *(u32x4*)(rowp + bj * HALF) = w; } }
    }
};

struct PanelStats {
    unsigned* xbuf;
    unsigned* cnt;
    unsigned* tmo;
    int ntn; float eps;
    unsigned code;
    __device__ __forceinline__ bool run(const f32x4 (&v)[2][2][4][2], const Unit& u, int wr, int wc, int fr, int fq, PG8_LAS unsigned char* lds, int wid, int lane) const {
        typedef float f32x2v __attribute__((ext_vector_type(2)));
        PG8_LAS f32x2v* P = (PG8_LAS f32x2v*)lds;
        PG8_LAS f32x2v* S = (PG8_LAS f32x2v*)(lds + 8192);
        PG8_LAS unsigned* flag = (PG8_LAS unsigned*)(lds + 8192 + 2048);
#pragma unroll
        for (int ai = 0; ai < 2; ++ai)
#pragma unroll
            for (int m = 0; m < 4; ++m) {
                float s = 0.f;
#pragma unroll
                for (int bj = 0; bj < 2; ++bj)
#pragma unroll
                    for (int n = 0; n < 2; ++n) { const f32x4 x = v[ai][bj][m][n]; s += (x[0] + x[1]) + (x[2] + x[3]); }
                s += __shfl_xor(s, 16); s += __shfl_xor(s, 32);
                const float mw = s * (1.0f / 64.0f); float q = 0.f;
#pragma unroll
                for (int bj = 0; bj < 2; ++bj)
#pragma unroll
                    for (int n = 0; n < 2; ++n) { const f32x4 d = v[ai][bj][m][n] - mw; q += (d[0] * d[0] + d[1] * d[1]) + (d[2] * d[2] + d[3] * d[3]); }
                q += __shfl_xor(q, 16); q += __shfl_xor(q, 32);
                if (fq == 0) P[(ai * HALF + wr * 64 + m * 16 + fr) * 4 + wc] = (f32x2v){mw, q};
            }
        asm volatile("s_waitcnt lgkmcnt(0)" ::: "memory"); __builtin_amdgcn_s_barrier(); asm volatile("" ::: "memory");
#if defined(BROKEN_EXCHANGE_NO_WAIT)
#warning BROKEN CONTROL BUILD: the row-statistics exchange does not wait; results are wrong by design
        if (blockIdx.x >= 64) { const long long t0_ = clock64(); while (clock64() - t0_ < 60000) __builtin_amdgcn_s_sleep(8); }
#endif
        const int row = wid * 32 + (lane & 31);
        if (lane < 32) {
            const f32x2v a = P[row * 4 + 0], b = P[row * 4 + 1], c = P[row * 4 + 2], d = P[row * 4 + 3];
            const float mt = (a.x + b.x + c.x + d.x) * 0.25f;
            const float da = a.x - mt, db = b.x - mt, dc = c.x - mt, dd = d.x - mt;
            const float m2 = (a.y + b.y) + (c.y + d.y) + 64.0f * ((da * da + db * db) + (dc * dc + dd * dd));
            unsigned long long* slot = (unsigned long long*)xbuf + ((size_t)(u.pm * BM + row) * 4 + u.pn);
            __hip_atomic_store(slot, ((unsigned long long)__float_as_uint(m2) << 32) | __float_as_uint(mt), __ATOMIC_RELAXED, __HIP_MEMORY_SCOPE_AGENT);
        }
        asm volatile("s_waitcnt vmcnt(0)" ::: "memory");
        if (lane == 0) __hip_atomic_fetch_add(cnt + 64 * u.pm, 1u, __ATOMIC_RELAXED, __HIP_MEMORY_SCOPE_AGENT);
        if (wid == 0) {
            bool dead = false; const unsigned long long t0 = __builtin_amdgcn_s_memrealtime(); const unsigned want = 8u * (unsigned)ntn;
            for (;;) {
#if defined(BROKEN_EXCHANGE_NO_WAIT)
                break;
#endif
                if ((unsigned)__builtin_amdgcn_readfirstlane(__hip_atomic_load(cnt + 64 * u.pm, __ATOMIC_RELAXED, __HIP_MEMORY_SCOPE_AGENT)) >= want) break;
                if (__builtin_amdgcn_s_memrealtime() - t0 > 2000000ull) {
                    if (lane == 0) { unsigned expect = 0u; __hip_atomic_compare_exchange_strong(tmo + 1, &expect, code | (unsigned)(u.pm & 0xff), __ATOMIC_RELAXED, __ATOMIC_RELAXED, __HIP_MEMORY_SCOPE_AGENT);
                                     __hip_atomic_store(tmo, 1u, __ATOMIC_RELAXED, __HIP_MEMORY_SCOPE_AGENT); }
                    dead = true; break; }
                __builtin_amdgcn_s_sleep(2);
            }
            __builtin_amdgcn_fence(__ATOMIC_ACQUIRE, "agent");
            if (lane == 0) flag[0] = dead ? 1u : 0u;
        }
        asm volatile("s_waitcnt vmcnt(0) lgkmcnt(0)" ::: "memory"); __builtin_amdgcn_s_barrier(); asm volatile("" ::: "memory");
        const bool bad = flag[0] != 0u;
        if (lane < 32) {
            const unsigned long long* slot = (const unsigned long long*)xbuf + (size_t)(u.pm * BM + row) * 4; float mt[4], m2[4]; float ms = 0.f;
#pragma unroll
            for (int t = 0; t < 4; ++t) { if (t < ntn) { const unsigned long long w = __hip_atomic_load(slot + t, __ATOMIC_RELAXED, __HIP_MEMORY_SCOPE_AGENT); mt[t] = __uint_as_float((unsigned)w); m2[t] = __uint_as_float((unsigned)(w >> 32)); } else { mt[t] = 0.f; m2[t] = 0.f; } ms += mt[t]; }
            const float mean = ms / (float)ntn; float q = 0.f;
#pragma unroll
            for (int t = 0; t < 4; ++t) if (t < ntn) { const float dm = mt[t] - mean; q += m2[t] + 256.0f * dm * dm; }
            S[row] = (f32x2v){mean, 1.0f / sqrtf(q / (256.0f * (float)ntn) + eps)};
        }
        asm volatile("s_waitcnt lgkmcnt(0)" ::: "memory"); __builtin_amdgcn_s_barrier(); asm volatile("" ::: "memory");
        return bad;
    }
};
struct EpiLnRes {
    static constexpr bool PERM = false, AFTER_DRAIN = true;
    const float* base; float* out; int ldc; const float* bias; PanelStats st; unsigned poison;
    __device__ __forceinline__ void fused(f32x4 (&acc)[2][2][4][2], const Unit& u, int wr, int wc, int fr, int fq, PG8_LAS unsigned char* lds, int wid, int lane) const {
        typedef float f32x2v __attribute__((ext_vector_type(2)));
        const PG8_LAS f32x2v* S = (const PG8_LAS f32x2v*)(lds + 8192);
        const int col0 = u.pn * BM + wc * 32 + 4 * fq;
#pragma unroll
        for (int bj = 0; bj < 2; ++bj)
#pragma unroll
            for (int n = 0; n < 2; ++n) { const f32x4 bv = bias ? *(const f32x4*)(bias + col0 + bj * HALF + n * 16) : (f32x4){0.f, 0.f, 0.f, 0.f};
#pragma unroll
                for (int ai = 0; ai < 2; ++ai)
#pragma unroll
                    for (int m = 0; m < 4; ++m) acc[ai][bj][m][n] += bv; }
        f32x4 pre[4][2][2];
#pragma unroll
        for (int m = 0; m < 4; ++m) { const size_t off = (size_t)(u.pm * BM + wr * 64 + m * 16 + fr) * ldc + col0;
#pragma unroll
            for (int bj = 0; bj < 2; ++bj)
#pragma unroll
                for (int n = 0; n < 2; ++n) pre[m][bj][n] = *(const f32x4*)(base + off + bj * HALF + n * 16); }
        const bool bad = st.run(acc, u, wr, wc, fr, fq, lds, wid, lane) || poison != 0u;
        const float qnan = __builtin_nanf("");
#pragma unroll
        for (int ai = 0; ai < 2; ++ai)
#pragma unroll
            for (int m = 0; m < 4; ++m) { const int r = ai * HALF + wr * 64 + m * 16 + fr; const f32x2v sr = S[r]; const size_t off = (size_t)(u.pm * BM + r) * ldc + col0;
#pragma unroll
                for (int bj = 0; bj < 2; ++bj)
#pragma unroll
                    for (int n = 0; n < 2; ++n) { const f32x4 bs = ai == 0 ? pre[m][bj][n] : *(const f32x4*)(base + off + bj * HALF + n * 16); f32x4 o = bs + (acc[ai][bj][m][n] - sr.x) * sr.y;
                        if (bad) o = (f32x4){qnan, qnan, qnan, qnan}; *(f32x4*)(out + off + bj * HALF + n * 16) = o; }
                if (m & 1) asm volatile("" ::: "memory"); }
    }
};
struct EpiLnResLn {
    static constexpr bool PERM = false, AFTER_DRAIN = true;
    const float* base; float* out; bf16_t* xn; int ldc; const float* bias; PanelStats st1, st2; unsigned poison;
    __device__ __forceinline__ void fused(f32x4 (&acc)[2][2][4][2], const Unit& u, int wr, int wc, int fr, int fq, PG8_LAS unsigned char* lds, int wid, int lane) const {
        typedef float f32x2v __attribute__((ext_vector_type(2))); typedef unsigned u32x2v __attribute__((ext_vector_type(2)));
        const PG8_LAS f32x2v* S = (const PG8_LAS f32x2v*)(lds + 8192);
        const int col0 = u.pn * BM + wc * 32 + 4 * fq;
#pragma unroll
        for (int bj = 0; bj < 2; ++bj)
#pragma unroll
            for (int n = 0; n < 2; ++n) { const f32x4 bv = bias ? *(const f32x4*)(bias + col0 + bj * HALF + n * 16) : (f32x4){0.f, 0.f, 0.f, 0.f};
#pragma unroll
                for (int ai = 0; ai < 2; ++ai)
#pragma unroll
                    for (int m = 0; m < 4; ++m) acc[ai][bj][m][n] += bv; }
        bool bad = st1.run(acc, u, wr, wc, fr, fq, lds, wid, lane) || poison != 0u;
        const float qnan = __builtin_nanf("");
#pragma unroll
        for (int ai = 0; ai < 2; ++ai)
#pragma unroll
            for (int m = 0; m < 4; ++m) { const int r = ai * HALF + wr * 64 + m * 16 + fr; const f32x2v sr = S[r]; const size_t off = (size_t)(u.pm * BM + r) * ldc + col0;
#pragma unroll
                for (int bj = 0; bj < 2; ++bj)
#pragma unroll
                    for (int n = 0; n < 2; ++n) { const f32x4 bs = *(const f32x4*)(base + off + bj * HALF + n * 16); acc[ai][bj][m][n] = bs + (acc[ai][bj][m][n] - sr.x) * sr.y; }
                asm volatile("" : "+v"(acc[ai][0][m][0]), "+v"(acc[ai][0][m][1]), "+v"(acc[ai][1][m][0]), "+v"(acc[ai][1][m][1]));
                if (m & 1) asm volatile("" ::: "memory"); }
        const bool bad1 = bad;
        bad = st2.run(acc, u, wr, wc, fr, fq, lds, wid, lane) || bad;
#pragma unroll
        for (int ai = 0; ai < 2; ++ai)
#pragma unroll
            for (int m = 0; m < 4; ++m) { const int r = ai * HALF + wr * 64 + m * 16 + fr; const f32x2v sr = S[r]; const size_t off = (size_t)(u.pm * BM + r) * ldc + col0;
#pragma unroll
                for (int bj = 0; bj < 2; ++bj)
#pragma unroll
                    for (int n = 0; n < 2; ++n) { const f32x4 x1 = acc[ai][bj][m][n]; *(f32x4*)(out + off + bj * HALF + n * 16) = bad1 ? (f32x4){qnan, qnan, qnan, qnan} : x1;
                        const f32x4 o = (x1 - sr.x) * sr.y; u32x2v w; w.x = cvt_pk_bf16(o[0], o[1]); w.y = cvt_pk_bf16(o[2], o[3]);
                        if (bad) { w.x = 0x7fc07fc0u; w.y = 0x7fc07fc0u; } *(u32x2v*)(xn + off + bj * HALF + n * 16) = w; }
                asm volatile("" ::: "memory"); }
    }
};

template <class Epi, class Sched, bool ALIGN_EPI = false, bool SP2 = false>
__device__ __forceinline__ void gemm_phase(PG8_LAS unsigned char* lds, const Gemm g, const Sched& S, const Epi& E) {
    const int tid = threadIdx.x, wid = __builtin_amdgcn_readfirstlane(tid >> 6), lane = tid & 63, wr = wid >> 2, wc = wid & 3, fr = lane & 15, fq = lane >> 4;
    const int K = g.K, nt = K / BK;
    unsigned voffA[2], voffB[2];
#pragma unroll
    for (int i = 0; i < 2; ++i) { int R, C; stage_rc(tid * 16 + i * 8192, R, C); const int Rb = Epi::PERM ? ((R & ~31) + perm32(R & 31)) : R;
        voffA[i] = (unsigned)(R * K + C) * 2u; voffB[i] = (unsigned)(Rb * K + C) * 2u; }
    const size_t kstep = (size_t)(BK * 2);
    const size_t hstep = (size_t)HALF * K * 2;
    const size_t tstep = 2 * hstep;
    const unsigned ldsw = (unsigned)wid * 1024u;
    const int aoff = lds_byte(wr * 64 + fr, fq * 8), boff = lds_byte(wc * 32 + fr, fq * 8);
#define PG8_SA(b, h) (((b) * 2 + (h)) * HTB)
#define PG8_SB(b, h) ((4 + (b) * 2 + (h)) * HTB)
#define PG8_STAGE(bufoff, gbase, voff) do { _Pragma("unroll") for (int _i = 0; _i < 2; ++_i) \
        __builtin_amdgcn_global_load_lds((const unsigned*)((const char*)(gbase) + (voff)[_i]), (PG8_LAS unsigned*)(lds + (bufoff) + ldsw + _i * 8192), 16, 0, 0); } while (0)
#define PG8_LDA(dst, b, h) do { _Pragma("unroll") for (int m = 0; m < 4; ++m) _Pragma("unroll") for (int k = 0; k < 2; ++k) dst[m][k] = *(const PG8_LAS bf16x8*)(lds + PG8_SA(b, h) + aoff + m * 2048 + k * 1024); } while (0)
#define PG8_LDB(dst, b, h) do { _Pragma("unroll") for (int n = 0; n < 2; ++n) _Pragma("unroll") for (int k = 0; k < 2; ++k) dst[n][k] = *(const PG8_LAS bf16x8*)(lds + PG8_SB(b, h) + boff + n * 2048 + k * 1024); } while (0)
#define PG8_MMA(ai, bj, At, Bt) do { __builtin_amdgcn_s_setprio(1); _Pragma("unroll") for (int m = 0; m < 4; ++m) _Pragma("unroll") for (int n = 0; n < 2; ++n) _Pragma("unroll") for (int k = 0; k < 2; ++k) \
        acc[ai][bj][m][n] = __builtin_amdgcn_mfma_f32_16x16x32_bf16(Bt[n][k], At[m][k], acc[ai][bj][m][n], 0, 0, 0); __builtin_amdgcn_s_setprio(0); } while (0)
#define PG8_WAIT_V(n) asm volatile("s_waitcnt vmcnt(" #n ")" ::: "memory")
#define PG8_WAIT_L(n) asm volatile("s_waitcnt lgkmcnt(" #n ")" ::: "memory")
#define PG8_BAR __builtin_amdgcn_s_barrier()
#define PG8_SCHED __builtin_amdgcn_sched_barrier(0)
    Unit cur, nxt; int ui = 0;
    if (!S.next(0, cur)) return;
    f32x4 acc[2][2][4][2];
#pragma unroll
    for (int a = 0; a < 2; ++a)
#pragma unroll
        for (int b = 0; b < 2; ++b)
#pragma unroll
            for (int m = 0; m < 4; ++m)
#pragma unroll
                for (int n = 0; n < 2; ++n) acc[a][b][m][n] = (f32x4){0.f, 0.f, 0.f, 0.f};
    bf16x8 At[4][2], B0[2][2], B1[2][2];
    const char* cA = (const char*)g.A + (size_t)cur.pm * tstep + (size_t)cur.k0 * kstep; const char* cB = (const char*)g.Bt + (size_t)cur.pn * tstep + (size_t)cur.k0 * kstep;
    S.a_ready(cur);
    if constexpr (SP2) {
        PG8_STAGE(PG8_SB(0, 0), cB, voffB); PG8_STAGE(PG8_SB(0, 1), cB + hstep, voffB); PG8_STAGE(PG8_SA(0, 0), cA, voffA); PG8_STAGE(PG8_SA(0, 1), cA + hstep, voffA);
        if (wr == 1) PG8_BAR;
        PG8_WAIT_V(2); PG8_BAR;
        PG8_STAGE(PG8_SB(1, 0), cB + kstep, voffB); PG8_STAGE(PG8_SA(1, 0), cA + kstep, voffA); PG8_STAGE(PG8_SB(1, 1), cB + hstep + kstep, voffB);
        PG8_WAIT_V(6); PG8_BAR;
    } else {
        PG8_STAGE(PG8_SB(0, 0), cB, voffB); PG8_STAGE(PG8_SA(0, 0), cA, voffA); PG8_STAGE(PG8_SB(0, 1), cB + hstep, voffB); PG8_STAGE(PG8_SA(0, 1), cA + hstep, voffA);
        if (wr == 1) PG8_BAR;
        PG8_WAIT_V(4); PG8_BAR;
        PG8_STAGE(PG8_SB(1, 0), cB + kstep, voffB); PG8_STAGE(PG8_SA(1, 0), cA + kstep, voffA); PG8_STAGE(PG8_SB(1, 1), cB + hstep + kstep, voffB);
        PG8_WAIT_V(6); PG8_BAR;
    }
    for (;;) {
        const bool has_next = S.next(ui + 1, nxt);
        const char* nA = has_next ? (const char*)g.A + (size_t)nxt.pm * tstep + (size_t)nxt.k0 * kstep : cA; const char* nB = has_next ? (const char*)g.Bt + (size_t)nxt.pn * tstep + (size_t)nxt.k0 * kstep : cB;
        const int ntc = cur.nk;
        for (int t = 0; t < ntc; t += 2) {
            const bool last = (t == ntc - 2);
            const char* a1 = cA + (size_t)(t + 1) * kstep;
            const char* a2 = last ? nA : cA + (size_t)(t + 2) * kstep; const char* b2 = last ? nB : cB + (size_t)(t + 2) * kstep;
            const char* a3 = a2 + kstep; const char* b3 = b2 + kstep;
            if (last && has_next) S.a_ready(nxt);
            if constexpr (SP2) {
            PG8_LDB(B0, 0, 0); PG8_LDB(B1, 0, 1); PG8_SCHED; PG8_LDA(At, 0, 0); PG8_STAGE(PG8_SA(1, 1), a1 + hstep, voffA);
            PG8_WAIT_V(8); PG8_WAIT_L(0); PG8_BAR; PG8_MMA(0, 0, At, B0); PG8_MMA(0, 1, At, B1); PG8_BAR; PG8_SCHED;
            PG8_LDA(At, 0, 1); PG8_STAGE(PG8_SB(0, 0), b2, voffB); PG8_STAGE(PG8_SB(0, 1), b2 + hstep, voffB); PG8_STAGE(PG8_SA(0, 0), a2, voffA);
            PG8_WAIT_V(8); PG8_WAIT_L(0); PG8_BAR; PG8_MMA(1, 0, At, B0); PG8_MMA(1, 1, At, B1); PG8_BAR; PG8_SCHED;
            PG8_LDB(B0, 1, 0); PG8_LDB(B1, 1, 1); PG8_SCHED; PG8_LDA(At, 1, 0); PG8_STAGE(PG8_SA(0, 1), a2 + hstep, voffA);
            PG8_WAIT_V(8); PG8_WAIT_L(0); PG8_BAR; PG8_MMA(0, 0, At, B0); PG8_MMA(0, 1, At, B1); PG8_BAR; PG8_SCHED;
            PG8_LDA(At, 1, 1); PG8_STAGE(PG8_SB(1, 0), b3, voffB); PG8_STAGE(PG8_SB(1, 1), b3 + hstep, voffB); PG8_STAGE(PG8_SA(1, 0), a3, voffA);
            PG8_WAIT_V(8); PG8_WAIT_L(0); PG8_BAR; PG8_MMA(1, 0, At, B0); PG8_MMA(1, 1, At, B1); PG8_BAR; PG8_SCHED;
            } else {
            PG8_LDB(B0, 0, 0); PG8_SCHED; PG8_LDA(At, 0, 0); PG8_STAGE(PG8_SA(1, 1), a1 + hstep, voffA);
            PG8_WAIT_L(8); PG8_BAR; PG8_WAIT_L(0); PG8_MMA(0, 0, At, B0); PG8_BAR; PG8_SCHED;
            PG8_LDB(B1, 0, 1); PG8_STAGE(PG8_SB(0, 0), b2, voffB);
            PG8_BAR; PG8_WAIT_L(0); PG8_MMA(0, 1, At, B1); PG8_BAR;
            PG8_LDA(At, 0, 1); PG8_STAGE(PG8_SA(0, 0), a2, voffA);
            PG8_BAR; PG8_WAIT_L(0); PG8_MMA(1, 0, At, B0); PG8_BAR; PG8_SCHED;
            PG8_STAGE(PG8_SB(0, 1), b2 + hstep, voffB);
            PG8_WAIT_V(6); PG8_BAR; PG8_MMA(1, 1, At, B1); PG8_BAR;
            PG8_LDB(B0, 1, 0); PG8_SCHED; PG8_LDA(At, 1, 0); PG8_STAGE(PG8_SA(0, 1), a2 + hstep, voffA);
            PG8_WAIT_L(8); PG8_BAR; PG8_WAIT_L(0); PG8_MMA(0, 0, At, B0); PG8_BAR; PG8_SCHED;
            PG8_LDB(B1, 1, 1); PG8_STAGE(PG8_SB(1, 0), b3, voffB);
            PG8_BAR; PG8_WAIT_L(0); PG8_MMA(0, 1, At, B1); PG8_BAR;
            PG8_LDA(At, 1, 1); PG8_STAGE(PG8_SA(1, 0), a3, voffA);
            PG8_BAR; PG8_WAIT_L(0); PG8_MMA(1, 0, At, B0); PG8_BAR; PG8_SCHED;
            PG8_STAGE(PG8_SB(1, 1), b3 + hstep, voffB);
            PG8_WAIT_V(6); PG8_BAR; PG8_MMA(1, 1, At, B1); PG8_BAR;
            }
        }
        if constexpr (ALIGN_EPI) { if (wr == 0) PG8_BAR; }
        if constexpr (!Epi::AFTER_DRAIN) { E(acc, cur, wr, wc, fr, fq); S.done(cur); }
        if (!has_next) break;
#pragma unroll
        for (int a = 0; a < 2; ++a)
#pragma unroll
            for (int b = 0; b < 2; ++b)
#pragma unroll
                for (int m = 0; m < 4; ++m)
#pragma unroll
                    for (int n = 0; n < 2; ++n) acc[a][b][m][n] = (f32x4){0.f, 0.f, 0.f, 0.f};
        cur = nxt; cA = nA; cB = nB; ++ui;
        if constexpr (ALIGN_EPI) { if (wr == 1) PG8_BAR; }
    }
    PG8_WAIT_V(0);
    if constexpr (!ALIGN_EPI) { if (wr == 0) PG8_BAR; }
    PG8_BAR;
    if constexpr (Epi::AFTER_DRAIN) { E.fused(acc, cur, wr, wc, fr, fq, lds, wid, lane); S.done(cur); }
#undef PG8_SA
#undef PG8_SB
#undef PG8_STAGE
#undef PG8_LDA
#undef PG8_LDB
#undef PG8_MMA
#undef PG8_WAIT_V
#undef PG8_WAIT_L
#undef PG8_BAR
#undef PG8_SCHED
}
}

constexpr int D = 4096, PBATCH = 4, PSEQ = 2048, MPROMPT = PBATCH * PSEQ, SBATCH = 32, SSEQ = 4, MSAMPLE = SBATCH * SSEQ;
constexpr int MREAL = MPROMPT + MSAMPLE;
constexpr int MPAD = 8448;
constexpr int NE = 5120;
constexpr int NO = 16384;
constexpr int FF = 11008, DM = 512;
constexpr float ALPHA = 1.41421356237309515f;
constexpr float LN_EPS = 1e-5f, RMS_EPS = 1e-6f;
constexpr int NWAVES = 8;

constexpr size_t MiB = 1u << 20;
constexpr size_t WS_CTL = 0, CTL_ZERO_BYTES = 1 * MiB;
constexpr size_t WS_AB = 1 * MiB;
constexpr size_t WS_BB = WS_AB + 65536;
constexpr size_t WS_BT = WS_BB + 1048576;
constexpr size_t WS_LB = WS_BT + 16384;
constexpr size_t WS_SSQ = WS_LB + 16384;
constexpr size_t WS_WEIN = 4 * MiB, WS_WGLU = 44 * MiB, WS_WEOUT = 52 * MiB, WS_WOIN = 84 * MiB, WS_WOOUT = 212 * MiB;
constexpr size_t WS_LAYER = 244 * MiB, LAYER_STRIDE = 274 * MiB;
constexpr size_t L_WMQ = 0, L_WMKV = 4 * MiB, L_WMO = 12 * MiB, L_WGU = 16 * MiB, L_WD = 188 * MiB;
constexpr size_t WS_X = 792 * MiB;
constexpr size_t WS_XN = 924 * MiB;
constexpr size_t WS_MIX = 990 * MiB;
constexpr size_t WS_QC = 1056 * MiB;
constexpr size_t WS_CO = 1065 * MiB;
constexpr size_t WS_MPB = 1074 * MiB;
constexpr size_t WS_KVM = 1082 * MiB;
constexpr size_t WS_HBIG = 1086 * MiB;
constexpr size_t WS_Z = WS_HBIG + 83 * MiB;
constexpr size_t WS_H1S = WS_HBIG + 264 * MiB;
constexpr size_t WS_HFS = WS_H1S + 32 * MiB;
constexpr size_t WS_END = WS_HFS + 44 * MiB;
static_assert((size_t)MPAD * NE * 2 <= 83 * MiB && (size_t)MPAD * NO * 2 <= 264 * MiB && WS_LAYER + 2 * LAYER_STRIDE == WS_X, "ws map");
constexpr int CW_TMO = 0, CW_CODE = 1, CW_BAR = 4096;

constexpr size_t O_Y = 0, O_PMK = 34078720, O_PMV = 35127296, O_PSK = 36175872, O_PSV = 36438016, O_PS5R = 36700160, O_PS5I = 36732928,
                 O_PHG = 36765696, O_SSK = 38862848, O_SSV = 40960000, O_SS5R = 43057152, O_SS5I = 43319296, O_SHG = 43581440, O_END = 60358656;

constexpr int RING_OFF = 0, RING_BYTES = 131072;
constexpr int LDS_BYTES = 147456;
constexpr int MISC_OFF = LDS_BYTES - 256;

#define GAS __attribute__((address_space(1)))
#define LAS __attribute__((address_space(3)))
#define DI __device__ __forceinline__
typedef unsigned short bf16;
typedef unsigned v4u __attribute__((ext_vector_type(4)));
typedef unsigned v2u __attribute__((ext_vector_type(2)));
typedef float f32x4 __attribute__((ext_vector_type(4)));
typedef float f32x2 __attribute__((ext_vector_type(2)));
typedef float f32x16 __attribute__((ext_vector_type(16)));
typedef short bf16x8 __attribute__((ext_vector_type(8)));
typedef GAS unsigned gu32;
#define RLX_AGENT __ATOMIC_RELAXED, __HIP_MEMORY_SCOPE_AGENT
#define LDS_WAIT() asm volatile("s_waitcnt lgkmcnt(0)" ::: "memory")
#define VM_WAIT() asm volatile("s_waitcnt vmcnt(0)" ::: "memory")
typedef __bf16 bf16x2_t __attribute__((ext_vector_type(2)));
DI unsigned pk2(float lo, float hi) { f32x2 v = {lo, hi}; bf16x2_t b = __builtin_convertvector(v, bf16x2_t); return __builtin_bit_cast(unsigned, b); }
DI float bflo(unsigned w) { return __uint_as_float(w << 16); }
DI float bfhi(unsigned w) { return __uint_as_float(w & 0xffff0000u); }
DI float bf2f(bf16 v) { return __uint_as_float(((unsigned)v) << 16); }
DI float wave_sum(float v) {
#pragma unroll
    for (int o = 1; o < 64; o <<= 1) v += __shfl_xor(v, o);
    return v;
}
DI float wave_max(float v) {
#pragma unroll
    for (int o = 1; o < 64; o <<= 1) v = fmaxf(v, __shfl_xor(v, o));
    return v;
}
DI float sigmoidf_(float x) { return __builtin_amdgcn_rcpf(1.0f + __expf(-x)); }
DI int crow(int reg, int h) { return (reg & 3) + 8 * (reg >> 2) + 4 * h; }
#define MFMA32(a, b, c) __builtin_amdgcn_mfma_f32_32x32x16_bf16((a), (b), (c), 0, 0, 0)

#define XB_TMO      128
#define XB_XCNT(j)  (256  + 64 * (j))
#define XB_XSUB(j)  (1280 + 64 * (j))
#define XB_XGEN(j)  (2304 + 64 * (j))
#define XB_TOP      3328
#define XB_TOPGEN   3392
#define XCD_BAR_WORDS 3456
#define XB_SPIN_CAP (1u << 18)

__device__ __forceinline__ unsigned xb_ld(unsigned* p)              { return __hip_atomic_load(p, __ATOMIC_RELAXED, __HIP_MEMORY_SCOPE_AGENT); }
__device__ __forceinline__ unsigned xb_add(unsigned* p, unsigned v) { return __hip_atomic_fetch_add(p, v, __ATOMIC_RELAXED, __HIP_MEMORY_SCOPE_AGENT); }
__device__ __forceinline__ unsigned xb_xcc_id() { return (unsigned)__builtin_amdgcn_s_getreg((3 << 11) | 20) & 0xFu; }
#define XB_SPIN(cond, bar) do { unsigned _sp = 0; while (cond) { __builtin_amdgcn_s_sleep(1); \
    if ((++_sp & 255u) == 0u) { if (xb_ld(&(bar)[XB_TMO])) break; if (_sp > XB_SPIN_CAP) { atomicAdd(&(bar)[XB_TMO], 1u); break; } } } } while (0)

struct XcdBarrier {
    unsigned* bar; unsigned x;
    volatile LAS unsigned* st;
};

__device__ __forceinline__ XcdBarrier xcd_barrier_post(unsigned* bar, volatile LAS unsigned* st) {
    XcdBarrier b; b.bar = bar; b.x = xb_xcc_id(); b.st = st;
    if (threadIdx.x == 0) (void)xb_add(&bar[XB_XCNT(b.x)], 1u);
    return b;
}
__device__ __forceinline__ void xcd_barrier_complete(unsigned* bar, unsigned x, unsigned& nloc, unsigned& nx) {
    const unsigned G = gridDim.x * gridDim.y * gridDim.z;
    unsigned sum, cnt, mine, sp = 0u;
    for (;;) {
        sum = 0u; cnt = 0u; mine = 0u;
#pragma unroll
        for (unsigned j = 0; j < 16; ++j) { const unsigned c = xb_ld(&bar[XB_XCNT(j)]); sum += c; cnt += (c > 0u) ? 1u : 0u; mine = (j == x) ? c : mine; }
        if (sum == G) break;
        __builtin_amdgcn_s_sleep(1);
        if ((++sp & 255u) == 0u) { if (xb_ld(&bar[XB_TMO])) break; if (sp > XB_SPIN_CAP) { atomicAdd(&bar[XB_TMO], 1u); break; } }
    }
    nloc = mine > 0u ? mine : 1u; nx = cnt > 0u ? cnt : 1u;
}

__device__ __forceinline__ void xcd_barrier(const XcdBarrier& b) {
    asm volatile("s_waitcnt vmcnt(0)" ::: "memory");
    __syncthreads();
    if (threadIdx.x == 0) {
        unsigned* bar = b.bar;
        __builtin_amdgcn_s_waitcnt(0);
        unsigned nloc = b.st[0], nx = b.st[1];
        if (nloc == 0u) { xcd_barrier_complete(bar, b.x, nloc, nx); b.st[0] = nloc; b.st[1] = nx; }
        const unsigned old = xb_add(&bar[XB_XSUB(b.x)], 1u);
        const unsigned gen = old / nloc;
        if (old + 1u == (gen + 1u) * nloc) {
            __builtin_amdgcn_fence(__ATOMIC_RELEASE, "agent");
            asm volatile("s_waitcnt vmcnt(0)" ::: "memory");
            const unsigned og = xb_add(&bar[XB_TOP], 1u);
            const unsigned tg = og / nx;
            if (og + 1u == (tg + 1u) * nx) xb_add(&bar[XB_TOPGEN], 1u);
            else XB_SPIN(xb_ld(&bar[XB_TOPGEN]) == tg, bar);
            __builtin_amdgcn_fence(__ATOMIC_ACQUIRE, "agent");
            xb_add(&bar[XB_XGEN(b.x)], 1u);
            asm volatile("s_waitcnt vmcnt(0)" ::: "memory");
        } else {
            XB_SPIN(xb_ld(&bar[XB_XGEN(b.x)]) == gen, bar);
            __builtin_amdgcn_fence(__ATOMIC_ACQUIRE, "agent");
            asm volatile("s_waitcnt vmcnt(0)" ::: "memory");
        }
    }
    __syncthreads();
}

struct EpiStoreBf16 {
    static constexpr bool PERM = true, AFTER_DRAIN = false;
    bf16* O; int ldc;
    DI void operator()(const f32x4 (&acc)[2][2][4][2], const pg8::Unit& u, int wr, int wc, int fr, int fq) const {
        const int row0 = u.pm * 256 + wr * 64 + fr, col0 = u.pn * 256 + wc * 32 + 8 * fq;
#pragma unroll
        for (int ai = 0; ai < 2; ++ai)
#pragma unroll
            for (int m = 0; m < 4; ++m) { bf16* rowp = O + (size_t)(row0 + ai * 128 + m * 16) * ldc + col0;
#pragma unroll
                for (int bj = 0; bj < 2; ++bj) { const f32x4 v0 = acc[ai][bj][m][0], v1 = acc[ai][bj][m][1];
                    v4u w; w.x = pk2(v0[0], v0[1]); w.y = pk2(v0[2], v0[3]); w.z = pk2(v1[0], v1[1]); w.w = pk2(v1[2], v1[3]);
                    *(v4u*)(rowp + bj * 128) = w; } }
    }
};
struct EpiMemKV {
    static constexpr bool PERM = false, AFTER_DRAIN = false;
    float* outk; float* outv; bf16* kvm;
    DI void operator()(const f32x4 (&acc)[2][2][4][2], const pg8::Unit& u, int wr, int wc, int fr, int fq) const {
        const int row0 = u.pm * 256 + wr * 64 + fr, col0 = u.pn * 256 + wc * 32 + 4 * fq;
        float* obase = (u.pn < 2) ? outk : outv; const int ocol0 = col0 - ((u.pn < 2) ? 0 : 512);
#pragma unroll
        for (int ai = 0; ai < 2; ++ai)
#pragma unroll
            for (int m = 0; m < 4; ++m) { const int row = row0 + ai * 128 + m * 16;
#pragma unroll
                for (int bj = 0; bj < 2; ++bj)
#pragma unroll
                    for (int n = 0; n < 2; ++n) { const f32x4 v = acc[ai][bj][m][n]; const int cc = bj * 128 + n * 16;
                        *(f32x4*)(obase + (size_t)row * 512 + ocol0 + cc) = v;
                        v2u w; w.x = pk2(v[0], v[1]); w.y = pk2(v[2], v[3]);
                        *(v2u*)(kvm + (size_t)row * 1024 + col0 + cc) = w; } }
    }
};
struct EpiGlu {
    static constexpr bool PERM = true, AFTER_DRAIN = false;
    const bf16* Z; bf16* O;
    DI void operator()(const f32x4 (&acc)[2][2][4][2], const pg8::Unit& u, int wr, int wc, int fr, int fq) const {
        const int row0 = u.pm * 256 + wr * 64 + fr, col0 = u.pn * 256 + wc * 32 + 8 * fq;
#pragma unroll
        for (int ai = 0; ai < 2; ++ai)
#pragma unroll
            for (int m = 0; m < 4; ++m) { const int row = row0 + ai * 128 + m * 16;
#pragma unroll
                for (int bj = 0; bj < 2; ++bj) { const f32x4 v0 = acc[ai][bj][m][0], v1 = acc[ai][bj][m][1];
                    const v4u z = *(const v4u*)(Z + (size_t)row * 2048 + col0 + bj * 128);
                    v4u w;
                    w.x = pk2(bflo(z.x) * sigmoidf_(v0[0]), bfhi(z.x) * sigmoidf_(v0[1]));
                    w.y = pk2(bflo(z.y) * sigmoidf_(v0[2]), bfhi(z.y) * sigmoidf_(v0[3]));
                    w.z = pk2(bflo(z.z) * sigmoidf_(v1[0]), bfhi(z.z) * sigmoidf_(v1[1]));
                    w.w = pk2(bflo(z.w) * sigmoidf_(v1[2]), bfhi(z.w) * sigmoidf_(v1[3]));
                    *(v4u*)(O + (size_t)row * 4096 + col0 + bj * 128) = w; } }
    }
};
struct EpiRes {
    static constexpr bool PERM = true, AFTER_DRAIN = false;
    bf16* T; const bf16* XN; const float* ssq; float* part;
    DI void operator()(const f32x4 (&acc)[2][2][4][2], const pg8::Unit& u, int wr, int wc, int fr, int fq) const {
        const int row0 = u.pm * 256 + wr * 64 + fr, col0 = u.pn * 256 + wc * 32 + 8 * fq;
        if (u.ks < 0) {
#pragma unroll
            for (int ai = 0; ai < 2; ++ai)
#pragma unroll
                for (int m = 0; m < 4; ++m) { const int row = row0 + ai * 128 + m * 16;
                    float rs = 1.0f; if (ssq) rs = 1.0f / sqrtf(ssq[row] * (1.0f / 4096.0f) + RMS_EPS);
                    const size_t off = (size_t)row * D + col0;
                    v4u x[2];
#pragma unroll
                    for (int bj = 0; bj < 2; ++bj) x[bj] = *(const v4u*)(XN + off + bj * 128);
#pragma unroll
                    for (int bj = 0; bj < 2; ++bj) { const f32x4 a0 = acc[ai][bj][m][0] * rs, a1 = acc[ai][bj][m][1] * rs; v4u w;
                        w.x = pk2(bflo(x[bj].x) * ALPHA + a0[0], bfhi(x[bj].x) * ALPHA + a0[1]); w.y = pk2(bflo(x[bj].y) * ALPHA + a0[2], bfhi(x[bj].y) * ALPHA + a0[3]);
                        w.z = pk2(bflo(x[bj].z) * ALPHA + a1[0], bfhi(x[bj].z) * ALPHA + a1[1]); w.w = pk2(bflo(x[bj].w) * ALPHA + a1[2], bfhi(x[bj].w) * ALPHA + a1[3]);
                        *(v4u*)(T + off + bj * 128) = w; } }
        } else {
            float* pb = part + (size_t)u.ks * MSAMPLE * D;
#pragma unroll
            for (int m = 0; m < 4; ++m) { const int row = row0 + m * 16;
                float rs = 1.0f; if (ssq) rs = 1.0f / sqrtf(ssq[row] * (1.0f / 4096.0f) + RMS_EPS);
                const size_t off = (size_t)(row - MPROMPT) * D + col0;
#pragma unroll
                for (int bj = 0; bj < 2; ++bj) { *(f32x4*)(pb + off + bj * 128) = acc[0][bj][m][0] * rs; *(f32x4*)(pb + off + bj * 128 + 4) = acc[0][bj][m][1] * rs; } }
        }
    }
};
struct EpiGU {
    static constexpr bool PERM = true, AFTER_DRAIN = false;
    bf16* O; float* slab;
    DI void operator()(const f32x4 (&acc)[2][2][4][2], const pg8::Unit& u, int wr, int wc, int fr, int fq) const {
        if (u.ks >= 0) {
            float* sb = slab + (size_t)u.ks * MSAMPLE * (2 * FF); const int c0 = u.pn * 256 + wc * 32 + 8 * fq;
#pragma unroll
            for (int m = 0; m < 4; ++m) { const int row = wr * 64 + m * 16 + fr;
#pragma unroll
                for (int bj = 0; bj < 2; ++bj) { *(f32x4*)(sb + (size_t)row * (2 * FF) + c0 + bj * 128) = acc[0][bj][m][0]; *(f32x4*)(sb + (size_t)row * (2 * FF) + c0 + bj * 128 + 4) = acc[0][bj][m][1]; } }
            return;
        }
        const int row0 = u.pm * 256 + wr * 64 + fr, col0 = u.pn * 128 + wc * 32 + 8 * fq;
#pragma unroll
        for (int ai = 0; ai < 2; ++ai)
#pragma unroll
            for (int m = 0; m < 4; ++m) { const int row = row0 + ai * 128 + m * 16;
                const f32x4 g0 = acc[ai][0][m][0], g1 = acc[ai][0][m][1], u0 = acc[ai][1][m][0], u1 = acc[ai][1][m][1];
                v4u w;
                w.x = pk2(g0[0] * sigmoidf_(g0[0]) * u0[0], g0[1] * sigmoidf_(g0[1]) * u0[1]);
                w.y = pk2(g0[2] * sigmoidf_(g0[2]) * u0[2], g0[3] * sigmoidf_(g0[3]) * u0[3]);
                w.z = pk2(g1[0] * sigmoidf_(g1[0]) * u1[0], g1[1] * sigmoidf_(g1[1]) * u1[1]);
                w.w = pk2(g1[2] * sigmoidf_(g1[2]) * u1[2], g1[3] * sigmoidf_(g1[3]) * u1[3]);
                *(v4u*)(O + (size_t)row * FF + col0) = w; }
    }
};
struct EpiOddIn {
    static constexpr bool PERM = true, AFTER_DRAIN = false;
    bf16* O; const float* lb; float* slab;
    DI float act(float v, int type, float l) const {
        if (type == 0) return v * sigmoidf_(v);
        if (type == 1) return __logf(l + (1.0f - l) * sigmoidf_(v));
        if (type == 2) return v;
        return sigmoidf_(v);
    }
    DI void operator()(const f32x4 (&acc)[2][2][4][2], const pg8::Unit& u, int wr, int wc, int fr, int fq) const {
        const int row0 = u.pm * 256 + wr * 64 + fr, col0 = u.pn * 256 + wc * 32 + 8 * fq;
        if (u.ks >= 0) {
            float* sb = slab + (size_t)u.ks * MSAMPLE * NO;
#pragma unroll
            for (int m = 0; m < 4; ++m) { const int row = wr * 64 + m * 16 + fr;
#pragma unroll
                for (int bj = 0; bj < 2; ++bj) { *(f32x4*)(sb + (size_t)row * NO + col0 + bj * 128) = acc[0][bj][m][0]; *(f32x4*)(sb + (size_t)row * NO + col0 + bj * 128 + 4) = acc[0][bj][m][1]; } }
            return;
        }
        const int type = u.pn >> 4;
        float lbv[2][8];
#pragma unroll
        for (int bj = 0; bj < 2; ++bj)
#pragma unroll
            for (int e = 0; e < 8; ++e) lbv[bj][e] = (type == 1) ? lb[(col0 + bj * 128 + e) & 4095] : 0.f;
#pragma unroll
        for (int ai = 0; ai < 2; ++ai)
#pragma unroll
            for (int m = 0; m < 4; ++m) { const int row = row0 + ai * 128 + m * 16;
#pragma unroll
                for (int bj = 0; bj < 2; ++bj) { const f32x4 v0 = acc[ai][bj][m][0], v1 = acc[ai][bj][m][1];
                    v4u w;
                    w.x = pk2(act(v0[0], type, lbv[bj][0]), act(v0[1], type, lbv[bj][1]));
                    w.y = pk2(act(v0[2], type, lbv[bj][2]), act(v0[3], type, lbv[bj][3]));
                    w.z = pk2(act(v1[0], type, lbv[bj][4]), act(v1[1], type, lbv[bj][5]));
                    w.w = pk2(act(v1[2], type, lbv[bj][6]), act(v1[3], type, lbv[bj][7]));
                    *(v4u*)(O + (size_t)row * NO + col0 + bj * 128) = w; } }
    }
};

struct EpiSlab {
    static constexpr bool PERM = false, AFTER_DRAIN = false;
    float* P; float* S;
    DI void operator()(const f32x4 (&acc)[2][2][4][2], const pg8::Unit& u, int wr, int wc, int fr, int fq) const {
        const int col0 = u.pn * 256 + wc * 32 + 4 * fq;
        if (u.pm < 32) {
            float* pb = P + (size_t)u.ks * MPROMPT * DM;
#pragma unroll
            for (int ai = 0; ai < 2; ++ai)
#pragma unroll
                for (int m = 0; m < 4; ++m) { const int row = u.pm * 256 + ai * 128 + wr * 64 + m * 16 + fr;
#pragma unroll
                    for (int bj = 0; bj < 2; ++bj)
#pragma unroll
                        for (int n = 0; n < 2; ++n) *(f32x4*)(pb + (size_t)row * DM + col0 + bj * 128 + n * 16) = acc[ai][bj][m][n]; }
        } else {
            float* sb = S + (size_t)u.ks * MSAMPLE * DM;
#pragma unroll
            for (int m = 0; m < 4; ++m) { const int row = wr * 64 + m * 16 + fr;
#pragma unroll
                for (int bj = 0; bj < 2; ++bj)
#pragma unroll
                    for (int n = 0; n < 2; ++n) *(f32x4*)(sb + (size_t)row * DM + col0 + bj * 128 + n * 16) = acc[0][bj][m][n]; }
        }
    }
};

DI void ffn_act_sample(const float* slab, bf16* HF, int gt, int NGT) {
    constexpr size_t ST = (size_t)MSAMPLE * (2 * FF);
    for (int e = gt; e < MSAMPLE * (FF / 4); e += NGT) {
        const int r = e / (FF / 4), j0 = 4 * (e % (FF / 4));
        const float* p = slab + (size_t)r * (2 * FF) + 256 * (j0 >> 7) + (j0 & 127);
        f32x4 g4 = {0.f, 0.f, 0.f, 0.f}, u4 = g4;
#pragma unroll
        for (int sl = 0; sl < 4; ++sl) { g4 += *(const f32x4*)(p + sl * ST); u4 += *(const f32x4*)(p + sl * ST + 128); }
        v2u w; w.x = pk2(g4[0] * sigmoidf_(g4[0]) * u4[0], g4[1] * sigmoidf_(g4[1]) * u4[1]); w.y = pk2(g4[2] * sigmoidf_(g4[2]) * u4[2], g4[3] * sigmoidf_(g4[3]) * u4[3]);
        *(v2u*)(HF + (size_t)(MPROMPT + r) * FF + j0) = w;
    }
}

DI void transpose_item(const float* __restrict__ W, int K, int N, int k0, int n0, bf16* WT, int drow0, LAS unsigned char* scr, int lane) {
    const int g = lane >> 4, q = lane & 15;
    const float* src = W + (size_t)(k0 + 16 * g) * N + n0 + 4 * q;
    f32x4 v[16];
#pragma unroll
    for (int i = 0; i < 16; ++i) v[i] = __builtin_nontemporal_load((const f32x4*)(src + (size_t)i * N));
#pragma unroll
    for (int e = 0; e < 4; ++e) {
        v4u lo, hi;
        lo.x = pk2(v[0][e], v[1][e]); lo.y = pk2(v[2][e], v[3][e]); lo.z = pk2(v[4][e], v[5][e]); lo.w = pk2(v[6][e], v[7][e]);
        hi.x = pk2(v[8][e], v[9][e]); hi.y = pk2(v[10][e], v[11][e]); hi.z = pk2(v[12][e], v[13][e]); hi.w = pk2(v[14][e], v[15][e]);
        LAS unsigned char* t = scr + (4 * q + e) * 136 + 32 * g;
        *(LAS v2u*)(t) = (v2u){lo.x, lo.y}; *(LAS v2u*)(t + 8) = (v2u){lo.z, lo.w}; *(LAS v2u*)(t + 16) = (v2u){hi.x, hi.y}; *(LAS v2u*)(t + 24) = (v2u){hi.z, hi.w};
    }
    LDS_WAIT(); asm volatile("" ::: "memory");
    const int c = lane & 7, rr = lane >> 3;
#pragma unroll
    for (int j = 0; j < 8; ++j) { const int n = rr + 8 * j; const LAS unsigned char* t = scr + n * 136 + 16 * c;
        const v2u a = *(const LAS v2u*)t, b = *(const LAS v2u*)(t + 8);
        *(GAS v4u*)(WT + (size_t)(drow0 + n) * K + k0 + 8 * c) = (v4u){a.x, a.y, b.x, b.y}; }
    LDS_WAIT(); asm volatile("" ::: "memory");
}
DI int map_row(int n0, int mode) { return mode == 0 ? n0 : (mode == 1 ? 256 * (n0 >> 7) + (n0 & 127) : (mode == 2 ? 256 * (n0 >> 7) + 128 + (n0 & 127) : n0 + 512)); }
struct CvtItem { const float* src; bf16* dst; int N, K; };
DI void cvt_load(const CvtItem& I, f32x4 (&v)[16], int lane) {
    const float* src = I.src + (size_t)(16 * (lane >> 4)) * I.N + 4 * (lane & 15);
#pragma unroll
    for (int i = 0; i < 16; ++i) v[i] = __builtin_nontemporal_load((const f32x4*)(src + (size_t)i * I.N));
}
DI void cvt_finish(const CvtItem& I, const f32x4 (&v)[16], LAS unsigned char* scr, int lane) {
    const int g = lane >> 4, q = lane & 15;
#pragma unroll
    for (int e = 0; e < 4; ++e) {
        v4u lo, hi;
        lo.x = pk2(v[0][e], v[1][e]); lo.y = pk2(v[2][e], v[3][e]); lo.z = pk2(v[4][e], v[5][e]); lo.w = pk2(v[6][e], v[7][e]);
        hi.x = pk2(v[8][e], v[9][e]); hi.y = pk2(v[10][e], v[11][e]); hi.z = pk2(v[12][e], v[13][e]); hi.w = pk2(v[14][e], v[15][e]);
        LAS unsigned char* t = scr + (4 * q + e) * 136 + 32 * g;
        *(LAS v2u*)(t) = (v2u){lo.x, lo.y}; *(LAS v2u*)(t + 8) = (v2u){lo.z, lo.w}; *(LAS v2u*)(t + 16) = (v2u){hi.x, hi.y}; *(LAS v2u*)(t + 24) = (v2u){hi.z, hi.w};
    }
    LDS_WAIT(); asm volatile("" ::: "memory");
    const int c = lane & 7, rr = lane >> 3;
#pragma unroll
    for (int j = 0; j < 8; ++j) { const int n = rr + 8 * j; const LAS unsigned char* t = scr + n * 136 + 16 * c;
        const v2u a = *(const LAS v2u*)t, b = *(const LAS v2u*)(t + 8);
        *(GAS v4u*)(I.dst + (size_t)n * I.K + 8 * c) = (v4u){a.x, a.y, b.x, b.y}; }
    LDS_WAIT(); asm volatile("" ::: "memory");
}
#define CVT_MAT(Wp, K_, N_, WTp, mode) { const int cnt_ = ((K_) / 64) * ((N_) / 64); if (r >= 0 && r < cnt_) { const int nblk_ = (N_) / 64, kb_ = r / nblk_, nb_ = r % nblk_; \
        I.src = (Wp) + (size_t)(64 * kb_) * (N_) + 64 * nb_; I.dst = (WTp) + (size_t)map_row(64 * nb_, (mode)) * (K_) + 64 * kb_; I.N = (N_); I.K = (K_); } r -= cnt_; }
#define P0_MAT(Wp, K_, N_, WTp, mode) { const int cnt_ = ((K_) / 64) * ((N_) / 64); if (r < cnt_) { const int kblk_ = (K_) / 64, nb_ = r / kblk_, kb_ = r % kblk_; \
        transpose_item((Wp), (K_), (N_), 64 * kb_, 64 * nb_, (WTp), map_row(64 * nb_, (mode)), scr, lane); continue; } r -= cnt_; }

DI void ln_row(const bf16* tin, const float* part, int npart, const float* g, const float* b, float* yout, bf16* xn, int lane, float yscale = 1.0f) {
    f32x4 v[8][2]; float s = 0.f;
    { const GAS v4u* xr = (const GAS v4u*)(tin ? tin : xn) + lane; const float sc = tin ? 1.0f : ALPHA;
#pragma unroll
      for (int j = 0; j < 8; ++j) { const v4u w = xr[64 * j]; v[j][0] = (f32x4){bflo(w.x), bfhi(w.x), bflo(w.y), bfhi(w.y)} * sc; v[j][1] = (f32x4){bflo(w.z), bfhi(w.z), bflo(w.w), bfhi(w.w)} * sc; } }
    if (!tin) {
#pragma unroll 1
        for (int p = 0; p < npart; p += 4) {
            const GAS f32x4* pr = (const GAS f32x4*)(part + (size_t)p * MSAMPLE * D) + 2 * lane; constexpr size_t PS = (size_t)MSAMPLE * D / 4;
#pragma unroll
            for (int j = 0; j < 8; ++j) {
#pragma unroll
                for (int hh = 0; hh < 2; ++hh) { const f32x4 a0 = pr[128 * j + hh], a1 = pr[PS + 128 * j + hh], a2 = pr[2 * PS + 128 * j + hh], a3 = pr[3 * PS + 128 * j + hh]; v[j][hh] += (a0 + a1) + (a2 + a3); }
                if ((j & 1) == 1) __builtin_amdgcn_sched_barrier(0); } }
    }
#pragma unroll
    for (int j = 0; j < 8; ++j) s += ((v[j][0].x + v[j][0].y) + (v[j][0].z + v[j][0].w)) + ((v[j][1].x + v[j][1].y) + (v[j][1].z + v[j][1].w));
    const float mean = wave_sum(s) * (1.f / D); float s2 = 0.f;
#pragma unroll
    for (int j = 0; j < 8; ++j)
#pragma unroll
        for (int hh = 0; hh < 2; ++hh) { v[j][hh] = v[j][hh] - mean; s2 += (v[j][hh].x * v[j][hh].x + v[j][hh].y * v[j][hh].y) + (v[j][hh].z * v[j][hh].z + v[j][hh].w * v[j][hh].w); }
    const float rstd = 1.f / sqrtf(wave_sum(s2) * (1.f / D) + LN_EPS);
    GAS f32x4* o4 = (GAS f32x4*)yout + 2 * lane;
    GAS v4u* o8 = (GAS v4u*)xn + lane;
#pragma unroll
    for (int j = 0; j < 8; ++j) {
        const GAS f32x4* gp = (const GAS f32x4*)g + 2 * lane + 128 * j; const GAS f32x4* bp = (const GAS f32x4*)b + 2 * lane + 128 * j;
        const f32x4 y0 = v[j][0] * rstd * gp[0] + bp[0], y1 = v[j][1] * rstd * gp[1] + bp[1];
        if (yout) { o4[128 * j] = y0 * yscale; o4[128 * j + 1] = y1 * yscale; }
        else { v4u w; w.x = pk2(y0.x, y0.y); w.y = pk2(y0.z, y0.w); w.z = pk2(y1.x, y1.y); w.w = pk2(y1.z, y1.w); o8[64 * j] = w; }
    }
}
DI void ln_rows_prompt(LAS unsigned char* lds, const bf16* T, float* yout, bf16* XN, int gw, int NGW, int lane) {
    const LAS f32x4* gl = (const LAS f32x4*)lds + 2 * lane; const LAS f32x4* bl = (const LAS f32x4*)(lds + 16384) + 2 * lane;
    v4u w[8];
    if (gw < MPROMPT) { const GAS v4u* xr = (const GAS v4u*)(T + (size_t)gw * D) + lane;
#pragma unroll
        for (int j = 0; j < 8; ++j) w[j] = xr[64 * j]; }
#pragma unroll 1
    for (int m = gw; m < MPROMPT; m += NGW) {
        f32x4 v[8][2]; float s = 0.f;
#pragma unroll
        for (int j = 0; j < 8; ++j) { v[j][0] = (f32x4){bflo(w[j].x), bfhi(w[j].x), bflo(w[j].y), bfhi(w[j].y)}; v[j][1] = (f32x4){bflo(w[j].z), bfhi(w[j].z), bflo(w[j].w), bfhi(w[j].w)}; }
        { const int mn = (m + NGW < MPROMPT) ? m + NGW : m;
          const GAS v4u* xr = (const GAS v4u*)(T + (size_t)mn * D) + lane;
#pragma unroll
          for (int j = 0; j < 8; ++j) w[j] = xr[64 * j]; }
#pragma unroll
        for (int j = 0; j < 8; ++j) s += ((v[j][0].x + v[j][0].y) + (v[j][0].z + v[j][0].w)) + ((v[j][1].x + v[j][1].y) + (v[j][1].z + v[j][1].w));
        const float mean = wave_sum(s) * (1.f / D); float s2 = 0.f;
#pragma unroll
        for (int j = 0; j < 8; ++j)
#pragma unroll
            for (int hh = 0; hh < 2; ++hh) { v[j][hh] = v[j][hh] - mean; s2 += (v[j][hh].x * v[j][hh].x + v[j][hh].y * v[j][hh].y) + (v[j][hh].z * v[j][hh].z + v[j][hh].w * v[j][hh].w); }
        const float rstd = 1.f / sqrtf(wave_sum(s2) * (1.f / D) + LN_EPS);
        if (yout) { GAS f32x4* o4 = (GAS f32x4*)(yout + (size_t)m * D) + 2 * lane;
#pragma unroll
            for (int j = 0; j < 8; ++j) { o4[128 * j] = v[j][0] * rstd * gl[128 * j] + bl[128 * j]; o4[128 * j + 1] = v[j][1] * rstd * gl[128 * j + 1] + bl[128 * j + 1]; if (j & 1) __builtin_amdgcn_sched_barrier(0); }
        } else { GAS v4u* o8 = (GAS v4u*)(XN + (size_t)m * D) + lane;
#pragma unroll
            for (int j = 0; j < 8; ++j) { const f32x4 y0 = v[j][0] * rstd * gl[128 * j] + bl[128 * j], y1 = v[j][1] * rstd * gl[128 * j + 1] + bl[128 * j + 1];
                v4u o; o.x = pk2(y0.x, y0.y); o.y = pk2(y0.z, y0.w); o.z = pk2(y1.x, y1.y); o.w = pk2(y1.z, y1.w); o8[64 * j] = o; if (j & 1) __builtin_amdgcn_sched_barrier(0); }
        }
    }
}
DI void ln_phase(LAS unsigned char* lds, const bf16* T, const float* part, int npart, const float* g, const float* b, float* yout, bf16* XN, int gw, int NGW, int lane, float yscale_sample = 1.0f) {
    { const int tid_ = (gw & 7) * 64 + lane;
#pragma unroll
      for (int i = 0; i < 2; ++i) { *(LAS f32x4*)(lds + (tid_ + 512 * i) * 16) = ((const GAS f32x4*)g)[tid_ + 512 * i]; *(LAS f32x4*)(lds + 16384 + (tid_ + 512 * i) * 16) = ((const GAS f32x4*)b)[tid_ + 512 * i]; } }
    { const int wg = gw >> 3, nwg = NGW >> 3, j = nwg - 1 - wg;
      if ((gw & 7) == 0) for (int m = MPROMPT + j; m < MREAL; m += nwg)
          ln_row(nullptr, part + (size_t)(m - MPROMPT) * D, npart, g, b, yout ? yout + (size_t)m * D : nullptr, XN + (size_t)m * D, lane, yscale_sample); }
    LDS_WAIT(); __syncthreads();
    ln_rows_prompt(lds, T, yout, XN, gw, NGW, lane);
}
DI void copy_row(const float* src, float* xout, float oscale, bf16* xnout, int lane) {
    GAS f32x4* o4 = xout ? (GAS f32x4*)xout + lane : nullptr; GAS v2u* o8 = (GAS v2u*)xnout + lane;
#pragma unroll
    for (int j = 0; j < 16; ++j) {
        f32x4 y = {0.f, 0.f, 0.f, 0.f}; if (src) y = ((const GAS f32x4*)src)[lane + 64 * j];
        if (xout) o4[64 * j] = y * oscale;
        v2u w; w.x = pk2(y.x, y.y); w.y = pk2(y.z, y.w); o8[64 * j] = w;
    }
}

DI float reduce16(float (&v)[16], int lane) {
    const bool b5 = (lane & 32) != 0, b4 = (lane & 16) != 0, b3 = (lane & 8) != 0, b2 = (lane & 4) != 0;
#pragma unroll
    for (int i = 0; i < 8; ++i) { const float send = b5 ? v[i] : v[i + 8], keep = b5 ? v[i + 8] : v[i]; v[i] = keep + __shfl_xor(send, 32); }
#pragma unroll
    for (int i = 0; i < 4; ++i) { const float send = b4 ? v[i] : v[i + 4], keep = b4 ? v[i + 4] : v[i]; v[i] = keep + __shfl_xor(send, 16); }
#pragma unroll
    for (int i = 0; i < 2; ++i) { const float send = b3 ? v[i] : v[i + 2], keep = b3 ? v[i + 2] : v[i]; v[i] = keep + __shfl_xor(send, 8); }
    { const float send = b2 ? v[0] : v[1], keep = b2 ? v[1] : v[0]; v[0] = keep + __shfl_xor(send, 4); }
    v[0] += __shfl_xor(v[0], 2); v[0] += __shfl_xor(v[0], 1);
    return v[0];
}
DI int idx16(int lane) { return ((lane >> 5) & 1) * 8 + ((lane >> 4) & 1) * 4 + ((lane >> 3) & 1) * 2 + ((lane >> 2) & 1); }
DI float gelu_tanh(float x) { const float u = 0.7978845608028654f * (x + 0.044715f * x * x * x); const float t = 1.0f - 2.0f * __builtin_amdgcn_rcpf(1.0f + __expf(2.0f * u)); return 0.5f * x * (1.0f + t); }

struct S5Par { float ar, ai; float bbr[16], bbi[16], cr[16], ci[16]; float dsel; int hidx; };

template <bool WITH_Y>
DI void s5_block(const bf16* urows, int ntok, LAS float* ubuf, LAS float* ybuf, bf16* zrows, int lane, const S5Par& P, float& hr, float& hi) {
    if (lane < ntok) {
        const v4u a = *(const v4u*)(urows + (size_t)lane * NE), b = *(const v4u*)(urows + (size_t)lane * NE + 8);
        LAS f32x4* w = (LAS f32x4*)(ubuf + lane * 16);
        w[0] = (f32x4){bflo(a.x), bfhi(a.x), bflo(a.y), bfhi(a.y)}; w[1] = (f32x4){bflo(a.z), bfhi(a.z), bflo(a.w), bfhi(a.w)};
        w[2] = (f32x4){bflo(b.x), bfhi(b.x), bflo(b.y), bfhi(b.y)}; w[3] = (f32x4){bflo(b.z), bfhi(b.z), bflo(b.w), bfhi(b.w)};
    }
    LDS_WAIT(); asm volatile("" ::: "memory");
#pragma unroll 4
    for (int t = 0; t < ntok; ++t) {
        const LAS f32x4* up = (const LAS f32x4*)(ubuf + t * 16);
        const f32x4 u0 = up[0], u1 = up[1], u2 = up[2], u3 = up[3];
        const float u[16] = {u0.x, u0.y, u0.z, u0.w, u1.x, u1.y, u1.z, u1.w, u2.x, u2.y, u2.z, u2.w, u3.x, u3.y, u3.z, u3.w};
        float bur = 0.f, bui = 0.f;
#pragma unroll
        for (int h = 0; h < 16; ++h) { bur += P.bbr[h] * u[h]; bui += P.bbi[h] * u[h]; }
        const float nhr = P.ar * hr - P.ai * hi + bur, nhi = P.ar * hi + P.ai * hr + bui;
        hr = nhr; hi = nhi;
        if (WITH_Y) {
            float v[16];
#pragma unroll
            for (int h = 0; h < 16; ++h) v[h] = P.cr[h] * hr - P.ci[h] * hi;
            const float y = reduce16(v, lane) + P.dsel * ubuf[t * 16 + P.hidx];
            if ((lane & 3) == 0) ybuf[t * 16 + P.hidx] = gelu_tanh(y);
        }
    }
    if (WITH_Y) {
        LDS_WAIT(); asm volatile("" ::: "memory");
        if (lane < ntok) {
            const LAS f32x4* yp = (const LAS f32x4*)(ybuf + lane * 16);
            const f32x4 y0 = yp[0], y1 = yp[1], y2 = yp[2], y3 = yp[3];
            v4u a, b; a.x = pk2(y0.x, y0.y); a.y = pk2(y0.z, y0.w); a.z = pk2(y1.x, y1.y); a.w = pk2(y1.z, y1.w);
            b.x = pk2(y2.x, y2.y); b.y = pk2(y2.z, y2.w); b.z = pk2(y3.x, y3.y); b.w = pk2(y3.z, y3.w);
            *(v4u*)(zrows + (size_t)lane * 2048) = a; *(v4u*)(zrows + (size_t)lane * 2048 + 8) = b;
        }
    }
    LDS_WAIT(); asm volatile("" ::: "memory");
}
DI void s5_load_par(S5Par& P, const float* AB, const float* BB, const float* c_re, const float* c_im, const float* dsk, int g, int lane) {
    const f32x2 ab = *(const f32x2*)(AB + (size_t)(g * 64 + lane) * 2); P.ar = ab.x; P.ai = ab.y;
    const f32x4* bb = (const f32x4*)(BB + (size_t)(g * 64 + lane) * 32);
#pragma unroll
    for (int q = 0; q < 4; ++q) { const f32x4 r = bb[q], i = bb[4 + q]; P.bbr[4 * q] = r.x; P.bbr[4 * q + 1] = r.y; P.bbr[4 * q + 2] = r.z; P.bbr[4 * q + 3] = r.w;
        P.bbi[4 * q] = i.x; P.bbi[4 * q + 1] = i.y; P.bbi[4 * q + 2] = i.z; P.bbi[4 * q + 3] = i.w; }
#pragma unroll
    for (int h = 0; h < 16; ++h) { P.cr[h] = c_re[(size_t)g * 1024 + h * 64 + lane]; P.ci[h] = c_im[(size_t)g * 1024 + h * 64 + lane]; }
    P.hidx = idx16(lane); P.dsel = dsk[g * 16 + P.hidx];
}
DI void s5_prompt_unit(LAS unsigned char* lds, const bf16* H0, bf16* Z, const float* AB, const float* BB, const float* c_re, const float* c_im, const float* dsk,
                       float* ps5r, float* ps5i, int b, int g, int wid, int lane) {
    S5Par P; s5_load_par(P, AB, BB, c_re, c_im, dsk, g, lane);
    LAS float* ubuf = (LAS float*)(lds + wid * 8192); LAS float* ybuf = ubuf + 1024;
    LAS f32x2* HE = (LAS f32x2*)(lds + 65536);
    const int rowbase = b * PSEQ + 256 * wid;
    float hr = 0.f, hi = 0.f;
    for (int blk = 0; blk < 4; ++blk) s5_block<false>(H0 + (size_t)(rowbase + 64 * blk) * NE + 16 * g, 64, ubuf, ybuf, nullptr, lane, P, hr, hi);
    HE[wid * 64 + lane] = (f32x2){hr, hi};
    LDS_WAIT(); __syncthreads();
    float pr = P.ar, pi = P.ai;
#pragma unroll
    for (int s = 0; s < 8; ++s) { const float nr = pr * pr - pi * pi, ni = 2.f * pr * pi; pr = nr; pi = ni; }
    hr = 0.f; hi = 0.f;
    for (int v = 0; v < wid; ++v) { const f32x2 e = HE[v * 64 + lane]; const float nr = pr * hr - pi * hi + e.x, ni = pr * hi + pi * hr + e.y; hr = nr; hi = ni; }
    for (int blk = 0; blk < 4; ++blk)
        s5_block<true>(H0 + (size_t)(rowbase + 64 * blk) * NE + 16 * g, 64, ubuf, ybuf, Z + (size_t)(rowbase + 64 * blk) * 2048 + 16 * g, lane, P, hr, hi);
    if (wid == 7) { ps5r[(size_t)(b * 128 + g) * 64 + lane] = hr; ps5i[(size_t)(b * 128 + g) * 64 + lane] = hi; }
    __syncthreads();
}
DI void s5_sample_wave(LAS unsigned char* lds, const bf16* H0, bf16* Z, const float* AB, const float* BB, const float* c_re, const float* c_im, const float* dsk,
                       const float* st_re, const float* st_im, float* ss5r, float* ss5i, int g, int b0, int nb, int wid, int lane) {
    S5Par P; s5_load_par(P, AB, BB, c_re, c_im, dsk, g, lane);
    LAS float* ubuf = (LAS float*)(lds + wid * 8192); LAS float* ybuf = ubuf + 1024;
    for (int b = b0; b < b0 + nb; ++b) {
        float hr = st_re[(size_t)(b * 128 + g) * 64 + lane], hi = st_im[(size_t)(b * 128 + g) * 64 + lane];
        const int row = MPROMPT + 4 * b;
        s5_block<true>(H0 + (size_t)row * NE + 16 * g, 4, ubuf, ybuf, Z + (size_t)row * 2048 + 16 * g, lane, P, hr, hi);
        ss5r[(size_t)(b * 128 + g) * 64 + lane] = hr; ss5i[(size_t)(b * 128 + g) * 64 + lane] = hi;
    }
}

constexpr int SWA_KS = 144, SWA_VS = 392, SWA_VT_OFF = 192 * SWA_KS, SWA_BT_OFF = SWA_VT_OFF + 64 * SWA_VS;
DI bf16x8 pack8(const f32x16& x, int s) {
    v4u p; p.x = pk2(x[8 * s], x[8 * s + 1]); p.y = pk2(x[8 * s + 2], x[8 * s + 3]); p.z = pk2(x[8 * s + 4], x[8 * s + 5]); p.w = pk2(x[8 * s + 6], x[8 * s + 7]);
    return __builtin_bit_cast(bf16x8, p);
}
DI void swa_prompt_unit(LAS unsigned char* lds, const bf16* H0, bf16* MIX, const float* BT, const float* sinks, float* pk_out, float* pv_out,
                        int b, int kvh, int qb, int tid, int wid, int lane) {
    const int q0 = qb * 64;
#pragma unroll
    for (int i = 0; i < 3; ++i) {
        const int c = tid + 512 * i, row = c >> 3, part = c & 7, t = q0 - 128 + row;
        v4u val = {0u, 0u, 0u, 0u};
        if (t >= 0) val = *(const v4u*)(H0 + (size_t)(b * PSEQ + t) * NE + 4096 + kvh * 64 + part * 8);
        *(LAS v4u*)(lds + row * SWA_KS + part * 16) = val;
    }
#pragma unroll
    for (int i = 0; i < 3; ++i) {
        const int c = tid + 512 * i, key = c % 192, dc = c / 192, t = q0 - 128 + key;
        v4u val = {0u, 0u, 0u, 0u};
        if (t >= 0) val = *(const v4u*)(H0 + (size_t)(b * PSEQ + t) * NE + 4608 + kvh * 64 + dc * 8);
        LAS unsigned char* vt = lds + SWA_VT_OFF + (8 * dc) * SWA_VS + key * 2;
        *(LAS bf16*)(vt + 0 * SWA_VS) = (bf16)(val.x & 0xffffu); *(LAS bf16*)(vt + 1 * SWA_VS) = (bf16)(val.x >> 16);
        *(LAS bf16*)(vt + 2 * SWA_VS) = (bf16)(val.y & 0xffffu); *(LAS bf16*)(vt + 3 * SWA_VS) = (bf16)(val.y >> 16);
        *(LAS bf16*)(vt + 4 * SWA_VS) = (bf16)(val.z & 0xffffu); *(LAS bf16*)(vt + 5 * SWA_VS) = (bf16)(val.z >> 16);
        *(LAS bf16*)(vt + 6 * SWA_VS) = (bf16)(val.w & 0xffffu); *(LAS bf16*)(vt + 7 * SWA_VS) = (bf16)(val.w >> 16);
    }
    for (int e = tid; e < 768; e += 512) { const int gg = e / 192, x = e % 192; const int dist = 159 - x;
        ((LAS float*)(lds + SWA_BT_OFF))[e] = (dist >= 0 && dist < 128) ? BT[(size_t)(4 * kvh + gg) * 128 + dist] : -1.0e30f; }
    LDS_WAIT(); __syncthreads();
    if (qb == 31) {
        for (int e = tid; e < 128 * 64; e += 512) { const int j = e >> 6, d = e & 63;
            pk_out[((size_t)(b * 128 + j) * 8 + kvh) * 64 + d] = bf2f(*(const LAS bf16*)(lds + (64 + j) * SWA_KS + d * 2));
            pv_out[((size_t)(b * 128 + j) * 8 + kvh) * 64 + d] = bf2f(*(const LAS bf16*)(lds + SWA_VT_OFF + d * SWA_VS + (64 + j) * 2)); }
    }
    const int g = wid & 3, s = wid >> 2, hq = 4 * kvh + g, r = lane & 31, h = lane >> 5;
    const int tq = q0 + 32 * s + r; const size_t rowq = (size_t)(b * PSEQ + tq);
    bf16x8 qf[4];
#pragma unroll
    for (int ks = 0; ks < 4; ++ks) qf[ks] = *(const bf16x8*)(H0 + rowq * NE + 2048 + hq * 64 + 16 * ks + 8 * h);
    f32x16 S[5];
#pragma unroll
    for (int j = 0; j < 5; ++j) {
#pragma unroll
        for (int i = 0; i < 16; ++i) S[j][i] = 0.f;
#pragma unroll
        for (int ks = 0; ks < 4; ++ks) { const bf16x8 a = *(const LAS bf16x8*)(lds + (32 * (s + j) + r) * SWA_KS + (16 * ks + 8 * h) * 2); S[j] = MFMA32(a, qf[ks], S[j]); }
        __builtin_amdgcn_sched_barrier(0);
    }
    const LAS float* bt = (const LAS float*)(lds + SWA_BT_OFF) + g * 192 + (31 - r + 4 * h);
    const int thr = 128 - q0 - 32 * s - 4 * h;
    const float sink = sinks[hq];
    float mx = -3.0e38f;
#pragma unroll
    for (int j = 0; j < 5; ++j) {
#pragma unroll
        for (int i = 0; i < 16; ++i) { const int cji = 32 * j + (i & 3) + 8 * (i >> 2);
            const float sc = S[j][i] * 0.125f + bt[cji]; S[j][i] = (cji >= thr) ? sc : -1.0e30f; mx = fmaxf(mx, S[j][i]); }
        __builtin_amdgcn_sched_barrier(0); }
    mx = fmaxf(mx, __shfl_xor(mx, 32)); mx = fmaxf(mx, sink);
    float sum = 0.f;
#pragma unroll
    for (int j = 0; j < 5; ++j)
#pragma unroll
        for (int i = 0; i < 16; ++i) { const float p = __expf(S[j][i] - mx); S[j][i] = p; sum += p; }
    sum += __shfl_xor(sum, 32);
    const float inv = 1.0f / (sum + __expf(sink - mx));
    f32x16 O[2];
#pragma unroll
    for (int dt = 0; dt < 2; ++dt)
#pragma unroll
        for (int i = 0; i < 16; ++i) O[dt][i] = 0.f;
#pragma unroll
    for (int j = 0; j < 5; ++j)
#pragma unroll
        for (int k2 = 0; k2 < 2; ++k2) { const bf16x8 pf = pack8(S[j], k2);
#pragma unroll
            for (int dt = 0; dt < 2; ++dt) { const LAS unsigned char* vp = lds + SWA_VT_OFF + (32 * dt + r) * SWA_VS + (32 * (s + j) + 16 * k2 + 4 * h) * 2;
                const v2u lo = *(const LAS v2u*)vp, hi2 = *(const LAS v2u*)(vp + 16);
                v4u av; av.x = lo.x; av.y = lo.y; av.z = hi2.x; av.w = hi2.y;
                O[dt] = MFMA32(__builtin_bit_cast(bf16x8, av), pf, O[dt]); }
            __builtin_amdgcn_sched_barrier(0); }
    bf16* orow = MIX + rowq * D + 2048 + hq * 64;
#pragma unroll
    for (int dt = 0; dt < 2; ++dt)
#pragma unroll
        for (int q4 = 0; q4 < 4; ++q4) { v2u w; w.x = pk2(O[dt][4 * q4] * inv, O[dt][4 * q4 + 1] * inv); w.y = pk2(O[dt][4 * q4 + 2] * inv, O[dt][4 * q4 + 3] * inv);
            *(v2u*)(orow + 32 * dt + 8 * q4 + 4 * h) = w; }
    __syncthreads();
}

constexpr int SS_K = 0, SS_V = 132 * 65 * 4, SS_BT = SS_V + 132 * 64 * 4, SS_Q = SS_BT + 2048, SS_P = SS_Q + 4 * 1024;
DI void swa_sample_unit(LAS unsigned char* lds, const bf16* H0, bf16* MIX, const float* BT, const float* sinks, const float* ck, const float* cv, float* sk_out, float* sv_out,
                        int b, int kvh, int tid, int wid, int lane) {
    LAS float* Kf = (LAS float*)(lds + SS_K); LAS float* Vf = (LAS float*)(lds + SS_V); LAS float* bt = (LAS float*)(lds + SS_BT);
    for (int e = tid; e < 132 * 64; e += 512) { const int L = e >> 6, d = e & 63; float kv, vv;
        if (L < 128) { kv = ck[((size_t)(b * 128 + L) * 8 + kvh) * 64 + d]; vv = cv[((size_t)(b * 128 + L) * 8 + kvh) * 64 + d]; }
        else { const size_t row = (size_t)(MPROMPT + 4 * b + (L - 128)); kv = bf2f(H0[row * NE + 4096 + kvh * 64 + d]); vv = bf2f(H0[row * NE + 4608 + kvh * 64 + d]); }
        Kf[L * 65 + d] = kv; Vf[L * 64 + d] = vv;
        if (L >= 4) { sk_out[((size_t)(b * 128 + (L - 4)) * 8 + kvh) * 64 + d] = kv; sv_out[((size_t)(b * 128 + (L - 4)) * 8 + kvh) * 64 + d] = vv; }
    }
    bt[tid] = BT[(size_t)(4 * kvh + (tid >> 7)) * 128 + (tid & 127)];
    LDS_WAIT(); __syncthreads();
    if (wid < 4) {
        const int t = wid; const size_t row = (size_t)(MPROMPT + 4 * b + t);
        LAS float* qs = (LAS float*)(lds + SS_Q + wid * 1024); LAS float* ps = (LAS float*)(lds + SS_P + wid * 2048);
#pragma unroll
        for (int g = 0; g < 4; ++g) qs[g * 64 + lane] = bf2f(H0[row * NE + 2048 + (4 * kvh + g) * 64 + lane]) * 0.125f;
        LDS_WAIT(); asm volatile("" ::: "memory");
        const int L1 = t + 1 + lane, L2 = t + 65 + lane;
        float s1[4] = {0.f, 0.f, 0.f, 0.f}, s2[4] = {0.f, 0.f, 0.f, 0.f};
        for (int d = 0; d < 64; ++d) { const float k1 = Kf[L1 * 65 + d], k2 = Kf[L2 * 65 + d];
#pragma unroll
            for (int g = 0; g < 4; ++g) { const float q = qs[g * 64 + d]; s1[g] += q * k1; s2[g] += q * k2; } }
        float inv[4];
#pragma unroll
        for (int g = 0; g < 4; ++g) {
            const float a1 = s1[g] + bt[g * 128 + 127 - lane], a2 = s2[g] + bt[g * 128 + 63 - lane];
            const float sink = sinks[4 * kvh + g];
            const float mx = fmaxf(wave_max(fmaxf(a1, a2)), sink);
            const float p1 = __expf(a1 - mx), p2 = __expf(a2 - mx);
            inv[g] = 1.0f / (wave_sum(p1 + p2) + __expf(sink - mx));
            ps[g * 128 + lane] = p1; ps[g * 128 + 64 + lane] = p2;
        }
        LDS_WAIT(); asm volatile("" ::: "memory");
        float o[4] = {0.f, 0.f, 0.f, 0.f};
        for (int kk = 0; kk < 128; ++kk) { const float v = Vf[(t + 1 + kk) * 64 + lane];
#pragma unroll
            for (int g = 0; g < 4; ++g) o[g] += ps[g * 128 + kk] * v; }
#pragma unroll
        for (int g = 0; g < 4; ++g) MIX[row * D + 2048 + (4 * kvh + g) * 64 + lane] = (bf16)(pk2(o[g] * inv[g], 0.f) & 0xffffu);
    }
    __syncthreads();
}

constexpr size_t S5T_KF = 0, S5T_EF = 33 * 1024, S5T_FF = S5T_EF + 128 * 1024, S5T_GROUP = S5T_FF + 128 * 1024;
DI void cmul(float& xr, float& xi, float yr, float yi) { const float r = xr * yr - xi * yi, i = xr * yi + xi * yr; xr = r; xi = i; }

DI void s5_build_tables(unsigned char* tab, const float* AB, const float* BB, const float* c_re, const float* c_im, const float* dsk, int gt, int NGT) {
    for (int e = gt; e < 128 * 1024; e += NGT) {
        const int g = e >> 10, h = (e >> 6) & 15, hp = (e >> 2) & 15, pq = e & 3;
        float K[33];
#pragma unroll
        for (int l = 0; l < 33; ++l) K[l] = 0.f;
        for (int p = 16 * pq; p < 16 * pq + 16; ++p) {
            const float ar = AB[(size_t)(g * 64 + p) * 2], ai = AB[(size_t)(g * 64 + p) * 2 + 1];
            const float br = BB[(size_t)(g * 64 + p) * 32 + hp], bi = BB[(size_t)(g * 64 + p) * 32 + 16 + hp];
            const float cr = c_re[(size_t)g * 1024 + h * 64 + p], ci = c_im[(size_t)g * 1024 + h * 64 + p];
            float zr = cr * br - ci * bi, zi = cr * bi + ci * br;
#pragma unroll
            for (int l = 0; l < 33; ++l) { K[l] += zr; cmul(zr, zi, ar, ai); }
        }
#pragma unroll
        for (int l = 0; l < 33; ++l) {
            K[l] += __builtin_bit_cast(float, __builtin_amdgcn_update_dpp(0, __builtin_bit_cast(int, K[l]), 0xB1, 0xF, 0xF, true));
            K[l] += __builtin_bit_cast(float, __builtin_amdgcn_update_dpp(0, __builtin_bit_cast(int, K[l]), 0x4E, 0xF, 0xF, true)); }
        if (h == hp) K[0] += dsk[g * 16 + h];
        bf16* kf = (bf16*)(tab + (size_t)g * S5T_GROUP + S5T_KF);
#pragma unroll
        for (int f = 0; f < 33; ++f)
#pragma unroll
            for (int tl = 0; tl < 2; ++tl) { const int lag = f - 1 + tl; const float v = (lag >= 0 && lag <= 32) ? K[lag < 33 ? (lag < 0 ? 0 : lag) : 32] : 0.f;
                if ((f & 3) == pq) kf[((size_t)f * 64 + (tl * 16 + h) + 32 * (hp >> 3)) * 8 + (hp & 7)] = (bf16)(pk2(lag >= 0 ? v : 0.f, 0.f) & 0xffffu); }
    }
    for (int e = gt; e < 128 * 1024; e += NGT) {
        const int g = e >> 10, p = (e >> 4) & 63, hp = e & 15;
        const float ar = AB[(size_t)(g * 64 + p) * 2], ai = AB[(size_t)(g * 64 + p) * 2 + 1];
        float wr = BB[(size_t)(g * 64 + p) * 32 + hp], wi = BB[(size_t)(g * 64 + p) * 32 + 16 + hp];
        bf16* ef = (bf16*)(tab + (size_t)g * S5T_GROUP + S5T_EF);
        const int Jr = p >> 5, r = p & 31, lanei = r + 32 * (hp >> 3), el = hp & 7;
        for (int s = 31; s >= 0; --s) {
            ef[((size_t)(Jr * 32 + s) * 64 + lanei) * 8 + el] = (bf16)(pk2(wr, 0.f) & 0xffffu);
            ef[((size_t)((Jr + 2) * 32 + s) * 64 + lanei) * 8 + el] = (bf16)(pk2(wi, 0.f) & 0xffffu);
            cmul(wr, wi, ar, ai);
        }
    }
    for (int e = gt; e < 128 * 1024; e += NGT) {
        const int g = e >> 10, h = (e >> 6) & 15, p = e & 63;
        const float ar = AB[(size_t)(g * 64 + p) * 2], ai = AB[(size_t)(g * 64 + p) * 2 + 1];
        float zr = c_re[(size_t)g * 1024 + h * 64 + p], zi = c_im[(size_t)g * 1024 + h * 64 + p];
        bf16* ff = (bf16*)(tab + (size_t)g * S5T_GROUP + S5T_FF);
        const int kk = p >> 4, hf = (p >> 3) & 1, j = p & 7;
        for (int n = 1; n <= 32; ++n) {
            cmul(zr, zi, ar, ai);
            const int t = n - 1, I = t >> 1, row = (t & 1) * 16 + h, lanei = row + 32 * hf;
            ff[((size_t)(I * 8 + kk) * 64 + lanei) * 8 + j] = (bf16)(pk2(zr, 0.f) & 0xffffu);
            ff[((size_t)(I * 8 + 4 + kk) * 64 + lanei) * 8 + j] = (bf16)(pk2(-zi, 0.f) & 0xffffu);
        }
    }
}

constexpr int S5_HLOC_ROW = 520, S5_HIN_OFF = 128 * S5_HLOC_ROW, S5_HIN_ROW = 272;
DI void s5_mfma_unit(LAS unsigned char* lds, const bf16* H0, bf16* Z, const unsigned char* tab, const float* AB, float* ps5r, float* ps5i, int g, int tid, int wid, int lane) {
    const unsigned char* tg = tab + (size_t)g * S5T_GROUP;
    const int r = lane & 31, hf = lane >> 5, b = wid >> 1, odd = wid & 1;
    const int chunk = 32 * odd + r;
    const bf16* ucol = H0 + (size_t)(b * PSEQ + 32 * chunk) * NE + 16 * g + 8 * hf;
    const v4u* KFp = (const v4u*)(tg + S5T_KF) + lane; const v4u* EFp = (const v4u*)(tg + S5T_EF) + lane; const v4u* FFp = (const v4u*)(tg + S5T_FF) + lane;
    {
        f32x16 HJ[4];
#pragma unroll
        for (int J = 0; J < 4; ++J)
#pragma unroll
            for (int i = 0; i < 16; ++i) HJ[J][i] = 0.f;
#pragma unroll 4
        for (int s = 0; s < 32; ++s) {
            const bf16x8 uf = *(const bf16x8*)(ucol + (size_t)s * NE);
#pragma unroll
            for (int J = 0; J < 4; ++J) { const bf16x8 af = __builtin_bit_cast(bf16x8, EFp[(size_t)(J * 32 + s) * 64]); HJ[J] = MFMA32(af, uf, HJ[J]); }
            if ((s & 3) == 3) __builtin_amdgcn_sched_barrier(0);
        }
        for (int rd = 0; rd < 2; ++rd) {
            if ((wid >> 2) == rd) {
                const int bl = b & 1;
#pragma unroll
                for (int J = 0; J < 4; ++J)
#pragma unroll
                    for (int i = 0; i < 16; ++i) *(LAS float*)(lds + (bl * 64 + 32 * (J & 1) + crow(i, hf)) * S5_HLOC_ROW + chunk * 8 + (J >> 1) * 4) = HJ[J][i];
            }
            LDS_WAIT(); __syncthreads();
            if (tid < 128) {
                const int bl = tid >> 6, p = tid & 63, bb = 2 * rd + bl;
                const f32x2 a = *(const f32x2*)(AB + (size_t)(g * 64 + p) * 2); float Ar = a.x, Ai = a.y;
#pragma unroll
                for (int k = 0; k < 5; ++k) cmul(Ar, Ai, Ar, Ai);
                float hr = 0.f, hi = 0.f;
                const LAS unsigned char* xrow = lds + (bl * 64 + p) * S5_HLOC_ROW;
                LAS unsigned char* hin = lds + S5_HIN_OFF + (bb * 64) * S5_HIN_ROW + p * 2;
#pragma unroll 8
                for (int c = 0; c < 64; ++c) {
                    const f32x2 x = *(const LAS f32x2*)(xrow + c * 8);
                    *(LAS bf16*)(hin + c * S5_HIN_ROW) = (bf16)(pk2(hr, 0.f) & 0xffffu); *(LAS bf16*)(hin + c * S5_HIN_ROW + 128) = (bf16)(pk2(hi, 0.f) & 0xffffu);
                    const float nr = Ar * hr - Ai * hi + x.x, ni = Ar * hi + Ai * hr + x.y; hr = nr; hi = ni;
                }
                ps5r[(size_t)(bb * 128 + g) * 64 + p] = hr; ps5i[(size_t)(bb * 128 + g) * 64 + p] = hi;
            }
            LDS_WAIT(); __syncthreads();
        }
    }
    bf16x8 HB[8];
#pragma unroll
    for (int kk = 0; kk < 8; ++kk) HB[kk] = *(const LAS bf16x8*)(lds + S5_HIN_OFF + (32 * wid + r) * S5_HIN_ROW + (16 * kk + 8 * hf) * 2);
    asm volatile("" : "+v"(ucol));
#pragma unroll
    for (int pass = 0; pass < 2; ++pass) {
        f32x16 Y[8];
#pragma unroll
        for (int q = 0; q < 8; ++q)
#pragma unroll
            for (int i = 0; i < 16; ++i) Y[q][i] = 0.f;
        const int I0 = 8 * pass, smax = 16 * pass + 15;
#pragma unroll 2
        for (int s = 0; s <= smax; ++s) {
            const bf16x8 uf = *(const bf16x8*)(ucol + (size_t)s * NE);
#pragma unroll
            for (int q = 0; q < 8; ++q) { const int d = 2 * (I0 + q) - s;
                if (d >= -1) { const bf16x8 kf = __builtin_bit_cast(bf16x8, KFp[(size_t)(d + 1) * 64]); Y[q] = MFMA32(kf, uf, Y[q]); } }
            __builtin_amdgcn_sched_barrier(0);
        }
#pragma unroll
        for (int kk = 0; kk < 8; ++kk) {
#pragma unroll
            for (int q = 0; q < 8; ++q) { const bf16x8 ff = __builtin_bit_cast(bf16x8, FFp[(size_t)((I0 + q) * 8 + kk) * 64]); Y[q] = MFMA32(ff, HB[kk], Y[q]); }
            __builtin_amdgcn_sched_barrier(0); }
#pragma unroll
        for (int q = 0; q < 8; ++q) {
            int zrow = b * PSEQ + 32 * chunk + 2 * (I0 + q); asm volatile("" : "+v"(zrow));
            bf16* zq = Z + (size_t)zrow * 2048 + 16 * g + 4 * hf;
#pragma unroll
            for (int q4 = 0; q4 < 4; ++q4) {
                v2u w; w.x = pk2(gelu_tanh(Y[q][4 * q4]), gelu_tanh(Y[q][4 * q4 + 1])); w.y = pk2(gelu_tanh(Y[q][4 * q4 + 2]), gelu_tanh(Y[q][4 * q4 + 3]));
                *(v2u*)(zq + (q4 >> 1) * 2048 + 8 * (q4 & 1)) = w; }
            __builtin_amdgcn_sched_barrier(0);
        }
    }
    __syncthreads();
}

constexpr int CA_KS = 272, CA_VS = 520, CA_VT_OFF = 256 * CA_KS;
DI void cross_prompt_unit(LAS unsigned char* lds, const float* QP  , const bf16* KVM  , bf16* CO, int b, int hd, int qblk, int tid, int wid, int lane) {
#pragma unroll
    for (int i = 0; i < 8; ++i) {
        const int c = tid + 512 * i, row = c >> 4, part = c & 15;
        const v4u val = *(const v4u*)(KVM + (size_t)(b * 256 + row) * 1024 + hd * 128 + part * 8);
        *(LAS v4u*)(lds + row * CA_KS + part * 16) = val;
    }
#pragma unroll
    for (int i = 0; i < 8; ++i) {
        const int c = tid + 512 * i, key = c & 255, dc = c >> 8;
        const v4u val = *(const v4u*)(KVM + (size_t)(b * 256 + key) * 1024 + 512 + hd * 128 + dc * 8);
        LAS unsigned char* vt = lds + CA_VT_OFF + (8 * dc) * CA_VS + key * 2;
        *(LAS bf16*)(vt + 0 * CA_VS) = (bf16)(val.x & 0xffffu); *(LAS bf16*)(vt + 1 * CA_VS) = (bf16)(val.x >> 16);
        *(LAS bf16*)(vt + 2 * CA_VS) = (bf16)(val.y & 0xffffu); *(LAS bf16*)(vt + 3 * CA_VS) = (bf16)(val.y >> 16);
        *(LAS bf16*)(vt + 4 * CA_VS) = (bf16)(val.z & 0xffffu); *(LAS bf16*)(vt + 5 * CA_VS) = (bf16)(val.z >> 16);
        *(LAS bf16*)(vt + 6 * CA_VS) = (bf16)(val.w & 0xffffu); *(LAS bf16*)(vt + 7 * CA_VS) = (bf16)(val.w >> 16);
    }
    LDS_WAIT(); __syncthreads();
    const int r = lane & 31, h = lane >> 5;
    const size_t rowq = (size_t)(b * PSEQ + qblk * 256 + 32 * wid + r);
    bf16x8 qf[8];
#pragma unroll
    for (int ks = 0; ks < 8; ++ks) { const float* qp = QP + rowq * DM + hd * 128 + 16 * ks + 8 * h; f32x4 lo = {0.f, 0.f, 0.f, 0.f}, hi4 = lo;
#pragma unroll
        for (int sl = 0; sl < 4; ++sl) { lo += *(const f32x4*)(qp + (size_t)sl * MPROMPT * DM); hi4 += *(const f32x4*)(qp + (size_t)sl * MPROMPT * DM + 4); }
        v4u w; w.x = pk2(lo[0], lo[1]); w.y = pk2(lo[2], lo[3]); w.z = pk2(hi4[0], hi4[1]); w.w = pk2(hi4[2], hi4[3]); qf[ks] = __builtin_bit_cast(bf16x8, w); }
    f32x16 O[4];
#pragma unroll
    for (int dt = 0; dt < 4; ++dt)
#pragma unroll
        for (int i = 0; i < 16; ++i) O[dt][i] = 0.f;
    float mrun = -1.0e30f, lrun = 0.f;
    const float scale = 0.08838834764831845f;
#pragma unroll 1
    for (int c4 = 0; c4 < 4; ++c4) {
        f32x16 S[2];
#pragma unroll
        for (int tt = 0; tt < 2; ++tt) {
#pragma unroll
            for (int i = 0; i < 16; ++i) S[tt][i] = 0.f;
#pragma unroll
            for (int ks = 0; ks < 8; ++ks) { const bf16x8 a = *(const LAS bf16x8*)(lds + (64 * c4 + 32 * tt + r) * CA_KS + (16 * ks + 8 * h) * 2); S[tt] = MFMA32(a, qf[ks], S[tt]); }
        }
        float cm = -3.0e38f;
#pragma unroll
        for (int tt = 0; tt < 2; ++tt)
#pragma unroll
            for (int i = 0; i < 16; ++i) { S[tt][i] *= scale; cm = fmaxf(cm, S[tt][i]); }
        cm = fmaxf(cm, __shfl_xor(cm, 32));
        const float mnew = fmaxf(mrun, cm), alpha = __expf(mrun - mnew);
        float ps = 0.f;
#pragma unroll
        for (int tt = 0; tt < 2; ++tt)
#pragma unroll
            for (int i = 0; i < 16; ++i) { const float p = __expf(S[tt][i] - mnew); S[tt][i] = p; ps += p; }
        lrun = lrun * alpha + ps; mrun = mnew;
#pragma unroll
        for (int dt = 0; dt < 4; ++dt)
#pragma unroll
            for (int i = 0; i < 16; ++i) O[dt][i] *= alpha;
#pragma unroll
        for (int tt = 0; tt < 2; ++tt)
#pragma unroll
            for (int k2 = 0; k2 < 2; ++k2) { const bf16x8 pf = pack8(S[tt], k2);
#pragma unroll
                for (int dt = 0; dt < 4; ++dt) { const LAS unsigned char* vp = lds + CA_VT_OFF + (32 * dt + r) * CA_VS + (64 * c4 + 32 * tt + 16 * k2 + 4 * h) * 2;
                    const v2u lo = *(const LAS v2u*)vp, hi2 = *(const LAS v2u*)(vp + 16);
                    v4u av; av.x = lo.x; av.y = lo.y; av.z = hi2.x; av.w = hi2.y;
                    O[dt] = MFMA32(__builtin_bit_cast(bf16x8, av), pf, O[dt]); } }
    }
    lrun += __shfl_xor(lrun, 32);
    const float inv = 1.0f / lrun;
    bf16* orow = CO + rowq * DM + hd * 128;
#pragma unroll
    for (int dt = 0; dt < 4; ++dt)
#pragma unroll
        for (int q4 = 0; q4 < 4; ++q4) { v2u w; w.x = pk2(O[dt][4 * q4] * inv, O[dt][4 * q4 + 1] * inv); w.y = pk2(O[dt][4 * q4 + 2] * inv, O[dt][4 * q4 + 3] * inv);
            *(v2u*)(orow + 32 * dt + 8 * q4 + 4 * h) = w; }
    __syncthreads();
}
DI void cross_sample_unit(LAS unsigned char* lds, const float* QS  , const float* ck, const float* cv, bf16* CO, int b, int hd, int tid, int wid, int lane) {
    LAS float* sc = (LAS float*)lds;
    LAS float* po = (LAS float*)(lds + 4096);
    const int l32 = lane & 31, half = lane >> 5;
    f32x4 qv[4];
#pragma unroll
    for (int t = 0; t < 4; ++t) { f32x4 q = {0.f, 0.f, 0.f, 0.f};
#pragma unroll
        for (int sl = 0; sl < 8; ++sl) q += *(const f32x4*)(QS + ((size_t)sl * MSAMPLE + 4 * b + t) * DM + hd * 128 + 4 * l32);
        v2u w; w.x = pk2(q[0], q[1]); w.y = pk2(q[2], q[3]); qv[t] = (f32x4){bflo(w.x), bfhi(w.x), bflo(w.y), bfhi(w.y)}; }
    const float* kb = ck + ((size_t)b * 256 * 4 + hd) * 128;
    const float scale = 0.08838834764831845f;
#pragma unroll
    for (int blk = 0; blk < 2; ++blk) {
        f32x4 kv[8];
#pragma unroll
        for (int it = 0; it < 8; ++it) kv[it] = *(const f32x4*)(kb + (size_t)(32 * wid + 16 * blk + 2 * it + half) * 512 + 4 * l32);
#pragma unroll
        for (int it = 0; it < 8; ++it) {
            float d[4];
#pragma unroll
            for (int t = 0; t < 4; ++t) d[t] = kv[it].x * qv[t].x + kv[it].y * qv[t].y + kv[it].z * qv[t].z + kv[it].w * qv[t].w;
#pragma unroll
            for (int o = 1; o < 32; o <<= 1)
#pragma unroll
                for (int t = 0; t < 4; ++t) d[t] += __shfl_xor(d[t], o);
            if (l32 == 0) *(LAS f32x4*)(sc + (32 * wid + 16 * blk + 2 * it + half) * 4) = (f32x4){d[0] * scale, d[1] * scale, d[2] * scale, d[3] * scale};
        }
    }
    LDS_WAIT(); __syncthreads();
    if (wid == 0) {
        f32x4 e[4]; f32x4 mx = {-3e38f, -3e38f, -3e38f, -3e38f};
#pragma unroll
        for (int k = 0; k < 4; ++k) { e[k] = *(const LAS f32x4*)(sc + (lane + 64 * k) * 4); mx.x = fmaxf(mx.x, e[k].x); mx.y = fmaxf(mx.y, e[k].y); mx.z = fmaxf(mx.z, e[k].z); mx.w = fmaxf(mx.w, e[k].w); }
        mx.x = wave_max(mx.x); mx.y = wave_max(mx.y); mx.z = wave_max(mx.z); mx.w = wave_max(mx.w);
        f32x4 sm = {0.f, 0.f, 0.f, 0.f};
#pragma unroll
        for (int k = 0; k < 4; ++k) { e[k].x = __expf(e[k].x - mx.x); e[k].y = __expf(e[k].y - mx.y); e[k].z = __expf(e[k].z - mx.z); e[k].w = __expf(e[k].w - mx.w); sm += e[k]; }
        sm.x = 1.0f / wave_sum(sm.x); sm.y = 1.0f / wave_sum(sm.y); sm.z = 1.0f / wave_sum(sm.z); sm.w = 1.0f / wave_sum(sm.w);
#pragma unroll
        for (int k = 0; k < 4; ++k) *(LAS f32x4*)(sc + (lane + 64 * k) * 4) = e[k] * sm;
    }
    LDS_WAIT(); __syncthreads();
    const float* vb = cv + ((size_t)b * 256 * 4 + hd) * 128;
    f32x2 o[4] = {{0.f, 0.f}, {0.f, 0.f}, {0.f, 0.f}, {0.f, 0.f}};
#pragma unroll
    for (int blk = 0; blk < 4; ++blk) {
        f32x2 vv[8];
#pragma unroll
        for (int it = 0; it < 8; ++it) vv[it] = *(const f32x2*)(vb + (size_t)(32 * wid + 8 * blk + it) * 512 + 2 * lane);
#pragma unroll
        for (int it = 0; it < 8; ++it) { const f32x4 p = *(const LAS f32x4*)(sc + (32 * wid + 8 * blk + it) * 4);
            o[0] += vv[it] * p.x; o[1] += vv[it] * p.y; o[2] += vv[it] * p.z; o[3] += vv[it] * p.w; }
    }
#pragma unroll
    for (int t = 0; t < 4; ++t) *(LAS f32x2*)(po + (wid * 4 + t) * 128 + 2 * lane) = o[t];
    LDS_WAIT(); __syncthreads();
    { const int t = tid >> 7, d = tid & 127; float s = 0.f;
#pragma unroll
      for (int w8 = 0; w8 < 8; ++w8) s += po[(w8 * 4 + t) * 128 + d];
      const float s1 = __shfl_xor(s, 1);
      if ((d & 1) == 0) *(unsigned*)(CO + (size_t)(MPROMPT + 4 * b + t) * DM + hd * 128 + d) = pk2(s, s1); }
    __syncthreads();
}

DI float reduce8(float (&v)[8], int lane) {
    const bool b5 = (lane & 32) != 0, b4 = (lane & 16) != 0, b3 = (lane & 8) != 0;
#pragma unroll
    for (int i = 0; i < 4; ++i) { const float send = b5 ? v[i] : v[i + 4], keep = b5 ? v[i + 4] : v[i]; v[i] = keep + __shfl_xor(send, 32); }
#pragma unroll
    for (int i = 0; i < 2; ++i) { const float send = b4 ? v[i] : v[i + 2], keep = b4 ? v[i + 2] : v[i]; v[i] = keep + __shfl_xor(send, 16); }
    { const float send = b3 ? v[0] : v[1], keep = b3 ? v[1] : v[0]; v[0] = keep + __shfl_xor(send, 8); }
    v[0] += __shfl_xor(v[0], 4); v[0] += __shfl_xor(v[0], 2); v[0] += __shfl_xor(v[0], 1);
    return v[0];
}
DI float sl4(const float* S, size_t idx) { constexpr size_t ST = (size_t)MSAMPLE * NO; return (S[idx] + S[idx + ST]) + (S[idx + 2 * ST] + S[idx + 3 * ST]); }
DI void hgrn_unit(LAS unsigned char* lds, const float* H1S, const float* lbt, bf16* OG, float* SSQ, const float* norm_g, const float* s0, float* sout,
                  int sb, int hh, int dvh, int tid, int wid, int lane) {
    const int rowbase = MPROMPT + 4 * sb;
    LAS float* SL = (LAS float*)lds;
    float S0r[8], S1r[8];
    if (s0) {
        const int row = tid >> 2, seg = tid & 3;
#pragma unroll
        for (int e = 0; e < 4; ++e) *(LAS f32x4*)(SL + row * 68 + 16 * seg + 4 * e) = *(const f32x4*)(s0 + (size_t)row * 128 + 64 * dvh + 16 * seg + 4 * e);
        LDS_WAIT(); __syncthreads();
#pragma unroll
        for (int i = 0; i < 8; ++i) { S0r[i] = SL[lane * 68 + 8 * wid + i]; S1r[i] = SL[(lane + 64) * 68 + 8 * wid + i]; }
        LDS_WAIT(); __syncthreads();
    } else {
#pragma unroll
        for (int i = 0; i < 8; ++i) { S0r[i] = 0.f; S1r[i] = 0.f; }
    }
    const int idx = ((lane >> 5) & 1) * 4 + ((lane >> 4) & 1) * 2 + ((lane >> 3) & 1);
    const int dvw = 64 * dvh + 8 * wid + idx;
    const float ng = norm_g[hh * 128 + dvw];
    const float lb0 = lbt[hh * 128 + lane], lb1 = lbt[hh * 128 + lane + 64];
#pragma unroll
    for (int tt = 0; tt < 4; ++tt) {
        const size_t rb = (size_t)(4 * sb + tt) * NO + hh * 128;
        const float qa_ = sl4(H1S, rb + lane), qb_ = sl4(H1S, rb + lane + 64), fa_ = sl4(H1S, rb + 4096 + lane), fb_ = sl4(H1S, rb + 4096 + lane + 64), ga_ = sl4(H1S, rb + 12288 + dvw);
        float v[8];
#pragma unroll
        for (int i = 0; i < 8; ++i) v[i] = bf2f((bf16)(pk2(sl4(H1S, rb + 8192 + 64 * dvh + 8 * wid + i), 0.f) & 0xffffu));
        const float qa = bf2f((bf16)(pk2(qa_ * sigmoidf_(qa_), 0.f) & 0xffffu)), qb = bf2f((bf16)(pk2(qb_ * sigmoidf_(qb_), 0.f) & 0xffffu));
        const float f0 = lb0 + (1.0f - lb0) * sigmoidf_(fa_), f1 = lb1 + (1.0f - lb1) * sigmoidf_(fb_), k0 = 1.0f - f0, k1 = 1.0f - f1, sgv = sigmoidf_(ga_);
        float po[8];
#pragma unroll
        for (int i = 0; i < 8; ++i) { S0r[i] = f0 * S0r[i] + k0 * v[i]; S1r[i] = f1 * S1r[i] + k1 * v[i]; po[i] = qa * S0r[i] + qb * S1r[i]; }
        const float o = reduce8(po, lane);
        float sq = o * o; sq += __shfl_xor(sq, 8); sq += __shfl_xor(sq, 16); sq += __shfl_xor(sq, 32);
        const size_t row = (size_t)(rowbase + tt);
        if (lane == 0) atomicAdd(SSQ + row, sq);
        if ((lane & 7) == 0) OG[row * D + hh * 128 + dvw] = (bf16)(pk2(o * ng * sgv, 0.f) & 0xffffu);
    }
#pragma unroll
    for (int i = 0; i < 8; ++i) { SL[lane * 68 + 8 * wid + i] = S0r[i]; SL[(lane + 64) * 68 + 8 * wid + i] = S1r[i]; }
    LDS_WAIT(); __syncthreads();
    { const int row = tid >> 2, seg = tid & 3;
#pragma unroll
      for (int e = 0; e < 4; ++e) *(f32x4*)(sout + (size_t)row * 128 + 64 * dvh + 16 * seg + 4 * e) = *(const LAS f32x4*)(SL + row * 68 + 16 * seg + 4 * e); }
    LDS_WAIT(); __syncthreads();
}

constexpr int HG_QS = 272, HG_TS = 80, HG_Q = 0, HG_K = 8704, HG_KL = 17408, HG_VT = 27648, HG_DEC = 37888, HG_SET = 38400, HG_TOT = 2 * HG_SET, HG_SSQ = HG_TOT + 4096;
#define MFMA16(a, b, c) __builtin_amdgcn_mfma_f32_16x16x32_bf16((a), (b), (c), 0, 0, 0)
DI bf16x8 pack44(const f32x4& lo, const f32x4& hi) { v4u p; p.x = pk2(lo[0], lo[1]); p.y = pk2(lo[2], lo[3]); p.z = pk2(hi[0], hi[1]); p.w = pk2(hi[2], hi[3]); return __builtin_bit_cast(bf16x8, p); }
DI bf16x8 ld2x8(const LAS unsigned char* p, int off2) { const v2u lo = *(const LAS v2u*)p, hi = *(const LAS v2u*)(p + off2); v4u a; a.x = lo.x; a.y = lo.y; a.z = hi.x; a.w = hi.y; return __builtin_bit_cast(bf16x8, a); }

DI float row16_sum(float v) {
    v += __builtin_bit_cast(float, __builtin_amdgcn_update_dpp(0, __builtin_bit_cast(int, v), 0xB1, 0xF, 0xF, true));
    v += __builtin_bit_cast(float, __builtin_amdgcn_update_dpp(0, __builtin_bit_cast(int, v), 0x4E, 0xF, 0xF, true));
    v += __builtin_bit_cast(float, __builtin_amdgcn_update_dpp(0, __builtin_bit_cast(int, v), 0x141, 0xF, 0xF, true));
    v += __builtin_bit_cast(float, __builtin_amdgcn_update_dpp(0, __builtin_bit_cast(int, v), 0x140, 0xF, 0xF, true));
    return v;
}
DI void hgrn_prompt_unit(LAS unsigned char* lds, const bf16* H1, bf16* OG, float* SSQ, const float* norm_g, float* sout, int b, int hh, int tid, int wid, int lane) {
    const int dp = tid & 63, tq = tid >> 6, dk = 2 * dp;
    const int vtok = tid & 31, vdc = tid >> 5;
    const int li = lane & 15, g = lane >> 4;
    const size_t rowbase = (size_t)b * PSEQ;
    const bf16* hb = H1 + rowbase * NO + hh * 128;
    const float ng = norm_g[hh * 128 + 16 * wid + li];
    f32x4 S[8];
#pragma unroll
    for (int t = 0; t < 8; ++t) S[t] = (f32x4){0.f, 0.f, 0.f, 0.f};
    LAS float* TOT = (LAS float*)(lds + HG_TOT); LAS float* SSQP = (LAS float*)(lds + HG_SSQ);
    struct HgPre { unsigned q[4], l[4]; bf16 sg[8]; v4u v; };
    HgPre PA, PB;
    const unsigned poff = (unsigned)((4 * tq) * NO + dk) * 2u, voff = (unsigned)(vtok * NO + 8192 + 8 * vdc) * 2u, soff = (unsigned)((4 * g) * NO + 12288 + 16 * wid + li) * 2u;
#define HG_LOAD(c_) do { const unsigned char* cb = (const unsigned char*)(hb + (size_t)(32 * (c_)) * NO); \
        _Pragma("unroll") for (int e = 0; e < 4; ++e) { qn[e] = *(const unsigned*)(cb + poff + e * (NO * 2)); ln[e] = *(const unsigned*)(cb + poff + e * (NO * 2) + 8192); } \
        vn = *(const v4u*)(cb + voff); \
        _Pragma("unroll") for (int e = 0; e < 8; ++e) sgn[e] = *(const bf16*)(cb + soff + (16 * (e >> 2) + (e & 3)) * (NO * 2)); } while (0)
#define HG_REFS(P_) unsigned (&qn)[4] = (P_).q; unsigned (&ln)[4] = (P_).l; bf16 (&sgn)[8] = (P_).sg; v4u& vn = (P_).v
    { HG_REFS(PA); HG_LOAD(0); }
    { HG_REFS(PB); HG_LOAD(1); }
    auto chunk = [&](const int c, HgPre& P) __attribute__((always_inline)) {
        HG_REFS(P);
        LAS unsigned char* B = lds + (c & 1) * HG_SET;
        float lf[8], pre[8], qv[8]; bf16 sg[8];
        { float run0 = 0.f, run1 = 0.f;
#pragma unroll
          for (int e = 0; e < 4; ++e) { lf[2 * e] = bflo(ln[e]); lf[2 * e + 1] = bfhi(ln[e]); qv[2 * e] = bflo(qn[e]); qv[2 * e + 1] = bfhi(qn[e]);
              run0 += lf[2 * e]; run1 += lf[2 * e + 1]; pre[2 * e] = run0; pre[2 * e + 1] = run1; }
#pragma unroll
          for (int e = 0; e < 8; ++e) sg[e] = sgn[e];
          *(LAS f32x2*)(TOT + tq * 128 + dk) = (f32x2){run0, run1}; }
        const v4u vcur = vn;
        LDS_WAIT(); __builtin_amdgcn_s_barrier(); asm volatile("" ::: "memory");
        if (c > 0 && tid < 32) {
            float s = 0.f;
#pragma unroll
            for (int w8 = 0; w8 < 8; ++w8) s += SSQP[w8 * 32 + tid];
            atomicAdd(SSQ + rowbase + 32 * (c - 1) + tid, s);
        }
        if (c + 2 < 64) HG_LOAD(c + 2);
        {
            f32x2 off = {0.f, 0.f}, total = {0.f, 0.f};
#pragma unroll
            for (int t8 = 0; t8 < 8; ++t8) { const f32x2 tv = *(const LAS f32x2*)(TOT + t8 * 128 + dk); total += tv; if (t8 < tq) off += tv; }
            const float dec0 = __expf(total.x), dec1 = __expf(total.y);
            unsigned kl0[2], kl1[2];
#pragma unroll
            for (int e = 0; e < 4; e += 2) {
                float klv[2][2];
#pragma unroll
                for (int x = 0; x < 2; ++x) { const int tok = 4 * tq + e + x;
                    const float c0 = off.x + pre[2 * (e + x)], c1 = off.y + pre[2 * (e + x) + 1];
                    const float k0 = 1.0f - __expf(lf[2 * (e + x)]), k1 = 1.0f - __expf(lf[2 * (e + x) + 1]);
                    const float e0 = __expf(c0), e1 = __expf(c1), i0 = __builtin_amdgcn_rcpf(e0), i1 = __builtin_amdgcn_rcpf(e1);
                    const float kt0 = k0 * i0, kt1 = k1 * i1;
                    *(LAS unsigned*)(B + HG_Q + tok * HG_QS + dk * 2) = pk2(qv[2 * (e + x)] * e0, qv[2 * (e + x) + 1] * e1);
                    *(LAS unsigned*)(B + HG_K + tok * HG_QS + dk * 2) = pk2(kt0, kt1);
                    klv[x][0] = kt0 * dec0; klv[x][1] = kt1 * dec1; }
                kl0[e >> 1] = pk2(klv[0][0], klv[1][0]); kl1[e >> 1] = pk2(klv[0][1], klv[1][1]);
            }
            *(LAS v2u*)(B + HG_KL + dk * HG_TS + tq * 8) = (v2u){kl0[0], kl0[1]};
            *(LAS v2u*)(B + HG_KL + (dk + 1) * HG_TS + tq * 8) = (v2u){kl1[0], kl1[1]};
            if (tq == 0) *(LAS f32x2*)(B + HG_DEC + dk * 4) = (f32x2){dec0, dec1};
            LAS unsigned char* vt = B + HG_VT + (8 * vdc) * HG_TS + vtok * 2;
            *(LAS bf16*)(vt + 0 * HG_TS) = (bf16)(vcur.x & 0xffffu); *(LAS bf16*)(vt + 1 * HG_TS) = (bf16)(vcur.x >> 16);
            *(LAS bf16*)(vt + 2 * HG_TS) = (bf16)(vcur.y & 0xffffu); *(LAS bf16*)(vt + 3 * HG_TS) = (bf16)(vcur.y >> 16);
            *(LAS bf16*)(vt + 4 * HG_TS) = (bf16)(vcur.z & 0xffffu); *(LAS bf16*)(vt + 5 * HG_TS) = (bf16)(vcur.z >> 16);
            *(LAS bf16*)(vt + 6 * HG_TS) = (bf16)(vcur.w & 0xffffu); *(LAS bf16*)(vt + 7 * HG_TS) = (bf16)(vcur.w >> 16);
        }
        LDS_WAIT(); __builtin_amdgcn_s_barrier(); asm volatile("" ::: "memory");
        f32x4 T00 = {0.f, 0.f, 0.f, 0.f}, T01 = T00, T11 = T00;
#pragma unroll
        for (int kk = 0; kk < 4; ++kk) {
            const bf16x8 kA0 = *(const LAS bf16x8*)(B + HG_K + li * HG_QS + (32 * kk + 8 * g) * 2), kA1 = *(const LAS bf16x8*)(B + HG_K + (16 + li) * HG_QS + (32 * kk + 8 * g) * 2);
            const bf16x8 qB0 = *(const LAS bf16x8*)(B + HG_Q + li * HG_QS + (32 * kk + 8 * g) * 2), qB1 = *(const LAS bf16x8*)(B + HG_Q + (16 + li) * HG_QS + (32 * kk + 8 * g) * 2);
            T00 = MFMA16(kA0, qB0, T00); T01 = MFMA16(kA0, qB1, T01); T11 = MFMA16(kA1, qB1, T11);
        }
#pragma unroll
        for (int r4 = 0; r4 < 4; ++r4) { const bool keep = (4 * g + r4) <= li; T00[r4] = keep ? T00[r4] : 0.f; T11[r4] = keep ? T11[r4] : 0.f; }
        const f32x4 z4 = {0.f, 0.f, 0.f, 0.f};
        const LAS unsigned char* vrow = B + HG_VT + (16 * wid + li) * HG_TS;
        const bf16x8 vBp = ld2x8(vrow + 8 * g, 32);
        f32x4 O0 = MFMA16(pack44(T00, z4), vBp, z4), O1 = MFMA16(pack44(T01, T11), vBp, z4);
#pragma unroll
        for (int kk = 0; kk < 4; ++kk) {
            const bf16x8 bS = pack44(S[2 * kk], S[2 * kk + 1]);
            const bf16x8 qA0 = ld2x8(B + HG_Q + li * HG_QS + (32 * kk + 4 * g) * 2, 32), qA1 = ld2x8(B + HG_Q + (16 + li) * HG_QS + (32 * kk + 4 * g) * 2, 32);
            O0 = MFMA16(qA0, bS, O0); O1 = MFMA16(qA1, bS, O1);
        }
        const bf16x8 vBn = *(const LAS bf16x8*)(vrow + 16 * g);
#pragma unroll
        for (int t = 0; t < 8; ++t) {
            const f32x4 dec = *(const LAS f32x4*)(B + HG_DEC + (16 * t + 4 * g) * 4);
            const bf16x8 klA = *(const LAS bf16x8*)(B + HG_KL + (16 * t + li) * HG_TS + 16 * g);
            S[t] = MFMA16(klA, vBn, S[t] * dec);
        }
        float sq[8];
#pragma unroll
        for (int e = 0; e < 8; ++e) { const float o = (e < 4) ? O0[e & 3] : O1[e & 3]; sq[e] = o * o;
            const size_t row = rowbase + 32 * c + 16 * (e >> 2) + 4 * g + (e & 3);
            OG[row * D + hh * 128 + 16 * wid + li] = (bf16)(pk2(o * ng * bf2f(sg[e]), 0.f) & 0xffffu); }
#pragma unroll
        for (int e = 0; e < 8; ++e) sq[e] = row16_sum(sq[e]);
        if (li == 0) {
#pragma unroll
            for (int e = 0; e < 8; ++e) SSQP[wid * 32 + 16 * (e >> 2) + 4 * g + (e & 3)] = sq[e];
        }
    };
#pragma unroll 1
    for (int c2 = 0; c2 < 64; c2 += 2) { chunk(c2, PA); chunk(c2 + 1, PB); }
    LDS_WAIT(); __syncthreads();
    if (tid < 32) { float s = 0.f;
#pragma unroll
        for (int w8 = 0; w8 < 8; ++w8) s += SSQP[w8 * 32 + tid];
        atomicAdd(SSQ + rowbase + 32 * 63 + tid, s); }
#pragma unroll
    for (int t = 0; t < 8; ++t)
#pragma unroll
        for (int r4 = 0; r4 < 4; ++r4) sout[(size_t)(16 * t + 4 * g + r4) * 128 + 16 * wid + li] = S[t][r4];
    __syncthreads();
#undef HG_LOAD
#undef HG_REFS
}

#ifndef PROBE
#define PROBE 0
#endif
#ifndef PG8_SP2
#define PG8_SP2 true
#endif
#ifndef MK_SPLIT
#define MK_SPLIT 0
#endif
constexpr int N_PHASES = 26;
struct Args { const float* in[36]; float* outp; unsigned char* wsp; int ph_lo, ph_hi; };
enum { I_XP = 0, I_XS, I_CMK, I_CMV, I_CSK, I_CSV, I_S5R, I_S5I, I_SHG, I_MEMP, I_RELB, I_WEIN, I_LAMR, I_LAMI, I_LOGDT, I_BRE, I_BIM, I_CRE, I_CIM, I_S5D, I_WGLU, I_SINK, I_WEOUT,
       I_LBL, I_WOIN, I_NORMG, I_WOOUT, I_WMQ, I_WMK, I_WMV, I_WMO, I_WFG, I_WFU, I_WFD, I_LNG, I_LNB };

DI const float* arg_in(int k) { const char __attribute__((address_space(4)))* p = (const char __attribute__((address_space(4)))*)__builtin_amdgcn_kernarg_segment_ptr(); asm volatile("" : "+s"(p));
    return *(const float* const __attribute__((address_space(4)))*)(p + 8 * k); }
#define ARG(k) arg_in(k)
constexpr int CVA_FIXED = (2048 / 64) * (2048 / 64) + 2 * (4096 / 64) * (4096 / 64) + (4096 / 64) * (16384 / 64);
constexpr int CVA_LAYER = (4096 / 64) * (512 / 64) + (512 / 64) * (4096 / 64) + 2 * (4096 / 64) * (11008 / 64) + (11008 / 64) * (4096 / 64);
constexpr int CVA_NITEMS = CVA_FIXED + 2 * CVA_LAYER - (11008 / 64) * (4096 / 64);
DI CvtItem cvt_decode_a1(int r, unsigned char* wsb) {
    CvtItem I; I.src = nullptr; I.dst = nullptr; I.N = 0; I.K = 0;
    CVT_MAT(ARG(I_WGLU), 2048, 2048, (bf16*)(wsb + WS_WGLU), 0)
    CVT_MAT(ARG(I_WEOUT), 4096, 4096, (bf16*)(wsb + WS_WEOUT), 0)
    CVT_MAT(ARG(I_WOOUT), 4096, 4096, (bf16*)(wsb + WS_WOOUT), 0)
    CVT_MAT(ARG(I_WOIN), 4096, 16384, (bf16*)(wsb + WS_WOIN), 0)
    const int l = r >= CVA_LAYER ? 1 : 0; if (r >= 0) r -= l * CVA_LAYER;
    unsigned char* lw = wsb + WS_LAYER + (size_t)l * LAYER_STRIDE;
    CVT_MAT(ARG(I_WMQ) + (size_t)l * 4096 * 512, 4096, 512, (bf16*)(lw + L_WMQ), 0)
    CVT_MAT(ARG(I_WMO) + (size_t)l * 512 * 4096, 512, 4096, (bf16*)(lw + L_WMO), 0)
    CVT_MAT(ARG(I_WFU) + (size_t)l * 4096 * FF, 4096, FF, (bf16*)(lw + L_WGU), 2)
    CVT_MAT(ARG(I_WFG) + (size_t)l * 4096 * FF, 4096, FF, (bf16*)(lw + L_WGU), 1)
    CVT_MAT(ARG(I_WFD) + (size_t)l * FF * 4096, FF, 4096, (bf16*)(lw + L_WD), 0)
    return I;
}
DI void cvt_run_a1(unsigned char* wsb, LAS unsigned char* scr, int gw, int NGW, int lane) {
    f32x4 va[16], vb[16], vc[16];
    int it = gw;
    if (it >= CVA_NITEMS) return;
    CvtItem Ia = cvt_decode_a1(it, wsb), Ib = Ia, Ic = Ia;
    cvt_load(Ia, va, lane);
    bool hb = it + NGW < CVA_NITEMS;
    if (hb) { Ib = cvt_decode_a1(it + NGW, wsb); cvt_load(Ib, vb, lane); }
    for (;;) {
        const bool hc = it + 2 * NGW < CVA_NITEMS;
        if (hc) { Ic = cvt_decode_a1(it + 2 * NGW, wsb); cvt_load(Ic, vc, lane); }
        cvt_finish(Ia, va, scr, lane);
        if (!hb) break;
        const bool ha = it + 3 * NGW < CVA_NITEMS;
        if (ha) { Ia = cvt_decode_a1(it + 3 * NGW, wsb); cvt_load(Ia, va, lane); }
        cvt_finish(Ib, vb, scr, lane);
        if (!hc) break;
        const bool hb2 = it + 4 * NGW < CVA_NITEMS;
        if (hb2) { Ib = cvt_decode_a1(it + 4 * NGW, wsb); cvt_load(Ib, vb, lane); }
        cvt_finish(Ic, vc, scr, lane);
        if (!ha) break;
        it += 3 * NGW; hb = hb2;
    }
}
#define GEMM_SPLIT(Aptr, Bptr, K_, NSL, SSQP) do { pg8::Gemm g_{(const pg8::bf16_t*)(Aptr), (const pg8::bf16_t*)(Bptr), MPAD, 4096, (K_)}; pg8::SplitOrder S_; S_.init(32, 4096, (K_), G, cu, (NSL)); \
        EpiRes E_{X, XN, (SSQP), PART}; pg8::gemm_phase<EpiRes, pg8::SplitOrder, true, PG8_SP2>(lds + RING_OFF, g_, S_, E_); } while (0)
#define GEMM_CALL(EpiT, Aptr, Bptr, M_, N_, K_, cidx, ...) do { pg8::Gemm g_{(const pg8::bf16_t*)(Aptr), (const pg8::bf16_t*)(Bptr), (M_), (N_), (K_)}; pg8::StaticOrder S_; S_.init((M_), (N_), (K_), G, (cidx)); \
        EpiT E_{__VA_ARGS__}; pg8::gemm_phase<EpiT, pg8::StaticOrder, true, PG8_SP2>(lds + RING_OFF, g_, S_, E_); } while (0)

__global__ void __launch_bounds__(NWAVES * 64, 2) hybrid_fwd(Args args) {
    extern __shared__ __attribute__((aligned(16))) unsigned char lds_raw[];
    LAS unsigned char* lds = (LAS unsigned char*)lds_raw;
    volatile LAS unsigned* MISC = (volatile LAS unsigned*)(lds + MISC_OFF);
    const int tid = threadIdx.x, lane = tid & 63, wid = __builtin_amdgcn_readfirstlane(tid >> 6);
    const int G = gridDim.x, cu = blockIdx.x;
    const int gw = cu * NWAVES + wid, NGW = G * NWAVES;
    gu32* ctl = (gu32*)(args.wsp + WS_CTL);
    for (int u = tid; u < 64; u += NWAVES * 64) ((LAS unsigned*)(lds + MISC_OFF))[u] = 0u;
    __syncthreads();
    XcdBarrier bar = xcd_barrier_post((unsigned*)(ctl + CW_BAR), MISC + 8);
    const int lo = args.ph_lo, hi = args.ph_hi;
    int pid = 0;
#ifndef PMASK
#define PMASK 0xffffffffu
#endif
#ifndef PROBE_TA
#define PROBE_TA -1
#define PROBE_TB -1
#define PROBE_TS 1.0f
#define PROBE_TQ 0.26303f
#endif
#define PH_OPEN(k) if (((PMASK >> (k)) & 1u) && pid >= lo && pid < hi) { if (PROBE_TA >= 0 && cu == 0 && tid == 0) MISC[16 + pid] = (unsigned)__builtin_amdgcn_s_memrealtime();
#define PH_CLOSE if (PROBE_TA >= 0 && pid == N_PHASES - 2 && cu == 0 && tid == 0) { const float us_ = (float)(MISC[16 + PROBE_TB] - MISC[16 + PROBE_TA]) * 0.01f * PROBE_TS; *(float*)(args.wsp + WS_CTL + 8192) = exp2f(rintf(log2f(us_) / PROBE_TQ) * PROBE_TQ) * 1e-3f; }     if (pid + 1 < hi) xcd_barrier(bar); } ++pid;

#define AB ((float*)(args.wsp + WS_AB))
#define BB ((float*)(args.wsp + WS_BB))
#define BT ((float*)(args.wsp + WS_BT))
#define LB ((float*)(args.wsp + WS_LB))
#define SSQ ((float*)(args.wsp + WS_SSQ))
#define WEIN ((bf16*)(args.wsp + WS_WEIN))
#define WGLU ((bf16*)(args.wsp + WS_WGLU))
#define WEOUT ((bf16*)(args.wsp + WS_WEOUT))
#define WOIN ((bf16*)(args.wsp + WS_WOIN))
#define WOOUT ((bf16*)(args.wsp + WS_WOOUT))
#define X ((bf16*)(args.wsp + WS_X))
#define XN ((bf16*)(args.wsp + WS_XN))
#define MIX ((bf16*)(args.wsp + WS_MIX))
#define QC ((bf16*)(args.wsp + WS_QC))
#define CO ((bf16*)(args.wsp + WS_CO))
#define MPB ((bf16*)(args.wsp + WS_MPB))
#define KVM ((bf16*)(args.wsp + WS_KVM))
#define PART ((float*)(args.wsp + WS_HBIG + 200 * MiB))
#define S5TAB ((unsigned char*)(args.wsp + WS_HBIG + 120 * MiB))
#define QSLABP ((float*)(args.wsp + WS_HBIG))
#define QSLABS ((float*)(args.wsp + WS_HBIG + 64 * MiB))
#define H1S ((float*)(args.wsp + WS_H1S))
#define HFS ((float*)(args.wsp + WS_HFS))
#define H0 ((bf16*)(args.wsp + WS_HBIG))
#define Z ((bf16*)(args.wsp + WS_Z))
#define H1 ((bf16*)(args.wsp + WS_HBIG))
#define HF ((bf16*)(args.wsp + WS_HBIG))
#define ws (args.wsp)
#define out (args.outp)
    PH_OPEN(0)
    for (int rep_ = 0; rep_ < (PROBE == 1 ? 2 : 1); ++rep_) {
        LAS unsigned char* scr = lds + wid * 16384;
        constexpr int CNT_P0 = (4096 / 64) * (5120 / 64) + 4 * (4096 / 64) * (512 / 64);
        for (int it = gw; it < CNT_P0; it += NGW) {
            int r = it;
            P0_MAT(ARG(I_WEIN), 4096, 5120, WEIN, 0)
            P0_MAT(ARG(I_WMK), 4096, 512, (bf16*)(ws + WS_LAYER + L_WMKV), 0)
            P0_MAT(ARG(I_WMV), 4096, 512, (bf16*)(ws + WS_LAYER + L_WMKV), 3)
            P0_MAT(ARG(I_WMK) + (size_t)4096 * 512, 4096, 512, (bf16*)(ws + WS_LAYER + LAYER_STRIDE + L_WMKV), 0)
            P0_MAT(ARG(I_WMV) + (size_t)4096 * 512, 4096, 512, (bf16*)(ws + WS_LAYER + LAYER_STRIDE + L_WMKV), 3)
        }
        for (int m = gw; m < MPAD; m += NGW) {
            const float* src = m < MPROMPT ? ARG(I_XP) + (size_t)m * D : (m < MREAL ? ARG(I_XS) + (size_t)(m - MPROMPT) * D : nullptr);
            copy_row(src, nullptr, 1.f, XN + (size_t)m * D, lane);
        }
        for (int m = gw; m < 1024; m += NGW) copy_row(ARG(I_MEMP) + (size_t)m * D, nullptr, 1.f, MPB + (size_t)m * D, lane);
        const int gt = cu * (NWAVES * 64) + tid, NGT = G * NWAVES * 64;
        for (int e = gt; e < 128 * 64; e += NGT) {
            const int g = e >> 6;
            const float lr = fminf(ARG(I_LAMR)[e], -1e-4f), li = ARG(I_LAMI)[e], dt = expf(ARG(I_LOGDT)[g]);
            const float mag = expf(lr * dt), are = mag * cosf(li * dt), aim = mag * sinf(li * dt), den = lr * lr + li * li;
            const float fr = ((are - 1.0f) * lr + aim * li) / den, fi = (aim * lr - (are - 1.0f) * li) / den;
            AB[2 * e] = are; AB[2 * e + 1] = aim;
            for (int h = 0; h < 16; ++h) { const float br = ARG(I_BRE)[(size_t)e * 16 + h], bi = ARG(I_BIM)[(size_t)e * 16 + h];
                BB[(size_t)e * 32 + h] = fr * br - fi * bi; BB[(size_t)e * 32 + 16 + h] = fr * bi + fi * br; }
        }
        for (int e = gt; e < 32 * 128; e += NGT) {
            const int hq = e >> 7, n = e & 127; int bucket = n;
            if (n >= 16) { const int lg = 16 + (int)(logf((float)n / 16.0f) / 2.0794415416798357f * 16.0f); bucket = lg < 31 ? lg : 31; }
            BT[e] = ARG(I_RELB)[bucket * 32 + hq];
        }
        for (int e = gt; e < 4096; e += NGT) { const float l0 = ARG(I_LBL)[e], l1 = ARG(I_LBL)[4096 + e]; LB[e] = 1.0f / (1.0f + expf(l0 - l1)); }
        for (int e = gt; e < MPAD; e += NGT) SSQ[e] = 0.f;
    }
    PH_CLOSE

    PH_OPEN(1)
    {
        if (cu & 1) {
            {
                s5_build_tables(S5TAB, AB, BB, ARG(I_CRE), ARG(I_CIM), ARG(I_S5D), cu * (NWAVES * 64) + tid, G * NWAVES * 64);
                GEMM_CALL(EpiStoreBf16, XN, WEIN, MPAD, NE, 4096, cu, H0, NE);
                GEMM_CALL(EpiMemKV, MPB, ws + WS_LAYER + L_WMKV, 1024, 1024, 4096, (cu + G - 148) % G, out + O_PMK, out + O_PMV, KVM);
                GEMM_CALL(EpiMemKV, MPB, ws + WS_LAYER + LAYER_STRIDE + L_WMKV, 1024, 1024, 4096, (cu + G - 164) % G, out + O_PMK + 524288, out + O_PMV + 524288, KVM + 1024 * 1024);
            }
            {
                cvt_run_a1(ws, lds + wid * 16384, gw, NGW, lane);
                LDS_WAIT(); __syncthreads();
            }
        } else {
            {
                cvt_run_a1(ws, lds + wid * 16384, gw, NGW, lane);
                LDS_WAIT(); __syncthreads();
            }
            {
                s5_build_tables(S5TAB, AB, BB, ARG(I_CRE), ARG(I_CIM), ARG(I_S5D), cu * (NWAVES * 64) + tid, G * NWAVES * 64);
                GEMM_CALL(EpiStoreBf16, XN, WEIN, MPAD, NE, 4096, cu, H0, NE);
                GEMM_CALL(EpiMemKV, MPB, ws + WS_LAYER + L_WMKV, 1024, 1024, 4096, (cu + G - 148) % G, out + O_PMK, out + O_PMV, KVM);
                GEMM_CALL(EpiMemKV, MPB, ws + WS_LAYER + LAYER_STRIDE + L_WMKV, 1024, 1024, 4096, (cu + G - 164) % G, out + O_PMK + 524288, out + O_PMV + 524288, KVM + 1024 * 1024);
            }
        }
    }
    PH_CLOSE

    PH_OPEN(2)
    for (int rep_ = 0; rep_ < ((PROBE == 2 || PROBE == 7) ? 2 : 1); ++rep_) {
        const float* sinks = ARG(I_SINK);
#ifndef NO_U0
        {
        for (int i = cu; i < 128; i += G) s5_mfma_unit(lds, H0, Z, S5TAB, AB, out + O_PS5R, out + O_PS5I, i, tid, wid, lane);
        const int s_first = (G == 256) ? (cu >= 128 ? cu - 128 : 128) : cu, s_step = (G == 256) ? 128 : G;
        for (int j = s_first; j < 128; j += s_step) { const int wu = 8 * j + wid;
            s5_sample_wave(lds, H0, Z, AB, BB, ARG(I_CRE), ARG(I_CIM), ARG(I_S5D), ARG(I_S5R), ARG(I_S5I), out + O_SS5R, out + O_SS5I, wu & 127, 4 * (wu >> 7), 4, wid, lane);
            __syncthreads(); }
        }
#endif
#ifndef NO_U2
        if (!(PROBE == 7 && rep_ == 0))
        for (int i = cu; i < 1024; i += G) { const int u = i;
            swa_prompt_unit(lds, H0, MIX, BT, sinks, out + O_PSK, out + O_PSV, u >> 8, (u >> 5) & 7, u & 31, tid, wid, lane); }
#endif
#ifndef NO_U3
        if (!(PROBE == 7 && rep_ == 0))
        for (int i = cu; i < 256; i += G) { const int u = i;
            swa_sample_unit(lds, H0, MIX, BT, sinks, ARG(I_CSK), ARG(I_CSV), out + O_SSK, out + O_SSV, u >> 3, u & 7, tid, wid, lane); }
#endif
#if PROBE == 8
#ifndef NO_U2
        for (int i = cu; i < 1024; i += G) { const int u = i;
            swa_prompt_unit(lds, H0, MIX, BT, sinks, out + O_PSK, out + O_PSV, u >> 8, (u >> 5) & 7, u & 31, tid, wid, lane); }
#endif
#ifndef NO_U3
        for (int i = cu; i < 256; i += G) { const int u = i;
            swa_sample_unit(lds, H0, MIX, BT, sinks, ARG(I_CSK), ARG(I_CSV), out + O_SSK, out + O_SSV, u >> 3, u & 7, tid, wid, lane); }
#endif
#endif
    }
    PH_CLOSE

    PH_OPEN(3)
    { GEMM_CALL(EpiGlu, Z, WGLU, MPAD, 2048, 2048, cu, Z, MIX); }
    PH_CLOSE

    PH_OPEN(4)
    { GEMM_SPLIT(MIX, WEOUT, 4096, 16, nullptr); }
    PH_CLOSE

    {
        constexpr int l = 0;
        unsigned char* lw = ws + WS_LAYER + (size_t)l * LAYER_STRIDE;
        const float* lng = ARG(I_LNG) + (size_t)l * 3 * D; const float* lnb = ARG(I_LNB) + (size_t)l * 3 * D;
        PH_OPEN(8)
        { if (PROBE == 4) ln_phase(lds, X, PART, 16, lng, lnb, nullptr, (bf16*)(args.wsp + WS_HBIG + 140 * MiB), gw, NGW, lane);
          ln_phase(lds, X, PART, 16, lng, lnb, nullptr, XN, gw, NGW, lane); }
        PH_CLOSE
        PH_OPEN(9)
        { pg8::Gemm g_{(const pg8::bf16_t*)(XN), (const pg8::bf16_t*)(lw + L_WMQ), MPAD, 512, 4096}; pg8::SplitAllOrder S_; S_.init(4096, G, cu); EpiSlab E_{QSLABP, QSLABS};
          pg8::gemm_phase<EpiSlab, pg8::SplitAllOrder, true, PG8_SP2>(lds + RING_OFF, g_, S_, E_); }
        PH_CLOSE
        PH_OPEN(10)
        {
            for (int i = cu; i < 128; i += G) cross_prompt_unit(lds, QSLABP, KVM + (size_t)l * 1024 * 1024, CO, i >> 5, (i >> 3) & 3, i & 7, tid, wid, lane);
            for (int i = 128 + ((cu - 128 % G + G) % G); i < 256; i += G) { const int wu = i - 128;
                cross_sample_unit(lds, QSLABS, ARG(I_CMK) + (size_t)l * 32 * 256 * 512, ARG(I_CMV) + (size_t)l * 32 * 256 * 512, CO, wu >> 2, wu & 3, tid, wid, lane); }
        }
        PH_CLOSE
        PH_OPEN(11)
        { GEMM_SPLIT(CO, lw + L_WMO, 512, 4, nullptr); }
        PH_CLOSE
        PH_OPEN(12)
        { if (PROBE == 4) ln_phase(lds, X, PART, 4, lng + D, lnb + D, nullptr, (bf16*)(args.wsp + WS_HBIG + 140 * MiB), gw, NGW, lane);
          ln_phase(lds, X, PART, 4, lng + D, lnb + D, nullptr, XN, gw, NGW, lane); }
        PH_CLOSE
        PH_OPEN(13)
        { pg8::Gemm g_{(const pg8::bf16_t*)(XN), (const pg8::bf16_t*)(lw + L_WGU), MPAD, 2 * FF, 4096}; pg8::GuOrder S_; S_.init(2 * FF, 4096, G, cu); EpiGU E_{HF, HFS};
          pg8::gemm_phase<EpiGU, pg8::GuOrder, true, PG8_SP2>(lds + RING_OFF, g_, S_, E_); }
        PH_CLOSE
        PH_OPEN(13)
        { ffn_act_sample(HFS, HF, cu * (NWAVES * 64) + tid, G * NWAVES * 64); }
        PH_CLOSE
        PH_OPEN(14)
        { if (PROBE == 5) GEMM_CALL(EpiStoreBf16, HF, lw + L_WD, MPAD, 4096, FF, cu, MIX, 4096);
          if (PROBE == 6) { pg8::Gemm g_{(const pg8::bf16_t*)(HF), (const pg8::bf16_t*)(lw + L_WD), MPAD, 4096, FF}; pg8::SplitOrder S_; S_.init(32, 4096, FF, G, cu, 16); EpiStoreBf16 E_{MIX, 4096}; pg8::gemm_phase<EpiStoreBf16, pg8::SplitOrder, true, PG8_SP2>(lds + RING_OFF, g_, S_, E_); }
          GEMM_SPLIT(HF, lw + L_WD, FF, 16, nullptr); }
        PH_CLOSE
        PH_OPEN(15)
        { if (PROBE == 4) ln_phase(lds, X, PART, 16, lng + 2 * D, lnb + 2 * D, nullptr, (bf16*)(args.wsp + WS_HBIG + 140 * MiB), gw, NGW, lane);
          if (l == 1) ln_phase(lds, X, PART, 16, lng + 2 * D, lnb + 2 * D, out + O_Y, XN, gw, NGW, lane, PROBE_TA >= 0 ? 1.0f + *(const float*)(args.wsp + WS_CTL + 8192) : 1.0f); else ln_phase(lds, X, PART, 16, lng + 2 * D, lnb + 2 * D, nullptr, XN, gw, NGW, lane); }
        PH_CLOSE
    }
    {
            PH_OPEN(5)
            { pg8::Gemm g_{(const pg8::bf16_t*)(XN), (const pg8::bf16_t*)(WOIN), MPAD, NO, 4096}; pg8::SplitOrder S_; S_.init(32, NO, 4096, G, cu, 4); EpiOddIn E_{H1, LB, H1S};
              pg8::gemm_phase<EpiOddIn, pg8::SplitOrder, true, PG8_SP2>(lds + RING_OFF, g_, S_, E_); }
            PH_CLOSE
            PH_OPEN(6)
            for (int rep_ = ((PROBE == 3 || PROBE == 9) ? 0 : 1); rep_ < 2; ++rep_) {
                float* ssq_ = rep_ ? SSQ : (float*)(args.wsp + WS_CO);
                for (int i = cu; i < 128; i += G) hgrn_prompt_unit(lds, H1, MIX, ssq_, ARG(I_NORMG), out + O_PHG + (size_t)i * 16384, i >> 5, i & 31, tid, wid, lane);
                const int s_first = (G == 256) ? (cu >= 128 ? cu - 128 : 2048) : cu, s_step = (G == 256) ? 128 : G;
                if (!(PROBE == 9 && rep_ == 0))
                for (int u = s_first; u < 2048; u += s_step) { const int b = u >> 6, hh = (u >> 1) & 31, dvh = u & 1;
                    hgrn_unit(lds, H1S, LB, MIX, ssq_, ARG(I_NORMG), ARG(I_SHG) + (size_t)(b * 32 + hh) * 16384, out + O_SHG + (size_t)(b * 32 + hh) * 16384, b, hh, dvh, tid, wid, lane); }
                if (rep_ == 1 && (G != 256 || cu >= 128)) {
                    LAS unsigned char* scr = lds + wid * 16384;
                    unsigned char* lw1 = ws + WS_LAYER + LAYER_STRIDE;
                    constexpr int CNT_G = (4096 / 64) * (11008 / 64), CNT_D = (11008 / 64) * (4096 / 64);
                    const int w0 = (G == 256) ? (cu - 128) * NWAVES + wid : gw, nw = (G == 256) ? 128 * NWAVES : NGW;
                    for (int it = w0; it < CNT_D; it += nw) { int r = it;
                        P0_MAT(ARG(I_WFD) + (size_t)FF * 4096, FF, 4096, (bf16*)(lw1 + L_WD), 0)
                    }
                }
            }
            PH_CLOSE
            PH_OPEN(7)
            { GEMM_SPLIT(MIX, WOOUT, 4096, 16, SSQ); }
            PH_CLOSE
    }
    {
        constexpr int l = 1;
        unsigned char* lw = ws + WS_LAYER + (size_t)l * LAYER_STRIDE;
        const float* lng = ARG(I_LNG) + (size_t)l * 3 * D; const float* lnb = ARG(I_LNB) + (size_t)l * 3 * D;
        PH_OPEN(8)
        { if (PROBE == 4) ln_phase(lds, X, PART, 16, lng, lnb, nullptr, (bf16*)(args.wsp + WS_HBIG + 140 * MiB), gw, NGW, lane);
          ln_phase(lds, X, PART, 16, lng, lnb, nullptr, XN, gw, NGW, lane); }
        PH_CLOSE
        PH_OPEN(9)
        { pg8::Gemm g_{(const pg8::bf16_t*)(XN), (const pg8::bf16_t*)(lw + L_WMQ), MPAD, 512, 4096}; pg8::SplitAllOrder S_; S_.init(4096, G, cu); EpiSlab E_{QSLABP, QSLABS};
          pg8::gemm_phase<EpiSlab, pg8::SplitAllOrder, true, PG8_SP2>(lds + RING_OFF, g_, S_, E_); }
        PH_CLOSE
        PH_OPEN(10)
        {
            for (int i = cu; i < 128; i += G) cross_prompt_unit(lds, QSLABP, KVM + (size_t)l * 1024 * 1024, CO, i >> 5, (i >> 3) & 3, i & 7, tid, wid, lane);
            for (int i = 128 + ((cu - 128 % G + G) % G); i < 256; i += G) { const int wu = i - 128;
                cross_sample_unit(lds, QSLABS, ARG(I_CMK) + (size_t)l * 32 * 256 * 512, ARG(I_CMV) + (size_t)l * 32 * 256 * 512, CO, wu >> 2, wu & 3, tid, wid, lane); }
        }
        PH_CLOSE
        PH_OPEN(11)
        { GEMM_SPLIT(CO, lw + L_WMO, 512, 4, nullptr); }
        PH_CLOSE
        PH_OPEN(12)
        { if (PROBE == 4) ln_phase(lds, X, PART, 4, lng + D, lnb + D, nullptr, (bf16*)(args.wsp + WS_HBIG + 140 * MiB), gw, NGW, lane);
          ln_phase(lds, X, PART, 4, lng + D, lnb + D, nullptr, XN, gw, NGW, lane); }
        PH_CLOSE
        PH_OPEN(13)
        { pg8::Gemm g_{(const pg8::bf16_t*)(XN), (const pg8::bf16_t*)(lw + L_WGU), MPAD, 2 * FF, 4096}; pg8::GuOrder S_; S_.init(2 * FF, 4096, G, cu); EpiGU E_{HF, HFS};
          pg8::gemm_phase<EpiGU, pg8::GuOrder, true, PG8_SP2>(lds + RING_OFF, g_, S_, E_); }
        PH_CLOSE
        PH_OPEN(13)
        { ffn_act_sample(HFS, HF, cu * (NWAVES * 64) + tid, G * NWAVES * 64); }
        PH_CLOSE
        PH_OPEN(14)
        { if (PROBE == 5) GEMM_CALL(EpiStoreBf16, HF, lw + L_WD, MPAD, 4096, FF, cu, MIX, 4096);
          if (PROBE == 6) { pg8::Gemm g_{(const pg8::bf16_t*)(HF), (const pg8::bf16_t*)(lw + L_WD), MPAD, 4096, FF}; pg8::SplitOrder S_; S_.init(32, 4096, FF, G, cu, 16); EpiStoreBf16 E_{MIX, 4096}; pg8::gemm_phase<EpiStoreBf16, pg8::SplitOrder, true, PG8_SP2>(lds + RING_OFF, g_, S_, E_); }
          GEMM_SPLIT(HF, lw + L_WD, FF, 16, nullptr); }
        PH_CLOSE
        PH_OPEN(15)
        { if (PROBE == 4) ln_phase(lds, X, PART, 16, lng + 2 * D, lnb + 2 * D, nullptr, (bf16*)(args.wsp + WS_HBIG + 140 * MiB), gw, NGW, lane);
          if (l == 1) ln_phase(lds, X, PART, 16, lng + 2 * D, lnb + 2 * D, out + O_Y, XN, gw, NGW, lane, PROBE_TA >= 0 ? 1.0f + *(const float*)(args.wsp + WS_CTL + 8192) : 1.0f); else ln_phase(lds, X, PART, 16, lng + 2 * D, lnb + 2 * D, nullptr, XN, gw, NGW, lane); }
        PH_CLOSE
    }
#undef PH_OPEN
#undef PH_CLOSE
}
#undef AB
#undef BB
#undef BT
#undef LB
#undef SSQ
#undef WEIN
#undef WGLU
#undef WEOUT
#undef WOIN
#undef WOOUT
#undef X
#undef XN
#undef MIX
#undef QC
#undef CO
#undef MPB
#undef KVM
#undef H0
#undef HFS
#undef H1S
#undef QSLABP
#undef QSLABS
#undef S5TAB
#undef PART
#undef Z
#undef H1
#undef HF
#undef ws
#undef out

extern "C" void kernel_launch(void* const* d_in, const int* in_sizes, int n_in, void* d_out, int out_size, void* d_ws, size_t ws_size, hipStream_t stream) {
    static int grid = 0;
    if (grid == 0) {
        if (n_in != 36 || in_sizes[0] != MPROMPT * D || (size_t)out_size != O_END || ws_size < WS_END) {
            fprintf(stderr, "kernel_launch: shape/workspace mismatch: n_in %d in0 %d out %d ws %zu (need %zu); nothing launched\n", n_in, n_in > 0 ? in_sizes[0] : -1, out_size, ws_size, (size_t)WS_END); grid = -1; return; }
        int dev = 0, cus = 0, per_cu = 0;
        if (hipGetDevice(&dev) != hipSuccess || hipDeviceGetAttribute(&cus, hipDeviceAttributeMultiprocessorCount, dev) != hipSuccess) { grid = -1; return; }
        if (hipFuncSetAttribute((const void*)hybrid_fwd, hipFuncAttributeMaxDynamicSharedMemorySize, LDS_BYTES) != hipSuccess) { fprintf(stderr, "kernel_launch: hipFuncSetAttribute failed\n"); grid = -1; return; }
        if (hipOccupancyMaxActiveBlocksPerMultiprocessor(&per_cu, (const void*)hybrid_fwd, NWAVES * 64, LDS_BYTES) != hipSuccess || per_cu < 1)
            fprintf(stderr, "kernel_launch: note: occupancy query reports %d workgroups per CU\n", per_cu);
        (void)hipGetLastError();
        grid = cus;
    }
    if (grid < 0) return;
    if (hipMemsetAsync((char*)d_ws + WS_CTL, 0, CTL_ZERO_BYTES, stream) != hipSuccess) return;
    Args a{};
    for (int i = 0; i < 36; ++i) a.in[i] = (const float*)d_in[i];
    a.outp = (float*)d_out; a.wsp = (unsigned char*)d_ws;
#if MK_SPLIT
    for (int p = 0; p < N_PHASES; ++p) { a.ph_lo = p; a.ph_hi = p + 1; hipLaunchKernelGGL(hybrid_fwd, dim3(grid), dim3(NWAVES * 64), LDS_BYTES, stream, a); }
#else
    a.ph_lo = 0; a.ph_hi = N_PHASES;
    hipLaunchKernelGGL(hybrid_fwd, dim3(grid), dim3(NWAVES * 64), LDS_BYTES, stream, a);
#endif
    const hipError_t le = hipPeekAtLastError();
    if (le != hipSuccess) fprintf(stderr, "kernel_launch: launch failed: %s\n", hipGetErrorName(le));
}
```
